# Optimizing an MI355X kernel written in HIP

```python
import math
import jax, jax.numpy as jnp
from jax import lax
import numpy as np

D_MODEL = 1024
BATCH = 8
SEQ = 4096
DEPTH = 2

N_EVEN = (DEPTH + 1) // 2
N_ODD = DEPTH // 2
EPS = 1e-6
CONV_WIDTH = 4

LRU_WIDTH = D_MODEL
LRU_HEADS = 8
LRU_HEAD_DIM = LRU_WIDTH // LRU_HEADS
LRU_C = 8.0
MLSTM_WIDTH = D_MODEL
MLSTM_HEADS = 8
MLSTM_HEAD_DIM = MLSTM_WIDTH // MLSTM_HEADS
MLSTM_QKV_BLOCK = 4
MLSTM_CHUNK = 128
EVEN_IN = 2 * LRU_WIDTH + 2 * MLSTM_WIDTH
EVEN_MIX = LRU_WIDTH + MLSTM_WIDTH

SSD_INNER = 2 * D_MODEL
SSD_HEAD_DIM = 64
SSD_HEADS = SSD_INNER // SSD_HEAD_DIM
SSD_GROUPS = 8
SSD_HPG = SSD_HEADS // SSD_GROUPS
SSD_STATE = 128
SSD_CHUNK = 128
SSD_CONV_CH = SSD_INNER + 2 * SSD_GROUPS * SSD_STATE
SSD_IN = SSD_INNER + SSD_CONV_CH + SSD_HEADS

N_EXPERTS = 32
TOP_K = 4
D_FF = D_MODEL
SWIGLU_ALPHA = 1.702
SWIGLU_LIMIT = 7.0
MOE_BLOCK = 256

kernel_name = 'hybrid_lru_mlstm_ssd_moe_adaln'


def rmsnorm(x, g):
    xf = x.astype(jnp.float32)
    y = xf * lax.rsqrt(jnp.mean(xf * xf, axis=-1, keepdims=True) + EPS)
    return y * g.astype(jnp.float32)


def modulate(h, shift, scale):
    return h * (1.0 + scale[:, None, :]) + shift[:, None, :]


def causal_dwconv(x, w, b):
    seq = x.shape[1]
    xp = jnp.pad(x, ((0, 0), (CONV_WIDTH - 1, 0), (0, 0)))
    out = b + xp[:, 0:seq] * w[0]
    for j in range(1, CONV_WIDTH):
        out = out + xp[:, j:j + seq] * w[j]
    return out


def rg_lru(x, w_r, b_r, w_i, b_i, lam):
    bsz, seq, width = x.shape
    x = x.astype(jnp.float32)
    xh = x.reshape(bsz, seq, LRU_HEADS, LRU_HEAD_DIM)
    r = jax.nn.sigmoid(jnp.einsum('bshd,hde->bshe', xh, w_r) + b_r).reshape(bsz, seq, width)
    i = jax.nn.sigmoid(jnp.einsum('bshd,hde->bshe', xh, w_i) + b_i).reshape(bsz, seq, width)
    log_a = LRU_C * r * jax.nn.log_sigmoid(lam.astype(jnp.float32))
    a = jnp.exp(log_a)
    u = jnp.sqrt(-jnp.expm1(2.0 * log_a)) * (i * x)

    def combine(left, right):
        a_l, u_l = left
        a_r, u_r = right
        return a_l * a_r, a_r * u_l + u_r

    _, h = lax.associative_scan(combine, (a, u), axis=1)
    return h


def mlstm_chunkwise(q, k, v, ig, lf):
    bsz, nh, seq, dh = q.shape
    L = MLSTM_CHUNK
    nc = seq // L
    k = k * (dh ** -0.5)

    def to_chunks(t):
        return jnp.moveaxis(t.reshape(bsz, nh, nc, L, *t.shape[3:]), 2, 0)

    causal = jnp.tril(jnp.ones((L, L), dtype=bool))

    def step(carry, inp):
        C, n, m = carry
        q_, k_, v_, i_, f_ = inp
        g = jnp.cumsum(f_, axis=-1)
        dmat = g[..., :, None] - g[..., None, :] + i_[..., None, :]
        dmat = jnp.where(causal, dmat, -jnp.inf)
        m_inter = m[..., None] + g
        m_t = jnp.maximum(m_inter, jnp.max(dmat, axis=-1))
        w_intra = jnp.exp(dmat - m_t[..., None])
        w_inter = jnp.exp(m_inter - m_t)
        qk = jnp.einsum('bhtd,bhsd->bhts', q_, k_) * w_intra
        num = jnp.einsum('bhts,bhse->bhte', qk, v_) + w_inter[..., None] * jnp.einsum('bhtd,bhde->bhte', q_, C)
        den = jnp.sum(qk, axis=-1) + w_inter * jnp.einsum('bhtd,bhd->bht', q_, n)
        h = num / jnp.maximum(jnp.abs(den), jnp.exp(-m_t))[..., None]
        G = g[..., -1]
        dec_s = G[..., None] - g + i_
        m_new = jnp.maximum(m + G, jnp.max(dec_s, axis=-1))
        ws = jnp.exp(dec_s - m_new[..., None])
        wc = jnp.exp(m + G - m_new)
        C_new = wc[..., None, None] * C + jnp.einsum('bhs,bhsd,bhse->bhde', ws, k_, v_)
        n_new = wc[..., None] * n + jnp.einsum('bhs,bhsd->bhd', ws, k_)
        return (C_new, n_new, m_new), h

    init = (jnp.zeros((bsz, nh, dh, dh), jnp.float32),
            jnp.zeros((bsz, nh, dh), jnp.float32),
            jnp.full((bsz, nh), -jnp.inf, jnp.float32))
    _, hs = lax.scan(step, init, (to_chunks(q), to_chunks(k), to_chunks(v), to_chunks(ig), to_chunks(lf)))
    return jnp.moveaxis(hs, 0, 2).reshape(bsz, nh, seq, dh)


def mlstm_branch(xb, zb, conv_w, conv_b, w_q, w_k, w_v, w_ig, b_ig, w_fg, b_fg, norm_w, skip):
    bsz, seq, width = xb.shape
    xb = xb.astype(jnp.float32)
    xc = jax.nn.silu(causal_dwconv(xb, conv_w, conv_b))

    def headwise(t, w):
        tb = t.reshape(bsz, seq, width // MLSTM_QKV_BLOCK, MLSTM_QKV_BLOCK)
        return jnp.einsum('bsnd,nde->bsne', tb, w).reshape(bsz, seq, width)

    q = headwise(xc, w_q)
    k = headwise(xc, w_k)
    v = headwise(xb, w_v)
    qkv = jnp.concatenate([q, k, v], axis=-1)
    ig = jnp.transpose(qkv @ w_ig + b_ig, (0, 2, 1))
    lf = jnp.transpose(jax.nn.log_sigmoid(qkv @ w_fg + b_fg), (0, 2, 1))

    def heads(t):
        return jnp.transpose(t.reshape(bsz, seq, MLSTM_HEADS, MLSTM_HEAD_DIM), (0, 2, 1, 3))

    h = mlstm_chunkwise(heads(q), heads(k), heads(v), ig, lf)
    h = jnp.transpose(h, (0, 2, 1, 3))
    mu = jnp.mean(h, axis=-1, keepdims=True)
    var = jnp.mean(jnp.square(h - mu), axis=-1, keepdims=True)
    hn = ((h - mu) * lax.rsqrt(var + EPS)).reshape(bsz, seq, width) * norm_w
    return (hn + skip * xc) * jax.nn.silu(zb)


def even_mixer(u, w_in, lru_conv_w, lru_conv_b, lru_w_r, lru_b_r, lru_w_i, lru_b_i, lru_lambda,
               ml_conv_w, ml_conv_b, ml_w_q, ml_w_k, ml_w_v, ml_w_ig, ml_b_ig, ml_w_fg, ml_b_fg,
               ml_norm, ml_skip, w_out):
    proj = u @ w_in
    xa, ga, xb, zb = jnp.split(proj, [LRU_WIDTH, 2 * LRU_WIDTH, 2 * LRU_WIDTH + MLSTM_WIDTH], axis=-1)
    ya = rg_lru(causal_dwconv(xa, lru_conv_w, lru_conv_b), lru_w_r, lru_b_r, lru_w_i, lru_b_i, lru_lambda)
    ya = ya * jax.nn.gelu(ga)
    yb = mlstm_branch(xb, zb, ml_conv_w, ml_conv_b, ml_w_q, ml_w_k, ml_w_v, ml_w_ig, ml_b_ig,
                      ml_w_fg, ml_b_fg, ml_norm, ml_skip)
    return jnp.concatenate([ya, yb], axis=-1) @ w_out


def ssd_chunked(x, dt, A, Bm, Cm):
    bsz, seq = x.shape[:2]
    L = SSD_CHUNK
    nc = seq // L

    def to_chunks(t):
        return jnp.moveaxis(t.reshape(bsz, nc, L, *t.shape[2:]), 1, 0)

    causal = jnp.tril(jnp.ones((L, L), dtype=bool))[None, :, :, None, None]

    def step(state, inp):
        x_, dt_, B_, C_ = inp
        a = jnp.cumsum(dt_ * A, axis=1)
        seg = a[:, :, None] - a[:, None, :]
        decay = jnp.exp(jnp.where(causal, seg, -jnp.inf))
        cb = jnp.einsum('btgn,bsgn->btsg', C_, B_)
        w = cb[..., None] * decay * dt_[:, None]
        y_intra = jnp.einsum('btsgh,bsghp->btghp', w, x_)
        y_inter = jnp.einsum('btgn,bghpn->btghp', C_, state) * jnp.exp(a)[..., None]
        a_last = a[:, -1]
        ws = jnp.exp(a_last[:, None] - a) * dt_
        new_state = jnp.exp(a_last)[..., None, None] * state + jnp.einsum('bsgh,bsghp,bsgn->bghpn', ws, x_, B_)
        return new_state, y_intra + y_inter

    init = jnp.zeros((bsz, SSD_GROUPS, SSD_HPG, SSD_HEAD_DIM, SSD_STATE), jnp.float32)
    _, ys = lax.scan(step, init, (to_chunks(x), to_chunks(dt), to_chunks(Bm), to_chunks(Cm)))
    return jnp.moveaxis(ys, 0, 1).reshape(x.shape)


def ssd_mixer(u, w_in, conv_w, conv_b, dt_bias, a_log, d_skip, norm_w, w_out):
    bsz, seq, _ = u.shape
    proj = u @ w_in
    z = proj[..., :SSD_INNER]
    xbc = jax.nn.silu(causal_dwconv(proj[..., SSD_INNER:SSD_INNER + SSD_CONV_CH], conv_w, conv_b)).astype(jnp.float32)
    dt = jax.nn.softplus(proj[..., SSD_INNER + SSD_CONV_CH:] + dt_bias).astype(jnp.float32)
    gn = SSD_GROUPS * SSD_STATE
    xs = xbc[..., :SSD_INNER].reshape(bsz, seq, SSD_GROUPS, SSD_HPG, SSD_HEAD_DIM)
    Bm = xbc[..., SSD_INNER:SSD_INNER + gn].reshape(bsz, seq, SSD_GROUPS, SSD_STATE)
    Cm = xbc[..., SSD_INNER + gn:].reshape(bsz, seq, SSD_GROUPS, SSD_STATE)
    dt = dt.reshape(bsz, seq, SSD_GROUPS, SSD_HPG)
    A = -jnp.exp(a_log.astype(jnp.float32)).reshape(SSD_GROUPS, SSD_HPG)
    y = ssd_chunked(xs, dt, A, Bm, Cm)
    y = y + d_skip.reshape(SSD_GROUPS, SSD_HPG)[:, :, None] * xs
    y = (y.reshape(bsz, seq, SSD_INNER) * jax.nn.silu(z)).reshape(bsz, seq, SSD_GROUPS, SSD_INNER // SSD_GROUPS)
    y = y * lax.rsqrt(jnp.mean(y * y, axis=-1, keepdims=True) + EPS)
    y = y.reshape(bsz, seq, SSD_INNER) * norm_w
    return y @ w_out


def moe_ffn(u, router_w, router_b, w_gu, b_gu, w_down, b_down):
    bsz, seq, dm = u.shape
    xf = u.reshape(-1, dm)
    nt = xf.shape[0]
    logits = (xf @ router_w + router_b).astype(jnp.float32)
    top_v, top_i = lax.top_k(logits, TOP_K)
    gates = jax.nn.softmax(top_v, axis=-1)
    n_assign = nt * TOP_K
    flat_e = top_i.reshape(-1)
    flat_t = jnp.arange(n_assign, dtype=jnp.int32) // TOP_K
    flat_g = gates.reshape(-1)
    order = jnp.argsort(flat_e)
    e_sorted = flat_e[order]
    counts = jnp.bincount(flat_e, length=N_EXPERTS)
    padded = (counts + MOE_BLOCK - 1) // MOE_BLOCK * MOE_BLOCK
    pad_end = jnp.cumsum(padded)
    pad_start = pad_end - padded
    start = jnp.cumsum(counts) - counts
    dest = pad_start[e_sorted] + jnp.arange(n_assign, dtype=jnp.int32) - start[e_sorted]
    n_blocks = -(-n_assign // MOE_BLOCK) + N_EXPERTS
    n_rows = n_blocks * MOE_BLOCK
    row_tok = jnp.zeros((n_rows,), jnp.int32).at[dest].set(flat_t[order])
    row_gate = jnp.zeros((n_rows,), gates.dtype).at[dest].set(flat_g[order])
    block_e = jnp.minimum(jnp.searchsorted(pad_end, jnp.arange(n_blocks) * MOE_BLOCK, side='right'), N_EXPERTS - 1)

    def expert_block(args):
        e, tok, g = args
        hb = xf[tok] @ w_gu[e] + b_gu[e]
        h_glu = jnp.minimum(hb[:, :D_FF], SWIGLU_LIMIT)
        h_lin = jnp.clip(hb[:, D_FF:], -SWIGLU_LIMIT, SWIGLU_LIMIT)
        act = h_glu * jax.nn.sigmoid(SWIGLU_ALPHA * h_glu) * (h_lin + 1.0)
        return ((act @ w_down[e] + b_down[e]) * g[:, None]).astype(xf.dtype)

    y = lax.map(expert_block, (block_e, row_tok.reshape(n_blocks, MOE_BLOCK), row_gate.reshape(n_blocks, MOE_BLOCK)))
    out = jnp.zeros_like(xf).at[row_tok].add(y.reshape(n_rows, dm))
    return out.reshape(bsz, seq, dm)


def setup_inputs(seed: int = 0) -> dict:
    key = jax.random.key(seed)
    ks = iter(jax.random.split(key, 64))

    def nrm(shape, s):
        return jax.random.normal(next(ks), shape, jnp.float32) * s

    def gain(shape):
        return 1.0 + nrm(shape, 0.02)

    D = D_MODEL
    NE = N_EVEN
    NO = N_ODD
    x = nrm((BATCH, SEQ, D), 1.0)
    c = nrm((BATCH, D), 1.0)
    mod_w = nrm((DEPTH, D, 6 * D), D ** -0.5)
    mod_b = nrm((DEPTH, 6 * D), 0.01)
    norm_mix = gain((DEPTH, D))
    norm_ffn = gain((DEPTH, D))
    ev_w_in = nrm((NE, D, EVEN_IN), D ** -0.5)
    ev_lru_conv_w = nrm((NE, CONV_WIDTH, LRU_WIDTH), CONV_WIDTH ** -0.5)
    ev_lru_conv_b = nrm((NE, LRU_WIDTH), 0.01)
    ev_lru_w_r = nrm((NE, LRU_HEADS, LRU_HEAD_DIM, LRU_HEAD_DIM), LRU_HEAD_DIM ** -0.5)
    ev_lru_b_r = nrm((NE, LRU_HEADS, LRU_HEAD_DIM), 0.1)
    ev_lru_w_i = nrm((NE, LRU_HEADS, LRU_HEAD_DIM, LRU_HEAD_DIM), LRU_HEAD_DIM ** -0.5)
    ev_lru_b_i = nrm((NE, LRU_HEADS, LRU_HEAD_DIM), 0.1)
    a0 = jax.random.uniform(next(ks), (NE, LRU_WIDTH), jnp.float32, 0.9, 0.999) ** (1.0 / LRU_C)
    ev_lru_lambda = jnp.log(a0) - jnp.log1p(-a0)
    ev_ml_conv_w = nrm((NE, CONV_WIDTH, MLSTM_WIDTH), CONV_WIDTH ** -0.5)
    ev_ml_conv_b = nrm((NE, MLSTM_WIDTH), 0.01)
    nb = MLSTM_WIDTH // MLSTM_QKV_BLOCK
    ev_ml_w_q = nrm((NE, nb, MLSTM_QKV_BLOCK, MLSTM_QKV_BLOCK), MLSTM_QKV_BLOCK ** -0.5)
    ev_ml_w_k = nrm((NE, nb, MLSTM_QKV_BLOCK, MLSTM_QKV_BLOCK), MLSTM_QKV_BLOCK ** -0.5)
    ev_ml_w_v = nrm((NE, nb, MLSTM_QKV_BLOCK, MLSTM_QKV_BLOCK), MLSTM_QKV_BLOCK ** -0.5)
    ev_ml_w_ig = nrm((NE, 3 * MLSTM_WIDTH, MLSTM_HEADS), (3 * MLSTM_WIDTH) ** -0.5)
    ev_ml_b_ig = nrm((NE, MLSTM_HEADS), 0.1)
    ev_ml_w_fg = nrm((NE, 3 * MLSTM_WIDTH, MLSTM_HEADS), (3 * MLSTM_WIDTH) ** -0.5)
    ev_ml_b_fg = jnp.linspace(3.0, 6.0, MLSTM_HEADS, dtype=jnp.float32)[None, :] + nrm((NE, MLSTM_HEADS), 0.01)
    ev_ml_norm = gain((NE, MLSTM_WIDTH))
    ev_ml_skip = gain((NE, MLSTM_WIDTH))
    ev_w_out = nrm((NE, EVEN_MIX, D), EVEN_MIX ** -0.5)
    od_w_in = nrm((NO, D, SSD_IN), D ** -0.5)
    od_conv_w = nrm((NO, CONV_WIDTH, SSD_CONV_CH), CONV_WIDTH ** -0.5)
    od_conv_b = nrm((NO, SSD_CONV_CH), 0.01)
    dt0 = jnp.exp(jax.random.uniform(next(ks), (NO, SSD_HEADS), jnp.float32, math.log(1e-3), math.log(1e-1)))
    od_dt_bias = dt0 + jnp.log(-jnp.expm1(-dt0))
    od_a_log = jnp.log(jax.random.uniform(next(ks), (NO, SSD_HEADS), jnp.float32, 1.0, 16.0))
    od_d = 1.0 + nrm((NO, SSD_HEADS), 0.1)
    od_norm = gain((NO, SSD_INNER))
    od_w_out = nrm((NO, SSD_INNER, D), SSD_INNER ** -0.5)
    moe_router_w = nrm((DEPTH, D, N_EXPERTS), D ** -0.5)
    moe_router_b = nrm((DEPTH, N_EXPERTS), 0.01)
    moe_w_gu = nrm((DEPTH, N_EXPERTS, D, 2 * D_FF), D ** -0.5)
    moe_b_gu = nrm((DEPTH, N_EXPERTS, 2 * D_FF), 0.01)
    moe_w_down = nrm((DEPTH, N_EXPERTS, D_FF, D), D_FF ** -0.5)
    moe_b_down = nrm((DEPTH, N_EXPERTS, D), 0.01)
    final_norm = gain((D,))
    return {'x': x, 'c': c, 'mod_w': mod_w, 'mod_b': mod_b, 'norm_mix': norm_mix, 'norm_ffn': norm_ffn,
            'ev_w_in': ev_w_in, 'ev_lru_conv_w': ev_lru_conv_w, 'ev_lru_conv_b': ev_lru_conv_b,
            'ev_lru_w_r': ev_lru_w_r, 'ev_lru_b_r': ev_lru_b_r, 'ev_lru_w_i': ev_lru_w_i, 'ev_lru_b_i': ev_lru_b_i,
            'ev_lru_lambda': ev_lru_lambda, 'ev_ml_conv_w': ev_ml_conv_w, 'ev_ml_conv_b': ev_ml_conv_b,
            'ev_ml_w_q': ev_ml_w_q, 'ev_ml_w_k': ev_ml_w_k, 'ev_ml_w_v': ev_ml_w_v,
            'ev_ml_w_ig': ev_ml_w_ig, 'ev_ml_b_ig': ev_ml_b_ig, 'ev_ml_w_fg': ev_ml_w_fg, 'ev_ml_b_fg': ev_ml_b_fg,
            'ev_ml_norm': ev_ml_norm, 'ev_ml_skip': ev_ml_skip, 'ev_w_out': ev_w_out,
            'od_w_in': od_w_in, 'od_conv_w': od_conv_w, 'od_conv_b': od_conv_b, 'od_dt_bias': od_dt_bias,
            'od_a_log': od_a_log, 'od_d': od_d, 'od_norm': od_norm, 'od_w_out': od_w_out,
            'moe_router_w': moe_router_w, 'moe_router_b': moe_router_b, 'moe_w_gu': moe_w_gu,
            'moe_b_gu': moe_b_gu, 'moe_w_down': moe_w_down, 'moe_b_down': moe_b_down,
            'final_norm': final_norm}


def reference(x, c, mod_w, mod_b, norm_mix, norm_ffn,
              ev_w_in, ev_lru_conv_w, ev_lru_conv_b, ev_lru_w_r, ev_lru_b_r, ev_lru_w_i, ev_lru_b_i,
              ev_lru_lambda, ev_ml_conv_w, ev_ml_conv_b, ev_ml_w_q, ev_ml_w_k, ev_ml_w_v,
              ev_ml_w_ig, ev_ml_b_ig, ev_ml_w_fg, ev_ml_b_fg, ev_ml_norm, ev_ml_skip, ev_w_out,
              od_w_in, od_conv_w, od_conv_b, od_dt_bias, od_a_log, od_d, od_norm, od_w_out,
              moe_router_w, moe_router_b, moe_w_gu, moe_b_gu, moe_w_down, moe_b_down,
              final_norm):
    cond = jax.nn.silu(c.astype(jnp.float32))
    h = x
    for layer in range(DEPTH):
        mod = cond @ mod_w[layer] + mod_b[layer]
        sh_m, sc_m, g_m, sh_f, sc_f, g_f = jnp.split(mod, 6, axis=-1)
        u = modulate(rmsnorm(h, norm_mix[layer]), sh_m, sc_m)
        j = layer // 2
        if layer % 2 == 0:
            y = even_mixer(u, ev_w_in[j], ev_lru_conv_w[j], ev_lru_conv_b[j], ev_lru_w_r[j], ev_lru_b_r[j],
                           ev_lru_w_i[j], ev_lru_b_i[j], ev_lru_lambda[j], ev_ml_conv_w[j], ev_ml_conv_b[j],
                           ev_ml_w_q[j], ev_ml_w_k[j], ev_ml_w_v[j], ev_ml_w_ig[j], ev_ml_b_ig[j],
                           ev_ml_w_fg[j], ev_ml_b_fg[j], ev_ml_norm[j], ev_ml_skip[j], ev_w_out[j])
        else:
            y = ssd_mixer(u, od_w_in[j], od_conv_w[j], od_conv_b[j], od_dt_bias[j], od_a_log[j],
                          od_d[j], od_norm[j], od_w_out[j])
        h = h + g_m[:, None, :] * y
        u = modulate(rmsnorm(h, norm_ffn[layer]), sh_f, sc_f)
        h = h + g_f[:, None, :] * moe_ffn(u, moe_router_w[layer], moe_router_b[layer], moe_w_gu[layer],
                                          moe_b_gu[layer], moe_w_down[layer], moe_b_down[layer])
    return rmsnorm(h, final_norm)
```

```cpp
#include <hip/hip_runtime.h>
#include <cstdio>
#include <cstdint>

#ifndef MK_ONE_LAUNCH
#define MK_ONE_LAUNCH 1
#endif

#define GAS __attribute__((address_space(1)))
#define LAS __attribute__((address_space(3)))
typedef unsigned short bf16;
typedef short bf16x8 __attribute__((ext_vector_type(8)));
typedef float f32x4 __attribute__((ext_vector_type(4)));
typedef unsigned u32x4 __attribute__((ext_vector_type(4)));
typedef unsigned u32x2 __attribute__((ext_vector_type(2)));
typedef int i32x8 __attribute__((ext_vector_type(8)));
typedef int i32x4 __attribute__((ext_vector_type(4)));

constexpr int NB = 8, SEQ = 4096, D = 1024, MTOK = NB * SEQ, CH = 128, NCHUNK = SEQ / CH;
constexpr int EVEN_IN = 4096, OD_IN = 6176, OD_INP = 6400, MIXW = 2048;
constexpr int NE = 32, TOPK = 4, DFF = 1024, ECAP = MTOK;
constexpr float EPS = 1e-6f;
constexpr int NWAVES = 8, NTHR = 512;
constexpr int NPH = 20;

constexpr size_t MiB = 1u << 20;
constexpr size_t WS_CTL = 0, CTL_ZERO_BYTES = 128 * 1024;
constexpr size_t WS_MODP = 1 * MiB;
constexpr size_t WS_MODF = 7 * MiB;
constexpr size_t WS_LRUW = 8 * MiB;
constexpr size_t WS_GATEW = 8 * MiB + 512 * 1024;
constexpr size_t WS_ROUTW = 8 * MiB + 768 * 1024;
constexpr size_t WS_ROWTOK = 9 * MiB;
constexpr size_t WS_ROWGATE = 13 * MiB;
constexpr size_t WS_TOKSLOT = 17 * MiB;
constexpr size_t WS_LRU_AT = 18 * MiB, WS_LRU_HT = 19 * MiB, WS_LRU_CARRY = 20 * MiB;
constexpr size_t WS_ML_G = 21 * MiB, WS_ML_B = 22 * MiB;
constexpr size_t WS_ML_NLOC = 23 * MiB, WS_ML_NST = 24 * MiB;
constexpr size_t WS_ML_GT = 25 * MiB, WS_ML_ML = 25 * MiB + 65536, WS_ML_MS = 25 * MiB + 131072;
constexpr size_t WS_SSD_ALAST = 26 * MiB;
constexpr size_t WS_ARGTAB = 27 * MiB;
constexpr size_t WS_DUMMY = 27 * MiB + 65536;
constexpr size_t WS_WEVIN = 28 * MiB, WS_WEVOUT = 36 * MiB, WS_WODIN = 40 * MiB, WS_WODOUT = 53 * MiB;
constexpr size_t WS_WGU = 64 * MiB, WS_WDN = 320 * MiB;
constexpr size_t WS_U = 448 * MiB, WS_H1 = 512 * MiB, WS_H2 = 640 * MiB, WS_MIX = 768 * MiB;
constexpr size_t WS_PROJ = 896 * MiB, WS_ACT = WS_PROJ;
constexpr size_t WS_LRU_HL = 1152 * MiB, WS_LRU_PC = 1216 * MiB;
constexpr size_t WS_ST = 1296 * MiB;
constexpr size_t WS_CLOC = WS_ST, WS_CST = WS_ST + 128 * MiB;
constexpr size_t WS_SLOC = WS_ST, WS_SST = WS_ST + 256 * MiB;
constexpr size_t WS_YBUF = WS_ST;
constexpr size_t WS_XC = 1680 * MiB, WS_QG = 1744 * MiB, WS_KG = 1808 * MiB, WS_VG = 1872 * MiB;
constexpr size_t WS_XBC = 1680 * MiB;
constexpr size_t WS_DTG = 1936 * MiB, WS_ACG = 1940 * MiB;
constexpr size_t WS_END = 1944 * MiB;
constexpr int CW_BAR = 4096;
constexpr int CW_CNT = 16384;

constexpr int LDS_BYTES = 163840;
constexpr int L_MISC = LDS_BYTES - 256;
constexpr int L_SCHED = 135168;
constexpr int RLD = 272;
constexpr int L_RAW = 0, L_T0 = 35840, L_T1 = 70656, L_T2 = 105472, L_SM = 140288;
constexpr int L_DT = L_T2 + 17408, L_AC = L_DT + 16384;

typedef __bf16 bf16v2_t __attribute__((ext_vector_type(2)));
typedef float f32x2_t __attribute__((ext_vector_type(2)));
__device__ __forceinline__ unsigned pk2(float lo, float hi) { const f32x2_t f = {lo, hi}; return __builtin_bit_cast(unsigned, __builtin_convertvector(f, bf16v2_t)); }
__device__ __forceinline__ unsigned f2bf(float f) { return (unsigned)__builtin_bit_cast(unsigned short, (__bf16)f); }
__device__ __forceinline__ float bf2f(unsigned h) { return __builtin_bit_cast(float, h << 16); }
__device__ __forceinline__ float frcp(float x) { return __builtin_amdgcn_rcpf(x); }
__device__ __forceinline__ float sigmoidf_(float x) { return frcp(1.0f + __expf(-x)); }
__device__ __forceinline__ float siluf_(float x) { return x * frcp(1.0f + __expf(-x)); }
__device__ __forceinline__ float softplusf_(float x) { return x > 20.0f ? x : log1pf(__expf(x)); }
__device__ __forceinline__ float logsigmoidf_(float x) { return fminf(x, 0.0f) - log1pf(__expf(-fabsf(x))); }
__device__ __forceinline__ float gelu_tanh(float x) { const float y = 0.7978845608028654f * (x + 0.044715f * x * x * x); const float t = 1.0f - 2.0f * frcp(__expf(2.0f * y) + 1.0f); return 0.5f * x * (1.0f + t); }
__device__ __forceinline__ unsigned pk4_fp8(float a, float b, float c, float d) { int p = __builtin_amdgcn_cvt_pk_fp8_f32(a, b, 0, false); p = __builtin_amdgcn_cvt_pk_fp8_f32(c, d, p, true); return (unsigned)p; }
#define MFMA16(a, b, c) __builtin_amdgcn_mfma_f32_16x16x32_bf16((a), (b), (c), 0, 0, 0)
#define LFRAG(base, row, kel) (*(const LAS bf16x8*)((base) + (row) * RLD + (kel) * 2))
__device__ __forceinline__ float wave_sum(float v) {
#pragma unroll
    for (int o = 1; o < 64; o <<= 1) v += __shfl_xor(v, o);
    return v;
}
__device__ __forceinline__ float red16(float v) { v += __shfl_xor(v, 1); v += __shfl_xor(v, 2); v += __shfl_xor(v, 4); v += __shfl_xor(v, 8); return v; }

#define XB_TMO      128
#define XB_XCNT(j)  (256  + 64 * (j))
#define XB_XSUB(j)  (1280 + 64 * (j))
#define XB_XGEN(j)  (2304 + 64 * (j))
#define XB_TOP      3328
#define XB_TOPGEN   3392
#define XCD_BAR_WORDS 3456
#define XB_SPIN_CAP (1u << 18)
__device__ __forceinline__ unsigned xb_ld(unsigned* p)              { return __hip_atomic_load(p, __ATOMIC_RELAXED, __HIP_MEMORY_SCOPE_AGENT); }
__device__ __forceinline__ unsigned xb_add(unsigned* p, unsigned v) { return __hip_atomic_fetch_add(p, v, __ATOMIC_RELAXED, __HIP_MEMORY_SCOPE_AGENT); }
__device__ __forceinline__ unsigned xb_xcc_id() { return (unsigned)__builtin_amdgcn_s_getreg((3 << 11) | 20) & 0xFu; }
#define XB_SPIN(cond, bar) do { unsigned _sp = 0; while (cond) { __builtin_amdgcn_s_sleep(1); \
    if ((++_sp & 255u) == 0u) { if (xb_ld(&(bar)[XB_TMO])) break; if (_sp > XB_SPIN_CAP) { atomicAdd(&(bar)[XB_TMO], 1u); break; } } } } while (0)
struct XcdBarrier { unsigned* bar; unsigned x; volatile LAS unsigned* st; };
__device__ __forceinline__ XcdBarrier xcd_barrier_post(unsigned* bar, volatile LAS unsigned* st) {
    XcdBarrier b; b.bar = bar; b.x = xb_xcc_id(); b.st = st;
    if (threadIdx.x == 0) (void)xb_add(&bar[XB_XCNT(b.x)], 1u);
    return b;
}
__device__ __forceinline__ void xcd_barrier_complete(unsigned* bar, unsigned x, unsigned& nloc, unsigned& nx) {
    const unsigned G = gridDim.x * gridDim.y * gridDim.z;
    unsigned sum, cnt, mine, sp = 0u;
    for (;;) {
        sum = 0u; cnt = 0u; mine = 0u;
#pragma unroll
        for (unsigned j = 0; j < 16; ++j) { const unsigned c = xb_ld(&bar[XB_XCNT(j)]); sum += c; cnt += (c > 0u) ? 1u : 0u; mine = (j == x) ? c : mine; }
        if (sum == G) break;
        __builtin_amdgcn_s_sleep(1);
        if ((++sp & 255u) == 0u) { if (xb_ld(&bar[XB_TMO])) break; if (sp > XB_SPIN_CAP) { atomicAdd(&bar[XB_TMO], 1u); break; } }
    }
    nloc = mine > 0u ? mine : 1u; nx = cnt > 0u ? cnt : 1u;
}
__device__ __forceinline__ void xcd_barrier(const XcdBarrier& b) {
    asm volatile("s_waitcnt vmcnt(0)" ::: "memory");
    __syncthreads();
    if (threadIdx.x == 0) {
        unsigned* bar = b.bar;
        __builtin_amdgcn_s_waitcnt(0);
        unsigned nloc = b.st[0], nx = b.st[1];
        if (nloc == 0u) { xcd_barrier_complete(bar, b.x, nloc, nx); b.st[0] = nloc; b.st[1] = nx; }
        const unsigned old = xb_add(&bar[XB_XSUB(b.x)], 1u);
        const unsigned gen = old / nloc;
        if (old + 1u == (gen + 1u) * nloc) {
            __builtin_amdgcn_fence(__ATOMIC_RELEASE, "agent");
            asm volatile("s_waitcnt vmcnt(0)" ::: "memory");
            const unsigned og = xb_add(&bar[XB_TOP], 1u);
            const unsigned tg = og / nx;
            if (og + 1u == (tg + 1u) * nx) xb_add(&bar[XB_TOPGEN], 1u);
            else XB_SPIN(xb_ld(&bar[XB_TOPGEN]) == tg, bar);
            __builtin_amdgcn_fence(__ATOMIC_ACQUIRE, "agent");
            xb_add(&bar[XB_XGEN(b.x)], 1u);
            asm volatile("s_waitcnt vmcnt(0)" ::: "memory");
        } else {
            XB_SPIN(xb_ld(&bar[XB_XGEN(b.x)]) == gen, bar);
            __builtin_amdgcn_fence(__ATOMIC_ACQUIRE, "agent");
            asm volatile("s_waitcnt vmcnt(0)" ::: "memory");
        }
    }
    __syncthreads();
}

struct Args { const float* in[41]; float* out; unsigned char* ws; int ph_lo, ph_hi; };
struct InTab { const float* const* p; __device__ __forceinline__ const GAS float* operator[](int k) const { return (const GAS float*)p[k]; } };
struct PArgs { InTab in; };
struct Frame { LAS unsigned char* lds; int tid, lane, wave, G, bid; unsigned char* ws; unsigned* ctl; };
extern __shared__ __attribute__((aligned(16))) unsigned char lds_nl[];
__device__ __forceinline__ Frame make_frame(unsigned char* ws) { Frame F; F.lds = (LAS unsigned char*)lds_nl; F.tid = threadIdx.x; F.lane = F.tid & 63; F.wave = __builtin_amdgcn_readfirstlane(F.tid >> 6); F.G = gridDim.x; F.bid = blockIdx.x; F.ws = ws; F.ctl = (unsigned*)(ws + WS_CTL); return F; }

namespace pg8 {
constexpr int BM = 256, BK = 64, HALF = 128, HTB = HALF * BK * 2, STAGE_BYTES = 8 * HTB, NXCD = 8, WGM = 8;
__host__ __device__ __forceinline__ int lds_byte(int r, int c) { const int ch = c >> 3; return (r >> 3) * 1024 + (r & 7) * 128 + ((ch ^ (r & 7)) << 4) + (c & 7) * 2; }
__host__ __device__ __forceinline__ void stage_rc(int b, int& R, int& C) { const int piece = b >> 10, rip = (b >> 7) & 7, slot = (b >> 4) & 7; R = piece * 8 + rip; C = ((slot ^ rip) << 3); }
__host__ __device__ __forceinline__ int perm32(int rho) { const int n = rho >> 4, i = rho & 15; return 8 * (i >> 2) + 4 * n + (i & 3); }
__device__ __forceinline__ unsigned cvt_pk_bf16(float lo, float hi) { return pk2(lo, hi); }

struct Unit { int pm, pn, e, valid, rowbase; };

struct PlainSched {
    static constexpr bool GATHER = false;
    const bf16* A; const bf16* Bt; int PB, nM, nN, nwg, G, c;
    __device__ void init(const void* A_, const void* Bt_, int M, int N, int K_, int G_, int c_, int elem_bytes = 2) { A = (const bf16*)A_; Bt = (const bf16*)Bt_; PB = elem_bytes * K_; nM = M / BM; nN = N / BM; nwg = nM * nN; G = G_; c = c_; }
    __device__ __forceinline__ bool next(int i, Unit& u) const {
        const long L = (long)i * G + c; if (L >= nwg) return false;
        int wgid = (int)L; { const int q = nwg / NXCD, r = nwg % NXCD, xcd = wgid % NXCD, off = wgid / NXCD; wgid = (xcd < r ? xcd * (q + 1) : r * (q + 1) + (xcd - r) * q) + off; }
        const int nig = WGM * nN, gid = wgid / nig, fm = gid * WGM, gsz = (nM - fm) < WGM ? (nM - fm) : WGM;
        u.pm = fm + ((wgid % nig) % gsz); u.pn = (wgid % nig) / gsz; u.e = 0; u.valid = 256; u.rowbase = u.pm * 256; return true;
    }
    __device__ __forceinline__ const char* abase(const Unit& u) const { return (const char*)A + (size_t)u.pm * 256 * PB; }
    __device__ __forceinline__ const char* bbase(const Unit& u) const { return (const char*)Bt + (size_t)u.pn * 256 * PB; }
};
template <bool GATHER_, int NT_  , int MB_  >
struct MoeSched {
    static constexpr bool GATHER = GATHER_;
    const void* A; const void* Bt; const int* rowtok; int PB, G, c, ntiles; const LAS int* tab; size_t bstride;
    __device__ __forceinline__ bool next(int i, Unit& u) const {
        int blk, j;
        if (G == 256) { blk = i * 8 + (c & 7); j = c >> 3; } else { const long U = (long)i * G + c; blk = (int)(U >> 5); j = (int)(U & 31); }
        const int nblk = (ntiles + MB_ - 1) / MB_;
        if (blk >= nblk) return false;
        const int mtg = blk * MB_ + (j % MB_); u.pn = j / MB_;
        if (mtg >= ntiles) { u.e = -1; u.pm = 0; u.valid = 0; u.rowbase = 0; return true; }
        int e = 0;
#pragma unroll 1
        for (int q = 1; q < 32; ++q) if (tab[65 + q] <= mtg) e = q;
        u.e = e; u.pm = mtg - tab[65 + e];
        const int cnt = tab[e]; const int v = cnt - u.pm * 256; u.valid = v < 256 ? v : 256; u.rowbase = tab[32 + e] + u.pm * 256; return true;
    }
    __device__ __forceinline__ const char* abase(const Unit& u) const { return GATHER_ ? (const char*)A : (const char*)A + (size_t)u.rowbase * PB; }
    __device__ __forceinline__ const char* bbase(const Unit& u) const { return (const char*)Bt + ((size_t)u.e * bstride + (size_t)u.pn * 256) * PB; }
};

struct EpiBf16 {
    static constexpr bool PERM = true;
    bf16* O; int ldc; float scale;
    __device__ __forceinline__ void operator()(const f32x4 (&acc)[2][2][4][2], const Unit& u, int wr, int wc, int fr, int fq) const {
        const int row0 = u.pm * BM + wr * 64 + fr, col0 = u.pn * BM + wc * 32 + 8 * fq;
#pragma unroll
        for (int ai = 0; ai < 2; ++ai)
#pragma unroll
            for (int m = 0; m < 4; ++m) { bf16* rowp = O + (size_t)(row0 + ai * HALF + m * 16) * ldc + col0;
#pragma unroll
                for (int bj = 0; bj < 2; ++bj) { const f32x4 v0 = acc[ai][bj][m][0] * scale, v1 = acc[ai][bj][m][1] * scale;
                    u32x4 w; w.x = cvt_pk_bf16(v0[0], v0[1]); w.y = cvt_pk_bf16(v0[2], v0[3]); w.z = cvt_pk_bf16(v1[0], v1[1]); w.w = cvt_pk_bf16(v1[2], v1[3]);
                    *(u32x4*)(rowp + bj * HALF) = w; } }
    }
};
template <bool HIN_F32>
struct EpiResid {
    static constexpr bool PERM = true;
    const GAS void* hin; bf16* out; const float* gvec;
    __device__ __forceinline__ void operator()(const f32x4 (&acc)[2][2][4][2], const Unit& u, int wr, int wc, int fr, int fq) const {
        const int row0 = u.pm * BM + wr * 64 + fr, col0 = u.pn * BM + wc * 32 + 8 * fq;
        const float* gb = gvec + (size_t)((u.pm * BM) / SEQ) * 6144 + col0;
        f32x4 gv[2][2];
#pragma unroll
        for (int bj = 0; bj < 2; ++bj)
#pragma unroll
            for (int n = 0; n < 2; ++n) gv[bj][n] = *(const f32x4*)(gb + bj * HALF + 4 * n);
#pragma unroll
        for (int ai = 0; ai < 2; ++ai)
#pragma unroll
            for (int m = 0; m < 4; ++m) { const size_t off = (size_t)(row0 + ai * HALF + m * 16) * D + col0;
#pragma unroll
                for (int bj = 0; bj < 2; ++bj) { f32x4 h0, h1;
                    if (HIN_F32) { h0 = *(const GAS f32x4*)((const GAS float*)hin + off + bj * HALF); h1 = *(const GAS f32x4*)((const GAS float*)hin + off + bj * HALF + 4); }
                    else { const u32x4 hw = *(const GAS u32x4*)((const GAS bf16*)hin + off + bj * HALF); h0 = (f32x4){bf2f(hw.x & 0xffffu), bf2f(hw.x >> 16), bf2f(hw.y & 0xffffu), bf2f(hw.y >> 16)}; h1 = (f32x4){bf2f(hw.z & 0xffffu), bf2f(hw.z >> 16), bf2f(hw.w & 0xffffu), bf2f(hw.w >> 16)}; }
                    const f32x4 v0 = h0 + gv[bj][0] * acc[ai][bj][m][0], v1 = h1 + gv[bj][1] * acc[ai][bj][m][1];
                    u32x4 w; w.x = cvt_pk_bf16(v0[0], v0[1]); w.y = cvt_pk_bf16(v0[2], v0[3]); w.z = cvt_pk_bf16(v1[0], v1[1]); w.w = cvt_pk_bf16(v1[2], v1[3]);
                    *(u32x4*)(out + off + bj * HALF) = w; } }
    }
};
constexpr float WSCALE8 = 32.0f, WINV8 = 1.0f / 32.0f;
struct EpiSwiglu {
    static constexpr bool PERM = true;
    unsigned char* act; const GAS float* bgu; unsigned char* sink;
    __device__ __forceinline__ void operator()(const f32x4 (&acc)[2][2][4][2], const Unit& u, int wr, int wc, int fr, int fq) const {
        const int cc = u.pn * 128 + wc * 32 + 8 * fq;
        const GAS float* bb = bgu + (size_t)u.e * 2048 + cc;
        const f32x4 bg0 = *(const f32x4*)(bb), bg1 = *(const f32x4*)(bb + 4), bl0 = *(const f32x4*)(bb + 1024), bl1 = *(const f32x4*)(bb + 1028);
#pragma unroll
        for (int ai = 0; ai < 2; ++ai)
#pragma unroll
            for (int m = 0; m < 4; ++m) { const int r = ai * HALF + wr * 64 + m * 16 + fr;
                float o[8];
#pragma unroll
                for (int n = 0; n < 2; ++n)
#pragma unroll
                    for (int j = 0; j < 4; ++j) { float g = acc[ai][0][m][n][j] * WINV8 + (n ? bg1[j] : bg0[j]); float li = acc[ai][1][m][n][j] * WINV8 + (n ? bl1[j] : bl0[j]);
                        g = fminf(g, 7.0f); li = fminf(fmaxf(li, -7.0f), 7.0f);
                        o[n * 4 + j] = g * __builtin_amdgcn_rcpf(1.0f + __expf(-1.702f * g)) * (li + 1.0f); }
                u32x2 w; w.x = pk4_fp8(o[0], o[1], o[2], o[3]); w.y = pk4_fp8(o[4], o[5], o[6], o[7]);
                unsigned char* dst = (r < u.valid) ? act + (size_t)(u.rowbase + r) * DFF + cc : sink;
                *(u32x2*)dst = w; }
    }
};
constexpr float YSCALE8 = 16.0f, YINV8 = 1.0f / 16.0f;
struct EpiDown {
    static constexpr bool PERM = true;
    unsigned char* y; const GAS float* bdn; const float* rowgate; unsigned char* sink;
    __device__ __forceinline__ void operator()(const f32x4 (&acc)[2][2][4][2], const Unit& u, int wr, int wc, int fr, int fq) const {
        const int col0 = u.pn * BM + wc * 32 + 8 * fq;
        const GAS float* bb = bdn + (size_t)u.e * D + col0;
        f32x4 bv[2][2];
#pragma unroll
        for (int bj = 0; bj < 2; ++bj)
#pragma unroll
            for (int n = 0; n < 2; ++n) bv[bj][n] = *(const f32x4*)(bb + bj * HALF + 4 * n);
        const float* gp = rowgate + (size_t)u.e * ECAP + u.pm * 256 + wr * 64 + fr;
        float gts[2][4];
#pragma unroll
        for (int ai = 0; ai < 2; ++ai)
#pragma unroll
            for (int m = 0; m < 4; ++m) gts[ai][m] = gp[ai * HALF + m * 16];
#pragma unroll
        for (int ai = 0; ai < 2; ++ai)
#pragma unroll
            for (int m = 0; m < 4; ++m) { const int r = ai * HALF + wr * 64 + m * 16 + fr; const float gt = gts[ai][m] * YSCALE8; unsigned char* rowp = y + (size_t)(u.rowbase + r) * D + col0;
#pragma unroll
                for (int bj = 0; bj < 2; ++bj) { const f32x4 v0 = (acc[ai][bj][m][0] * WINV8 + bv[bj][0]) * gt, v1 = (acc[ai][bj][m][1] * WINV8 + bv[bj][1]) * gt;
                    u32x2 w; w.x = pk4_fp8(v0[0], v0[1], v0[2], v0[3]); w.y = pk4_fp8(v1[0], v1[1], v1[2], v1[3]);
                    *(u32x2*)((r < u.valid) ? rowp + bj * HALF : sink + 8 * bj) = w; } }
    }
};

template <class Epi, class Sched, bool FP8 = false>
__device__ __forceinline__ void gemm_phase(LAS unsigned char* lds, const Sched& S, const Epi& E) {
    const int tid = threadIdx.x, wid = __builtin_amdgcn_readfirstlane(tid >> 6), lane = tid & 63, wr = wid >> 2, wc = wid & 3, fr = lane & 15, fq = lane >> 4;
    const int PB = S.PB, nt = PB / 128;
    unsigned voffB[2], voffA0[2];
#pragma unroll
    for (int i = 0; i < 2; ++i) { int R, C; stage_rc(tid * 16 + i * 8192, R, C); const int Rb = Epi::PERM ? ((R & ~31) + perm32(R & 31)) : R;
        voffA0[i] = (unsigned)(R * PB + 2 * C); voffB[i] = (unsigned)(Rb * PB + 2 * C); }
    const size_t kstep = (size_t)(BK * 2);
    const size_t hstep = (size_t)HALF * PB;
    const unsigned ldsw = (unsigned)wid * 1024u;
    const int aoff0 = FP8 ? lds_byte(wr * 64 + fr, 16 * fq) : lds_byte(wr * 64 + fr, fq * 8), boff0 = FP8 ? lds_byte(wc * 32 + fr, 16 * fq) : lds_byte(wc * 32 + fr, fq * 8);
    const int aoff1 = FP8 ? lds_byte(wr * 64 + fr, 16 * fq + 8) : lds_byte(wr * 64 + fr, fq * 8 + 32), boff1 = FP8 ? lds_byte(wc * 32 + fr, 16 * fq + 8) : lds_byte(wc * 32 + fr, fq * 8 + 32);
#define PG8_SA(b, h) (((b) * 2 + (h)) * HTB)
#define PG8_SB(b, h) ((4 + (b) * 2 + (h)) * HTB)
#define PG8_STAGE(bufoff, gbase, voff) do { _Pragma("unroll") for (int _i = 0; _i < 2; ++_i) \
        __builtin_amdgcn_global_load_lds((const unsigned*)((const char*)(gbase) + (voff)[_i]), (LAS unsigned*)(lds + (bufoff) + ldsw + _i * 8192), 16, 0, 0); } while (0)
#define PG8_LDA(dst, b, h) do { _Pragma("unroll") for (int m = 0; m < 4; ++m) { const i32x4 _l0 = *(const LAS i32x4*)(lds + PG8_SA(b, h) + aoff0 + m * 2048), _l1 = *(const LAS i32x4*)(lds + PG8_SA(b, h) + aoff1 + m * 2048); \
        dst[m] = __builtin_shufflevector(_l0, _l1, 0, 1, 2, 3, 4, 5, 6, 7); } } while (0)
#define PG8_LDB(dst, b, h) do { _Pragma("unroll") for (int n = 0; n < 2; ++n) { const i32x4 _l0 = *(const LAS i32x4*)(lds + PG8_SB(b, h) + boff0 + n * 2048), _l1 = *(const LAS i32x4*)(lds + PG8_SB(b, h) + boff1 + n * 2048); \
        dst[n] = __builtin_shufflevector(_l0, _l1, 0, 1, 2, 3, 4, 5, 6, 7); } } while (0)
#define PG8_MMA(ai, bj, At, Bt) do { __builtin_amdgcn_s_setprio(1); _Pragma("unroll") for (int m = 0; m < 4; ++m) _Pragma("unroll") for (int n = 0; n < 2; ++n) { \
        if constexpr (FP8) { asm volatile("v_mfma_scale_f32_16x16x128_f8f6f4 %0, %1, %2, %0, %3, %3 op_sel_hi:[0,0,0]" : "+v"(acc[ai][bj][m][n]) : "v"(Bt[n]), "v"(At[m]), "v"(scl8)); } \
        else { acc[ai][bj][m][n] = __builtin_amdgcn_mfma_f32_16x16x32_bf16(__builtin_bit_cast(bf16x8, __builtin_shufflevector(Bt[n], Bt[n], 0, 1, 2, 3)), __builtin_bit_cast(bf16x8, __builtin_shufflevector(At[m], At[m], 0, 1, 2, 3)), acc[ai][bj][m][n], 0, 0, 0); \
               acc[ai][bj][m][n] = __builtin_amdgcn_mfma_f32_16x16x32_bf16(__builtin_bit_cast(bf16x8, __builtin_shufflevector(Bt[n], Bt[n], 4, 5, 6, 7)), __builtin_bit_cast(bf16x8, __builtin_shufflevector(At[m], At[m], 4, 5, 6, 7)), acc[ai][bj][m][n], 0, 0, 0); } } \
        __builtin_amdgcn_s_setprio(0); } while (0)
#define PG8_WAIT_V(n) asm volatile("s_waitcnt vmcnt(" #n ")" ::: "memory")
#define PG8_WAIT_L(n) asm volatile("s_waitcnt lgkmcnt(" #n ")" ::: "memory")
#define PG8_BAR __builtin_amdgcn_s_barrier()
#define PG8_SCHED __builtin_amdgcn_sched_barrier(0)
#define PG8_AOFFS(u, dst) do { if constexpr (Sched::GATHER) { int _tz = threadIdx.x; asm volatile("" : "+v"(_tz)); _Pragma("unroll") for (int _h = 0; _h < 2; ++_h) _Pragma("unroll") for (int _i = 0; _i < 2; ++_i) { \
            int _R, _C; stage_rc(_tz * 16 + _i * 8192, _R, _C); const int _r = _h * HALF + _R; const int _tk = S.rowtok[(size_t)(u).e * ECAP + (u).pm * 256 + (_r < (u).valid ? _r : (u).valid - 1)]; dst[_h][_i] = (unsigned)(_tk * PB + 2 * _C); } } \
        else { _Pragma("unroll") for (int _i = 0; _i < 2; ++_i) { dst[0][_i] = voffA0[_i]; dst[1][_i] = voffA0[_i] + (unsigned)hstep; } } } while (0)
    Unit cur, nxt; int ui = 0;
    for (;;) { if (!S.next(ui, cur)) return; if (cur.e >= 0) break; ++ui; }
    f32x4 acc[2][2][4][2];
#pragma unroll
    for (int a = 0; a < 2; ++a)
#pragma unroll
        for (int b = 0; b < 2; ++b)
#pragma unroll
            for (int m = 0; m < 4; ++m)
#pragma unroll
                for (int n = 0; n < 2; ++n) { acc[a][b][m][n] = (f32x4){0.f, 0.f, 0.f, 0.f}; asm volatile("" : "+v"(acc[a][b][m][n])); }
    unsigned scl8 = 0x7f7f7f7fu; asm volatile("" : "+v"(scl8));
    i32x8 At[4], B0[2], B1[2];
    const char* cA = S.abase(cur); const char* cB = S.bbase(cur);
    unsigned cO[2][2];
    PG8_AOFFS(cur, cO);
    PG8_STAGE(PG8_SB(0, 0), cB, voffB); PG8_STAGE(PG8_SB(0, 1), cB + hstep, voffB); PG8_STAGE(PG8_SA(0, 0), cA, cO[0]); PG8_STAGE(PG8_SA(0, 1), cA, cO[1]);
    if (wr == 1) PG8_BAR;
    PG8_WAIT_V(2); PG8_BAR;
    PG8_STAGE(PG8_SB(1, 0), cB + kstep, voffB); PG8_STAGE(PG8_SA(1, 0), cA + kstep, cO[0]); PG8_STAGE(PG8_SB(1, 1), cB + hstep + kstep, voffB);
    PG8_WAIT_V(6); PG8_BAR;
    for (;;) {
        int uj = ui + 1; bool has_next;
        for (;;) { has_next = S.next(uj, nxt); if (!has_next || nxt.e >= 0) break; ++uj; }
        const char* nA = has_next ? S.abase(nxt) : cA; const char* nB = has_next ? S.bbase(nxt) : cB;
        unsigned nO[2][2];
#pragma unroll
        for (int h = 0; h < 2; ++h)
#pragma unroll
            for (int i = 0; i < 2; ++i) nO[h][i] = cO[h][i];
        if (has_next) { PG8_AOFFS(nxt, nO); }
#pragma unroll 1
        for (int t = 0; t < nt; t += 2) {
            const bool last = (t == nt - 2);
            const char* a1 = cA + (size_t)(t + 1) * kstep;
            const char* a2 = last ? nA : cA + (size_t)(t + 2) * kstep; const char* b2 = last ? nB : cB + (size_t)(t + 2) * kstep;
            const char* a3 = a2 + kstep; const char* b3 = b2 + kstep;
            PG8_LDB(B0, 0, 0); PG8_LDB(B1, 0, 1); PG8_SCHED; PG8_LDA(At, 0, 0); PG8_STAGE(PG8_SA(1, 1), a1, cO[1]);
            if (last) {
#pragma unroll
                for (int h = 0; h < 2; ++h)
#pragma unroll
                    for (int i = 0; i < 2; ++i) cO[h][i] = nO[h][i]; }
            PG8_WAIT_V(8); PG8_WAIT_L(0); PG8_BAR; PG8_MMA(0, 0, At, B0); PG8_MMA(0, 1, At, B1); PG8_BAR; PG8_SCHED;
            PG8_LDA(At, 0, 1); PG8_STAGE(PG8_SB(0, 0), b2, voffB); PG8_STAGE(PG8_SB(0, 1), b2 + hstep, voffB); PG8_STAGE(PG8_SA(0, 0), a2, cO[0]);
            PG8_WAIT_V(8); PG8_WAIT_L(0); PG8_BAR; PG8_MMA(1, 0, At, B0); PG8_MMA(1, 1, At, B1); PG8_BAR; PG8_SCHED;
            PG8_LDB(B0, 1, 0); PG8_LDB(B1, 1, 1); PG8_SCHED; PG8_LDA(At, 1, 0); PG8_STAGE(PG8_SA(0, 1), a2, cO[1]);
            PG8_WAIT_V(8); PG8_WAIT_L(0); PG8_BAR; PG8_MMA(0, 0, At, B0); PG8_MMA(0, 1, At, B1); PG8_BAR; PG8_SCHED;
            PG8_LDA(At, 1, 1); PG8_STAGE(PG8_SB(1, 0), b3, voffB); PG8_STAGE(PG8_SB(1, 1), b3 + hstep, voffB); PG8_STAGE(PG8_SA(1, 0), a3, cO[0]);
            PG8_WAIT_V(8); PG8_WAIT_L(0); PG8_BAR; PG8_MMA(1, 0, At, B0); PG8_MMA(1, 1, At, B1); PG8_BAR; PG8_SCHED;
        }
        if (wr == 0) PG8_BAR;
        if constexpr (FP8) asm volatile("s_nop 15\n\ts_nop 15" ::: "memory");
        { int tz = threadIdx.x; asm volatile("" : "+v"(tz));
          const int wid2 = tz >> 6, lane2 = tz & 63; E(acc, cur, wid2 >> 2, wid2 & 3, lane2 & 15, lane2 >> 4); }
        if (!has_next) break;
#pragma unroll
        for (int a = 0; a < 2; ++a)
#pragma unroll
            for (int b = 0; b < 2; ++b)
#pragma unroll
                for (int m = 0; m < 4; ++m)
#pragma unroll
                    for (int n = 0; n < 2; ++n) { acc[a][b][m][n] = (f32x4){0.f, 0.f, 0.f, 0.f}; asm volatile("" : "+v"(acc[a][b][m][n])); }
        cur = nxt; cA = nA; cB = nB; ui = uj;
        if (wr == 1) PG8_BAR;
    }
    PG8_WAIT_V(0);
    PG8_BAR;
#undef PG8_SA
#undef PG8_SB
#undef PG8_STAGE
#undef PG8_LDA
#undef PG8_LDB
#undef PG8_MMA
#undef PG8_WAIT_V
#undef PG8_WAIT_L
#undef PG8_BAR
#undef PG8_SCHED
#undef PG8_AOFFS
}
}

__device__ __forceinline__ void transpose_item(const float* W, int K, int N, bf16* WT, int dst_row0, LAS float* scr, int k0, int n0, int lane) {
#pragma unroll 8
    for (int i = 0; i < 32; ++i) { const int kk = 2 * i + (lane >> 5); scr[kk * 33 + (lane & 31)] = W[(size_t)(k0 + kk) * N + n0 + (lane & 31)]; }
    asm volatile("s_waitcnt lgkmcnt(0)" ::: "memory");
    const int c = lane & 7;
#pragma unroll
    for (int j = 0; j < 4; ++j) { const int n = (lane >> 3) + 8 * j; const LAS float* s = scr + (8 * c) * 33 + n;
        u32x4 o; o.x = pk2(s[0 * 33], s[1 * 33]); o.y = pk2(s[2 * 33], s[3 * 33]); o.z = pk2(s[4 * 33], s[5 * 33]); o.w = pk2(s[6 * 33], s[7 * 33]);
        *(u32x4*)(WT + (size_t)(dst_row0 + n) * K + k0 + 8 * c) = o; }
    asm volatile("s_waitcnt lgkmcnt(0)" ::: "memory");
}
__device__ __forceinline__ void transpose_item_fp8(const float* W, int K, int N, unsigned char* WT, int dst_row0, LAS float* scr, int k0, int n0, int lane) {
#pragma unroll 8
    for (int i = 0; i < 32; ++i) { const int kk = 2 * i + (lane >> 5); scr[kk * 33 + (lane & 31)] = W[(size_t)(k0 + kk) * N + n0 + (lane & 31)] * pg8::WSCALE8; }
    asm volatile("s_waitcnt lgkmcnt(0)" ::: "memory");
    const int c = lane & 7;
#pragma unroll
    for (int j = 0; j < 4; ++j) { const int n = (lane >> 3) + 8 * j; const LAS float* s = scr + (8 * c) * 33 + n;
        u32x2 o; o.x = pk4_fp8(s[0 * 33], s[1 * 33], s[2 * 33], s[3 * 33]); o.y = pk4_fp8(s[4 * 33], s[5 * 33], s[6 * 33], s[7 * 33]);
        *(u32x2*)(WT + (size_t)(dst_row0 + n) * K + k0 + 8 * c) = o; }
    asm volatile("s_waitcnt lgkmcnt(0)" ::: "memory");
}
__device__ __forceinline__ void ph_prep(const Args& a, Frame& F) {
    if (F.bid == 0 && F.tid == 0) { const float** tab = (const float**)(F.ws + WS_ARGTAB);
#pragma unroll
        for (int i = 0; i < 41; ++i) tab[i] = a.in[i];
        tab[41] = a.out; }
    LAS float* scr = (LAS float*)(F.lds + F.wave * 16384);
    const int gw = F.bid * NWAVES + F.wave, NGW = F.G * NWAVES, lane = F.lane;
    unsigned char* ws = F.ws;
    {
        const float* cin = a.in[1]; const float* mw = a.in[2]; float* modp = (float*)(ws + WS_MODP);
        for (int it = gw; it < 2 * 96 * 16; it += NGW) {
            const int l = it / 1536, rem = it % 1536, cb = rem / 16, ks = rem % 16, col = cb * 64 + lane;
#pragma unroll
            for (int b = 0; b < 8; ++b) { const float cv = cin[b * D + ks * 64 + lane]; scr[b * 64 + lane] = siluf_(cv); }
            asm volatile("s_waitcnt lgkmcnt(0)" ::: "memory");
            float acc[8];
#pragma unroll
            for (int b = 0; b < 8; ++b) acc[b] = 0.f;
            const float* wp = mw + ((size_t)l * D + ks * 64) * 6144 + col;
#pragma unroll 8
            for (int k = 0; k < 64; ++k) { const float w = wp[(size_t)k * 6144];
#pragma unroll
                for (int b = 0; b < 8; ++b) acc[b] += scr[b * 64 + k] * w; }
#pragma unroll
            for (int b = 0; b < 8; ++b) modp[(size_t)((ks * 2 + l) * 8 + b) * 6144 + col] = acc[b];
            asm volatile("s_waitcnt lgkmcnt(0)" ::: "memory");
        }
    }
    {
        constexpr int I_EVIN = 16 * 128, I_EVOUT = 32 * 32, I_ODIN = 16 * 193, I_ODOUT = 32 * 32, I_GU = 64 * 1024, I_DN = 64 * 512, I_LRU = 16 * 8;
        constexpr int NIT = I_EVIN + I_EVOUT + I_ODIN + I_ODOUT + I_GU + I_DN + I_LRU;
        for (int it = gw; it < NIT; it += NGW) {
            int r = it;
            if (r < I_EVIN) { const int kb = r / 128, nb = r % 128; transpose_item(a.in[6], D, EVEN_IN, (bf16*)(ws + WS_WEVIN), 32 * nb, scr, 64 * kb, 32 * nb, lane); continue; } r -= I_EVIN;
            if (r < I_EVOUT) { const int kb = r / 32, nb = r % 32; transpose_item(a.in[25], MIXW, D, (bf16*)(ws + WS_WEVOUT), 32 * nb, scr, 64 * kb, 32 * nb, lane); continue; } r -= I_EVOUT;
            if (r < I_ODIN) { const int kb = r / 193, nb = r % 193; transpose_item_fp8(a.in[26], D, OD_IN, (unsigned char*)(ws + WS_WODIN), 32 * nb, scr, 64 * kb, 32 * nb, lane); continue; } r -= I_ODIN;
            if (r < I_ODOUT) { const int kb = r / 32, nb = r % 32; transpose_item(a.in[33], MIXW, D, (bf16*)(ws + WS_WODOUT), 32 * nb, scr, 64 * kb, 32 * nb, lane); continue; } r -= I_ODOUT;
            if (r < I_GU) { const int mat = r / 1024, rr = r % 1024, kb = rr / 64, nb = rr % 64, n0 = 32 * nb;
                const int drow = n0 < 1024 ? (n0 / 128) * 256 + (n0 % 128) : ((n0 - 1024) / 128) * 256 + 128 + ((n0 - 1024) % 128);
                transpose_item_fp8(a.in[36] + (size_t)mat * D * 2048, D, 2048, (unsigned char*)(ws + WS_WGU) + (size_t)mat * 2048 * D, drow, scr, 64 * kb, n0, lane); continue; } r -= I_GU;
            if (r < I_DN) { const int mat = r / 512, rr = r % 512, kb = rr / 32, nb = rr % 32;
                transpose_item_fp8(a.in[38] + (size_t)mat * DFF * D, DFF, D, (unsigned char*)(ws + WS_WDN) + (size_t)mat * D * DFF, 32 * nb, scr, 64 * kb, 32 * nb, lane); continue; } r -= I_DN;
            { const int mat = r / 8, rr = r % 8, kb = rr / 4, nb = rr % 4, which = mat / 8, h = mat % 8;
                transpose_item((which ? a.in[11] : a.in[9]) + (size_t)h * 128 * 128, 128, 128, (bf16*)(ws + WS_LRUW) + (size_t)(which * 8 + h) * 128 * 128, 32 * nb, scr, 64 * kb, 32 * nb, lane); }
        }
    }
    {
        const size_t gt = (size_t)F.bid * NTHR + F.tid, NT = (size_t)F.G * NTHR;
        u32x4* z = (u32x4*)((unsigned char*)(ws + WS_WODIN) + (size_t)OD_IN * D);
        for (size_t i = gt; i < (size_t)(OD_INP - OD_IN) * D / 16; i += NT) z[i] = (u32x4){0u, 0u, 0u, 0u};
        bf16* gwt = (bf16*)(ws + WS_GATEW);
        for (size_t i = gt; i < 16 * 1024; i += NT) { const int j = (int)(i / 1024), cch = (int)(i % 1024), n = cch >> 2, d = cch & 3, jj = j & 7; const float* Wg = (j < 8 ? a.in[19] : a.in[21]);
            float sc = 0.f, sb = 0.f;
#pragma unroll
            for (int e = 0; e < 4; ++e) { sc += a.in[16][(n * 4 + d) * 4 + e] * Wg[(size_t)(4 * n + e) * 8 + jj] + a.in[17][(n * 4 + d) * 4 + e] * Wg[(size_t)(1024 + 4 * n + e) * 8 + jj];
                sb += a.in[18][(n * 4 + d) * 4 + e] * Wg[(size_t)(2048 + 4 * n + e) * 8 + jj]; }
            gwt[i] = (bf16)f2bf(sc); gwt[16 * 1024 + i] = (bf16)f2bf(sb); }
        bf16* rw = (bf16*)(ws + WS_ROUTW);
        for (size_t i = gt; i < 2 * 32 * 1024; i += NT) { const int l = (int)(i / 32768), e = (int)((i / 1024) % 32), k = (int)(i % 1024);
            const float v = a.in[34][((size_t)l * D + k) * 32 + e]; const unsigned hi = f2bf(v); const unsigned lo = f2bf(v - bf2f(hi));
            rw[((size_t)(l * 2 + 0) * 32 + e) * 1024 + k] = (bf16)hi; rw[((size_t)(l * 2 + 1) * 32 + e) * 1024 + k] = (bf16)lo; }
    }
}

template <int MODE>
__device__ __forceinline__ void ph_rows(const PArgs& a, Frame& F, int l  ) {
    unsigned char* ws = F.ws;
    LAS float* gm = (LAS float*)(F.lds); LAS float* ga = (LAS float*)(F.lds + 4096); LAS float* gf = (LAS float*)(F.lds + 8192); LAS int* offs = (LAS int*)(F.lds + 12288);
    const float* modp = (const float*)(ws + WS_MODP); float* modf = (float*)(ws + WS_MODF);
    if (MODE == 0) {
        for (size_t i = (size_t)F.bid * NTHR + F.tid; i < 2 * 8 * 6144; i += (size_t)F.G * NTHR) { const int l2 = (int)(i / 49152), b = (int)((i / 6144) % 8), n = (int)(i % 6144);
            float s = a.in[3][l2 * 6144 + n];
#pragma unroll
            for (int ks = 0; ks < 16; ++ks) s += modp[(size_t)((ks * 2 + l2) * 8 + b) * 6144 + n];
            modf[i] = s; }
    }
    if (MODE != 0) { if (F.tid == 0) { int o = 0; for (int e = 0; e < NE; ++e) { offs[e] = o; o += (int)F.ctl[CW_CNT + l * 2048 + e * 64]; } } }
    for (int tile = F.bid; tile < MTOK / 128; tile += F.G) {
        const int b = (tile * 128) / SEQ;
        __syncthreads();
        for (int k = F.tid; k < D; k += NTHR) {
            if (MODE == 0) { float sh = a.in[3][k], sc = a.in[3][1024 + k];
#pragma unroll
                for (int ks = 0; ks < 16; ++ks) { const float* p = modp + (size_t)((ks * 2 + 0) * 8 + b) * 6144; sh += p[k]; sc += p[1024 + k]; }
                gm[k] = a.in[4][k] * (1.0f + sc); ga[k] = sh; }
            else if (MODE == 1) { const float* mf = modf + (size_t)((l + 1) * 8 + b) * 6144; gm[k] = a.in[4][(l + 1) * D + k] * (1.0f + mf[1024 + k]); ga[k] = mf[k]; gf[k] = modf[(size_t)(l * 8 + b) * 6144 + 5120 + k]; }
            else { gm[k] = a.in[40][k]; ga[k] = 0.f; gf[k] = modf[(size_t)(l * 8 + b) * 6144 + 5120 + k]; }
        }
        __syncthreads();
        int slotv = 0;
        if (MODE != 0) slotv = ((const int*)(ws + WS_TOKSLOT))[(size_t)(tile * 128 + F.wave * 16) * 4 + F.lane];
#pragma unroll 1
        for (int i = 0; i < 16; i += 2) {
            f32x4 v[2][4]; unsigned yw[2][4][4];
#pragma unroll
            for (int rr = 0; rr < 2; ++rr) { const int row = tile * 128 + F.wave * 16 + i + rr;
#pragma unroll
                for (int j = 0; j < 4; ++j) { if (MODE == 0) v[rr][j] = *(const f32x4*)(a.in[0] + (size_t)row * D + 4 * F.lane + 256 * j);
                    else { const u32x2 hw = *(const u32x2*)((const bf16*)(ws + WS_H1) + (size_t)row * D + 4 * F.lane + 256 * j); v[rr][j] = (f32x4){bf2f(hw.x & 0xffffu), bf2f(hw.x >> 16), bf2f(hw.y & 0xffffu), bf2f(hw.y >> 16)}; } }
                if (MODE != 0) {
#pragma unroll
                    for (int kk = 0; kk < 4; ++kk) { const int sl = __shfl(slotv, 4 * (i + rr) + kk); const int e = sl >> 15, pos = sl & 32767; const size_t yr = (size_t)(offs[e] + pos);
                        const unsigned char* yp = (const unsigned char*)(ws + WS_YBUF) + yr * D + 4 * F.lane;
#pragma unroll
                        for (int j = 0; j < 4; ++j) yw[rr][kk][j] = *(const unsigned*)(yp + 256 * j); } } }
#pragma unroll
            for (int rr = 0; rr < 2; ++rr) { const int row = tile * 128 + F.wave * 16 + i + rr;
                if (MODE != 0) {
#pragma unroll
                    for (int j = 0; j < 4; ++j) { f32x4 sm = (f32x4){0.f, 0.f, 0.f, 0.f};
#pragma unroll
                        for (int kk = 0; kk < 4; ++kk) { const int w = (int)yw[rr][kk][j]; sm[0] += __builtin_amdgcn_cvt_f32_fp8(w, 0); sm[1] += __builtin_amdgcn_cvt_f32_fp8(w, 1); sm[2] += __builtin_amdgcn_cvt_f32_fp8(w, 2); sm[3] += __builtin_amdgcn_cvt_f32_fp8(w, 3); }
                        const f32x4 g = *(const LAS f32x4*)(gf + 4 * F.lane + 256 * j); v[rr][j] = v[rr][j] + g * (sm * pg8::YINV8); }
                    if (MODE == 1) {
#pragma unroll
                        for (int j = 0; j < 4; ++j) { u32x2 hw; hw.x = pk2(v[rr][j][0], v[rr][j][1]); hw.y = pk2(v[rr][j][2], v[rr][j][3]); *(u32x2*)((bf16*)(ws + WS_H2) + (size_t)row * D + 4 * F.lane + 256 * j) = hw; } }
                }
                float ss = 0.f;
#pragma unroll
                for (int j = 0; j < 4; ++j) ss += (v[rr][j][0] * v[rr][j][0] + v[rr][j][1] * v[rr][j][1]) + (v[rr][j][2] * v[rr][j][2] + v[rr][j][3] * v[rr][j][3]);
                const float rstd = __builtin_amdgcn_rsqf(wave_sum(ss) * (1.0f / D) + EPS);
#pragma unroll
                for (int j = 0; j < 4; ++j) { const f32x4 m = *(const LAS f32x4*)(gm + 4 * F.lane + 256 * j); const f32x4 ad = *(const LAS f32x4*)(ga + 4 * F.lane + 256 * j);
                    const f32x4 o = v[rr][j] * rstd * m + ad;
                    if (MODE == 2) *(f32x4*)((float*)a.in[41] + (size_t)row * D + 4 * F.lane + 256 * j) = o;
                    else if (MODE == 1) *(unsigned*)((unsigned char*)(ws + WS_U) + (size_t)row * D + 4 * F.lane + 256 * j) = pk4_fp8(o[0], o[1], o[2], o[3]);
                    else { u32x2 w; w.x = pk2(o[0], o[1]); w.y = pk2(o[2], o[3]); *(u32x2*)((bf16*)(ws + WS_U) + (size_t)row * D + 4 * F.lane + 256 * j) = w; } } }
        }
    }
}

__device__ __forceinline__ void ph_route(const PArgs& a, Frame& F, int l) {
    unsigned char* ws = F.ws;
    LAS float* gm = (LAS float*)(F.lds); LAS float* ga = (LAS float*)(F.lds + 4096); LAS float* LG = (LAS float*)(F.lds + 8192);
    LAS int* lcnt = (LAS int*)(F.lds + 25600); LAS int* lbase = (LAS int*)(F.lds + 25728);
    const float* modf = (const float*)(ws + WS_MODF); const bf16* h1 = (const bf16*)(ws + WS_H1);
    const bf16* rw = (const bf16*)(ws + WS_ROUTW) + (size_t)l * 2 * 32 * 1024;
    const int r = F.lane & 15, kg = F.lane >> 4;
    for (int tile = F.bid; tile < MTOK / 128; tile += F.G) {
        const int b = (tile * 128) / SEQ;
        __syncthreads();
        for (int k = F.tid; k < D; k += NTHR) { const float* mf = modf + (size_t)(l * 8 + b) * 6144; gm[k] = a.in[5][l * D + k] * (1.0f + mf[4096 + k]); ga[k] = mf[3072 + k]; }
        if (F.tid < 32) lcnt[F.tid] = 0;
        __syncthreads();
        const int row = tile * 128 + F.wave * 16 + r;
        const bf16* hp = h1 + (size_t)row * D + 8 * kg;
        float ss = 0.f;
#pragma unroll 4
        for (int s = 0; s < 32; ++s) { const u32x4 hw = *(const u32x4*)(hp + 32 * s);
            const f32x4 x0 = (f32x4){bf2f(hw.x & 0xffffu), bf2f(hw.x >> 16), bf2f(hw.y & 0xffffu), bf2f(hw.y >> 16)}, x1 = (f32x4){bf2f(hw.z & 0xffffu), bf2f(hw.z >> 16), bf2f(hw.w & 0xffffu), bf2f(hw.w >> 16)};
            ss += (x0[0] * x0[0] + x0[1] * x0[1]) + (x0[2] * x0[2] + x0[3] * x0[3]) + (x1[0] * x1[0] + x1[1] * x1[1]) + (x1[2] * x1[2] + x1[3] * x1[3]); }
        ss += __shfl_xor(ss, 16); ss += __shfl_xor(ss, 32);
        const float rstd = __builtin_amdgcn_rsqf(ss * (1.0f / D) + EPS);
        f32x4 acc[2]; acc[0] = (f32x4){0.f, 0.f, 0.f, 0.f}; acc[1] = acc[0];
        unsigned char* up = (unsigned char*)(ws + WS_U) + (size_t)row * D + 8 * kg;
#pragma unroll 2
        for (int s = 0; s < 32; ++s) {
            const u32x4 hw = *(const u32x4*)(hp + 32 * s);
            const f32x4 x0 = (f32x4){bf2f(hw.x & 0xffffu), bf2f(hw.x >> 16), bf2f(hw.y & 0xffffu), bf2f(hw.y >> 16)}, x1 = (f32x4){bf2f(hw.z & 0xffffu), bf2f(hw.z >> 16), bf2f(hw.w & 0xffffu), bf2f(hw.w >> 16)};
            const f32x4 m0 = *(const LAS f32x4*)(gm + 32 * s + 8 * kg), m1 = *(const LAS f32x4*)(gm + 32 * s + 8 * kg + 4);
            const f32x4 a0 = *(const LAS f32x4*)(ga + 32 * s + 8 * kg), a1 = *(const LAS f32x4*)(ga + 32 * s + 8 * kg + 4);
            const f32x4 u0 = x0 * rstd * m0 + a0, u1 = x1 * rstd * m1 + a1;
            bf16x8 ahi, alo;
#pragma unroll
            for (int j = 0; j < 4; ++j) { const unsigned h0 = f2bf(u0[j]), h1b = f2bf(u1[j]); ahi[j] = (short)h0; ahi[4 + j] = (short)h1b; alo[j] = (short)f2bf(u0[j] - bf2f(h0)); alo[4 + j] = (short)f2bf(u1[j] - bf2f(h1b)); }
            { u32x2 w8; w8.x = pk4_fp8(u0[0], u0[1], u0[2], u0[3]); w8.y = pk4_fp8(u1[0], u1[1], u1[2], u1[3]); *(u32x2*)(up + 32 * s) = w8; }
#pragma unroll
            for (int nt = 0; nt < 2; ++nt) { const bf16x8 bhi = *(const bf16x8*)(rw + (size_t)(16 * nt + r) * 1024 + 32 * s + 8 * kg); const bf16x8 blo = *(const bf16x8*)(rw + (size_t)(32 + 16 * nt + r) * 1024 + 32 * s + 8 * kg);
                acc[nt] = MFMA16(ahi, bhi, acc[nt]); acc[nt] = MFMA16(ahi, blo, acc[nt]); acc[nt] = MFMA16(alo, bhi, acc[nt]); }
        }
#pragma unroll
        for (int nt = 0; nt < 2; ++nt)
#pragma unroll
            for (int j = 0; j < 4; ++j) LG[(F.wave * 16 + 4 * kg + j) * 33 + 16 * nt + r] = acc[nt][j] + a.in[35][l * 32 + 16 * nt + r];
        __syncthreads();
        int pe[4]; float pg[4]; int prank[4];
        if (F.tid < 128) {
            float lv[32];
#pragma unroll
            for (int e = 0; e < 32; ++e) lv[e] = LG[F.tid * 33 + e];
#pragma unroll
            for (int k = 0; k < 4; ++k) { float best = -3.0e38f; int bi = 0;
#pragma unroll
                for (int e = 0; e < 32; ++e) { const bool tk = lv[e] > best; best = tk ? lv[e] : best; bi = tk ? e : bi; }
                pe[k] = bi; pg[k] = best;
#pragma unroll
                for (int e = 0; e < 32; ++e) lv[e] = (e == bi) ? -3.0e38f : lv[e]; }
            const float mx = pg[0]; float sm = 0.f;
#pragma unroll
            for (int k = 0; k < 4; ++k) { pg[k] = __expf(pg[k] - mx); sm += pg[k]; }
            const float inv = 1.0f / sm;
#pragma unroll
            for (int k = 0; k < 4; ++k) { pg[k] *= inv; prank[k] = __hip_atomic_fetch_add(&lcnt[pe[k]], 1, __ATOMIC_RELAXED, __HIP_MEMORY_SCOPE_WORKGROUP); }
        }
        __syncthreads();
        if (F.tid < 32) { const int c = lcnt[F.tid]; lbase[F.tid] = c ? (int)atomicAdd(&F.ctl[CW_CNT + l * 2048 + F.tid * 64], (unsigned)c) : 0; }
        __syncthreads();
        if (F.tid < 128) {
            const int trow = tile * 128 + F.tid;
#pragma unroll
            for (int k = 0; k < 4; ++k) { const int pos = lbase[pe[k]] + prank[k]; const size_t li = (size_t)pe[k] * ECAP + pos;
                ((int*)(ws + WS_ROWTOK))[li] = trow; ((float*)(ws + WS_ROWGATE))[li] = pg[k]; ((int*)(ws + WS_TOKSLOT))[(size_t)trow * 4 + k] = pe[k] * 32768 + pos; }
        }
    }
}

#define RAW_PF(pr, src, ld, grow0, tseq0, c0) do { _Pragma("unroll") for (int i_ = 0; i_ < 5; ++i_) { const int q0_ = F.tid + i_ * NTHR, q_ = q0_ < 131 * 16 ? q0_ : 131 * 16 - 1, r_ = q_ >> 4, cc_ = q_ & 15; \
        const int back_ = (tseq0) - 3 + r_ >= 0 ? 3 - r_ : (tseq0);     \
        const u32x4 v_ = *(const u32x4*)((src) + (size_t)((grow0) - back_) * (ld) + (c0) + 8 * cc_); pr[i_] = ((tseq0) - 3 + r_ >= 0) ? v_ : (u32x4){0u, 0u, 0u, 0u}; } } while (0)
#define RAW_PW(pr) do { _Pragma("unroll") for (int i_ = 0; i_ < 5; ++i_) { const int q_ = F.tid + i_ * NTHR, r_ = q_ >> 4, cc_ = q_ & 15; if (q_ < 131 * 16) *(LAS u32x4*)(F.lds + L_RAW + r_ * RLD + cc_ * 16) = pr[i_]; } } while (0)
template <int RLDB>
__device__ __forceinline__ void tr_frag4(unsigned a, bf16x8 (&out)[4]) {
    u32x2 r0, r1, r2, r3, r4, r5, r6, r7;
    asm volatile(
        "ds_read_b64_tr_b16 %0, %8 offset:%9\n\t"
        "ds_read_b64_tr_b16 %1, %8 offset:%10\n\t"
        "ds_read_b64_tr_b16 %2, %8 offset:%11\n\t"
        "ds_read_b64_tr_b16 %3, %8 offset:%12\n\t"
        "ds_read_b64_tr_b16 %4, %8 offset:%13\n\t"
        "ds_read_b64_tr_b16 %5, %8 offset:%14\n\t"
        "ds_read_b64_tr_b16 %6, %8 offset:%15\n\t"
        "ds_read_b64_tr_b16 %7, %8 offset:%16\n\t"
        "s_waitcnt lgkmcnt(0)"
        : "=&v"(r0), "=&v"(r1), "=&v"(r2), "=&v"(r3), "=&v"(r4), "=&v"(r5), "=&v"(r6), "=&v"(r7)
        : "v"(a), "i"(0), "i"(4 * RLDB), "i"(32 * RLDB), "i"(36 * RLDB), "i"(64 * RLDB), "i"(68 * RLDB), "i"(96 * RLDB), "i"(100 * RLDB)
        : "memory");
    out[0] = __builtin_bit_cast(bf16x8, (u32x4){r0.x, r0.y, r1.x, r1.y});
    out[1] = __builtin_bit_cast(bf16x8, (u32x4){r2.x, r2.y, r3.x, r3.y});
    out[2] = __builtin_bit_cast(bf16x8, (u32x4){r4.x, r4.y, r5.x, r5.y});
    out[3] = __builtin_bit_cast(bf16x8, (u32x4){r6.x, r6.y, r7.x, r7.y});
}
__device__ __forceinline__ unsigned tr_addr(const LAS unsigned char* tile, int n0, int lane) { return (unsigned)(size_t)tile + (unsigned)((8 * (lane >> 4) + ((lane & 15) >> 2)) * RLD + (n0 + 4 * (lane & 3)) * 2); }
__device__ __forceinline__ void copy_tile(Frame& F, const bf16* src, int ld, int dstoff) {
#pragma unroll
    for (int i = 0; i < 4; ++i) { const int q = F.tid + i * NTHR, r = q >> 4, cc = q & 15; *(LAS u32x4*)(F.lds + dstoff + r * RLD + cc * 16) = *(const u32x4*)(src + (size_t)r * ld + 8 * cc); }
}
__device__ __forceinline__ u32x4 scale8(u32x4 v, float s) { u32x4 o; o.x = pk2(bf2f(v.x & 0xffffu) * s, bf2f(v.x >> 16) * s); o.y = pk2(bf2f(v.y & 0xffffu) * s, bf2f(v.y >> 16) * s); o.z = pk2(bf2f(v.z & 0xffffu) * s, bf2f(v.z >> 16) * s); o.w = pk2(bf2f(v.w & 0xffffu) * s, bf2f(v.w >> 16) * s); return o; }
#define WSYNC() do { asm volatile("s_waitcnt vmcnt(0)" ::: "memory"); __syncthreads(); } while (0)

constexpr int L_GT = L_SM, L_GC = L_SM + 8192, L_BC = L_GC + 4096, L_MV = L_BC + 4096, L_BM = L_MV + 4096, L_MP = L_BM + 32;
constexpr int L_WS = L_MP + 32;
__device__ __forceinline__ void ml_pre(const PArgs& a, Frame& F, int b, int c) {
    unsigned char* ws = F.ws; LAS unsigned char* lds = F.lds;
    const bf16* proj = (const bf16*)(ws + WS_PROJ);
    const int wid = F.wave, lane = F.lane, fr = lane & 15, fq = lane >> 4, row0 = b * SEQ + c * CH;
    const int n = F.tid & 31, tg = F.tid >> 5;
    LAS float* GT = (LAS float*)(lds + L_GT); LAS float* Gc = (LAS float*)(lds + L_GC); LAS float* Bc = (LAS float*)(lds + L_BC); LAS float* BM = (LAS float*)(lds + L_BM);
    const float kscale = 0.08838834764831845f;
    f32x4 gacc = (f32x4){0.f, 0.f, 0.f, 0.f};
    const bf16* wc = (const bf16*)(ws + WS_GATEW) + (size_t)fr * 1024 + 8 * fq; const bf16* wb = wc + 16 * 1024;
    u32x4 pr[5];
    RAW_PF(pr, proj, EVEN_IN, row0, c * CH, 2048);
    for (int h = 0; h < 8; ++h) {
        RAW_PW(pr);
        const int gc = 128 * h + 4 * n;
        f32x4 cw[4], wq[4], wk[4], wv[4];
        const f32x4 cb = *(const f32x4*)(a.in[15] + gc);
#pragma unroll
        for (int j = 0; j < 4; ++j) { cw[j] = *(const f32x4*)(a.in[14] + (size_t)j * D + gc); wq[j] = *(const f32x4*)(a.in[16] + (size_t)(32 * h + n) * 16 + 4 * j);
            wk[j] = *(const f32x4*)(a.in[17] + (size_t)(32 * h + n) * 16 + 4 * j) * kscale; wv[j] = *(const f32x4*)(a.in[18] + (size_t)(32 * h + n) * 16 + 4 * j); }
        __syncthreads();
        if (h < 7) RAW_PF(pr, proj, EVEN_IN, row0, c * CH, 2048 + 128 * (h + 1));
        float w0[4], w1[4], w2[4], w3[4];
        { const LAS unsigned char* rp = lds + L_RAW + (8 * tg) * RLD + 8 * n; u32x2 u;
          u = *(const LAS u32x2*)(rp); w0[0] = bf2f(u.x & 0xffffu); w0[1] = bf2f(u.x >> 16); w0[2] = bf2f(u.y & 0xffffu); w0[3] = bf2f(u.y >> 16);
          u = *(const LAS u32x2*)(rp + RLD); w1[0] = bf2f(u.x & 0xffffu); w1[1] = bf2f(u.x >> 16); w1[2] = bf2f(u.y & 0xffffu); w1[3] = bf2f(u.y >> 16);
          u = *(const LAS u32x2*)(rp + 2 * RLD); w2[0] = bf2f(u.x & 0xffffu); w2[1] = bf2f(u.x >> 16); w2[2] = bf2f(u.y & 0xffffu); w2[3] = bf2f(u.y >> 16); }
#pragma unroll
        for (int i = 0; i < 8; ++i) { const int t = 8 * tg + i;
            { const u32x2 u = *(const LAS u32x2*)(lds + L_RAW + (t + 3) * RLD + 8 * n); w3[0] = bf2f(u.x & 0xffffu); w3[1] = bf2f(u.x >> 16); w3[2] = bf2f(u.y & 0xffffu); w3[3] = bf2f(u.y >> 16); }
            float xc[4], q[4], k[4], v[4];
#pragma unroll
            for (int e = 0; e < 4; ++e) xc[e] = siluf_(cb[e] + cw[0][e] * w0[e] + cw[1][e] * w1[e] + cw[2][e] * w2[e] + cw[3][e] * w3[e]);
#pragma unroll
            for (int e = 0; e < 4; ++e) { q[e] = xc[0] * wq[0][e] + xc[1] * wq[1][e] + xc[2] * wq[2][e] + xc[3] * wq[3][e]; k[e] = xc[0] * wk[0][e] + xc[1] * wk[1][e] + xc[2] * wk[2][e] + xc[3] * wk[3][e];
                v[e] = w3[0] * wv[0][e] + w3[1] * wv[1][e] + w3[2] * wv[2][e] + w3[3] * wv[3][e]; }
            u32x2 o; o.x = pk2(xc[0], xc[1]); o.y = pk2(xc[2], xc[3]);
            *(LAS u32x2*)(lds + L_T0 + t * RLD + 8 * n) = o;
            const size_t go = (size_t)(row0 + t) * D + gc;
            *(u32x2*)((bf16*)(ws + WS_XC) + go) = o;
            o.x = pk2(q[0], q[1]); o.y = pk2(q[2], q[3]); *(u32x2*)((bf16*)(ws + WS_QG) + go) = o;
            o.x = pk2(k[0], k[1]); o.y = pk2(k[2], k[3]); *(u32x2*)((bf16*)(ws + WS_KG) + go) = o;
            o.x = pk2(v[0], v[1]); o.y = pk2(v[2], v[3]); *(u32x2*)((bf16*)(ws + WS_VG) + go) = o;
#pragma unroll
            for (int e = 0; e < 4; ++e) { w0[e] = w1[e]; w1[e] = w2[e]; w2[e] = w3[e]; } }
        __syncthreads();
#pragma unroll
        for (int ks = 0; ks < 4; ++ks) { const bf16x8 A1 = LFRAG(lds + L_T0, 16 * wid + fr, 32 * ks + 8 * fq); const bf16x8 B1 = *(const bf16x8*)(wc + 128 * h + 32 * ks); gacc = MFMA16(A1, B1, gacc);
            const bf16x8 A2 = LFRAG(lds + L_RAW, 16 * wid + fr + 3, 32 * ks + 8 * fq); const bf16x8 B2 = *(const bf16x8*)(wb + 128 * h + 32 * ks); gacc = MFMA16(A2, B2, gacc); }
        __syncthreads();
    }
#pragma unroll
    for (int j = 0; j < 4; ++j) { float v = gacc[j] + (fr < 8 ? a.in[20][fr] : a.in[22][fr - 8]); if (fr >= 8) v = logsigmoidf_(v); GT[(16 * wid + 4 * fq + j) * 16 + fr] = v; }
    __syncthreads();
    if (F.tid < 8) { const int h = F.tid; float g = 0.f, bmax = -3.0e38f;
        for (int t = 0; t < CH; ++t) { g += GT[t * 16 + 8 + h]; const float bb = GT[t * 16 + h] - g; Gc[t * 8 + h] = g; Bc[t * 8 + h] = bb; bmax = fmaxf(bmax, bb); }
        BM[h] = bmax; const int u = (b * 8 + h) * NCHUNK + c; ((float*)(ws + WS_ML_GT))[u] = g; ((float*)(ws + WS_ML_ML))[u] = g + bmax; }
    __syncthreads();
    for (int i = F.tid; i < CH * 8; i += NTHR) { ((float*)(ws + WS_ML_G))[(size_t)row0 * 8 + i] = Gc[i]; ((float*)(ws + WS_ML_B))[(size_t)row0 * 8 + i] = Bc[i]; }
}
__device__ __forceinline__ void ml_local2(const PArgs& a, Frame& F, int b, int c) {
    unsigned char* ws = F.ws; LAS unsigned char* lds = F.lds;
    const int wid = F.wave, lane = F.lane, fr = lane & 15, fq = lane >> 4, row0 = b * SEQ + c * CH;
    LAS float* Bc = (LAS float*)(lds + L_BC); LAS float* BM = (LAS float*)(lds + L_BM);
    WSYNC();
    u32x4 pk[4], pv[4];
#define KV_PF(hh) do { _Pragma("unroll") for (int i_ = 0; i_ < 4; ++i_) { const int q_ = F.tid + i_ * NTHR; const size_t o_ = (size_t)(row0 + (q_ >> 4)) * D + 128 * (hh) + 8 * (q_ & 15); pk[i_] = *(const u32x4*)((const bf16*)(ws + WS_KG) + o_); pv[i_] = *(const u32x4*)((const bf16*)(ws + WS_VG) + o_); } } while (0)
    KV_PF(0);
    for (int h = 0; h < 8; ++h) {
        const float bm = BM[h];
#pragma unroll
        for (int i = 0; i < 4; ++i) { const int q = F.tid + i * NTHR, r = q >> 4, cc = q & 15; const float sc = __expf(Bc[r * 8 + h] - bm);
            *(LAS u32x4*)(lds + L_T1 + r * RLD + cc * 16) = scale8(pk[i], sc);
            *(LAS u32x4*)(lds + L_T2 + r * RLD + cc * 16) = pv[i]; }
        __syncthreads();
        if (h < 7) KV_PF(h + 1);
        const int u = (b * 8 + h) * NCHUNK + c;
        bf16x8 Av[4]; tr_frag4<RLD>(tr_addr(lds + L_T2, 16 * wid, lane), Av);
        bf16* cl = (bf16*)(ws + WS_CLOC) + (size_t)u * 16384;
#pragma unroll
        for (int nt = 0; nt < 8; ++nt) { bf16x8 Bk[4]; tr_frag4<RLD>(tr_addr(lds + L_T1, 16 * nt, lane), Bk);
            f32x4 acc = (f32x4){0.f, 0.f, 0.f, 0.f};
#pragma unroll
            for (int ks = 0; ks < 4; ++ks) acc = MFMA16(Av[ks], Bk[ks], acc);
#pragma unroll
            for (int j = 0; j < 4; ++j) cl[(16 * wid + 4 * fq + j) * 128 + 16 * nt + fr] = (bf16)f2bf(acc[j]); }
        if (F.tid < 128) { float s0 = 0.f, s1 = 0.f;
#pragma unroll 8
            for (int t = 0; t < CH; t += 2) { s0 += bf2f(*(const LAS bf16*)(lds + L_T1 + t * RLD + F.tid * 2)); s1 += bf2f(*(const LAS bf16*)(lds + L_T1 + (t + 1) * RLD + F.tid * 2)); }
            ((float*)(ws + WS_ML_NLOC))[(size_t)u * 128 + F.tid] = s0 + s1; }
        __syncthreads();
    }
}

__device__ __forceinline__ void lru_fix(const PArgs& a, Frame& F, int b, int c) {
    unsigned char* ws = F.ws; const bf16* proj = (const bf16*)(ws + WS_PROJ);
    const int row0 = b * SEQ + c * CH, cc = F.tid & 127, tg = F.tid >> 7;
    const float* cp = (const float*)(ws + WS_LRU_CARRY) + (size_t)(b * NCHUNK + c) * D + 8 * cc;
    const f32x4 c0 = *(const f32x4*)cp, c1 = *(const f32x4*)(cp + 4);
#pragma unroll 1
    for (int t0 = 0; t0 < 32; t0 += 4) { u32x4 hw[4], pw[4], gw[4];
#pragma unroll
        for (int i = 0; i < 4; ++i) { const size_t r = (size_t)(row0 + 32 * tg + t0 + i); hw[i] = *(const u32x4*)((const bf16*)(ws + WS_LRU_HL) + r * D + 8 * cc); pw[i] = *(const u32x4*)((const bf16*)(ws + WS_LRU_PC) + r * D + 8 * cc); gw[i] = *(const u32x4*)(proj + r * EVEN_IN + 1024 + 8 * cc); }
#pragma unroll
        for (int i = 0; i < 4; ++i) { const size_t r = (size_t)(row0 + 32 * tg + t0 + i); float o[8];
#pragma unroll
            for (int e = 0; e < 8; ++e) { const unsigned hh = (e < 2) ? hw[i].x : (e < 4) ? hw[i].y : (e < 6) ? hw[i].z : hw[i].w, pq = (e < 2) ? pw[i].x : (e < 4) ? pw[i].y : (e < 6) ? pw[i].z : pw[i].w, gg = (e < 2) ? gw[i].x : (e < 4) ? gw[i].y : (e < 6) ? gw[i].z : gw[i].w;
                const float hl = bf2f((e & 1) ? (hh >> 16) : (hh & 0xffffu)), pc = bf2f((e & 1) ? (pq >> 16) : (pq & 0xffffu)), g = bf2f((e & 1) ? (gg >> 16) : (gg & 0xffffu));
                o[e] = (hl + pc * (e < 4 ? c0[e] : c1[e - 4])) * gelu_tanh(g); }
            u32x4 w; w.x = pk2(o[0], o[1]); w.y = pk2(o[2], o[3]); w.z = pk2(o[4], o[5]); w.w = pk2(o[6], o[7]);
            *(u32x4*)((bf16*)(ws + WS_MIX) + r * MIXW + 8 * cc) = w; } }
}
#undef KV_PF
__device__ __attribute__((noinline)) void ml_local2_nl(const GAS unsigned char* tab, GAS unsigned char* ws, int b, int c) { Frame F = make_frame((unsigned char*)ws); PArgs pa; pa.in.p = (const float* const*)tab; ml_local2(pa, F, b, c); }
__device__ __forceinline__ void ml_out2(const PArgs& a, Frame& F, int b, int c) {
    unsigned char* ws = F.ws; LAS unsigned char* lds = F.lds;
    const bf16* proj = (const bf16*)(ws + WS_PROJ); bf16* mix = (bf16*)(ws + WS_MIX);
    const int wid = F.wave, lane = F.lane, fr = lane & 15, fq = lane >> 4, row0 = b * SEQ + c * CH;
    LAS float* Gc = (LAS float*)(lds + L_GC); LAS float* Bc = (LAS float*)(lds + L_BC); LAS float* Mv = (LAS float*)(lds + L_MV); LAS float* MP = (LAS float*)(lds + L_MP);
    __syncthreads();
    for (int i = F.tid; i < CH * 8; i += NTHR) { Gc[i] = ((const float*)(ws + WS_ML_G))[(size_t)row0 * 8 + i]; Bc[i] = ((const float*)(ws + WS_ML_B))[(size_t)row0 * 8 + i]; }
    if (F.tid < 8) MP[F.tid] = ((const float*)(ws + WS_ML_MS))[(b * 8 + F.tid) * NCHUNK + c];
    LAS float* NWS = (LAS float*)(lds + L_GT);
    for (int i = F.tid; i < 1024; i += NTHR) { NWS[i] = a.in[23][i]; NWS[1024 + i] = a.in[24][i]; }
    __syncthreads();
    if (F.tid < 8) { const int h = F.tid; float pm = -3.0e38f; const float mp = MP[h]; for (int t = 0; t < CH; ++t) { pm = fmaxf(pm, Bc[t * 8 + h]); Mv[t * 8 + h] = fmaxf(mp, pm); } }
    __syncthreads();
    LAS unsigned char* PS = lds + L_RAW + wid * 16 * RLD;
    LAS unsigned char* HS = lds + L_T0 + wid * 8448;
    for (int h = 0; h < 8; ++h) {
        const size_t tb = (size_t)row0 * D + 128 * h;
        copy_tile(F, (const bf16*)(ws + WS_QG) + tb, D, L_T0); copy_tile(F, (const bf16*)(ws + WS_KG) + tb, D, L_T1); copy_tile(F, (const bf16*)(ws + WS_VG) + tb, D, L_T2);
        const int u = (b * 8 + h) * NCHUNK + c;
        u32x4 pc[4];
#pragma unroll
        for (int i = 0; i < 4; ++i) { const int q = F.tid + i * NTHR; pc[i] = *(const u32x4*)((const bf16*)(ws + WS_CST) + (size_t)u * 16384 + (size_t)(q >> 4) * 128 + 8 * (q & 15)); }
        __syncthreads();
        float rs[4] = {0.f, 0.f, 0.f, 0.f};
        float mrow[4];
#pragma unroll
        for (int j = 0; j < 4; ++j) mrow[j] = Mv[(16 * wid + 4 * fq + j) * 8 + h];
        bf16x8 Aq[4];
#pragma unroll
        for (int ks = 0; ks < 4; ++ks) Aq[ks] = LFRAG(lds + L_T0, 16 * wid + fr, 32 * ks + 8 * fq);
#pragma unroll
        for (int nt = 0; nt < 8; ++nt) {
            if (nt <= wid) {
                f32x4 sacc = (f32x4){0.f, 0.f, 0.f, 0.f};
#pragma unroll
                for (int ks = 0; ks < 4; ++ks) { const bf16x8 B = LFRAG(lds + L_T1, 16 * nt + fr, 32 * ks + 8 * fq); sacc = MFMA16(Aq[ks], B, sacc); }
                const int s_ = 16 * nt + fr; const float bs = Bc[s_ * 8 + h];
#pragma unroll
                for (int j = 0; j < 4; ++j) { const int t = 16 * wid + 4 * fq + j; const float p = (s_ <= t) ? sacc[j] * __expf(bs - mrow[j]) : 0.f; rs[j] += p;
                    *(LAS bf16*)(PS + (4 * fq + j) * RLD + s_ * 2) = (bf16)f2bf(p); }
            } else if (nt == wid + 1) {
#pragma unroll
                for (int j = 0; j < 4; ++j) *(LAS bf16*)(PS + (4 * fq + j) * RLD + (16 * nt + fr) * 2) = (bf16)0;
            }
        }
#pragma unroll
        for (int j = 0; j < 4; ++j) rs[j] = red16(rs[j]);
        __syncthreads();
#pragma unroll
        for (int i = 0; i < 4; ++i) { const int q = F.tid + i * NTHR; *(LAS u32x4*)(lds + L_T1 + (q >> 4) * RLD + (q & 15) * 16) = pc[i]; }
        __syncthreads();
        f32x4 oacc[8];
#pragma unroll
        for (int ne = 0; ne < 8; ++ne) oacc[ne] = (f32x4){0.f, 0.f, 0.f, 0.f};
#pragma unroll
        for (int ks = 0; ks < 4; ++ks) {
#pragma unroll
            for (int ne = 0; ne < 8; ++ne) { const bf16x8 B = LFRAG(lds + L_T1, 16 * ne + fr, 32 * ks + 8 * fq); oacc[ne] = MFMA16(Aq[ks], B, oacc[ne]); } }
        const float mp = MP[h];
        float winter[4];
#pragma unroll
        for (int j = 0; j < 4; ++j) winter[j] = __expf(mp - mrow[j]);
#pragma unroll
        for (int ne = 0; ne < 8; ++ne)
#pragma unroll
            for (int j = 0; j < 4; ++j) oacc[ne][j] *= winter[j];
        const int kmax = (wid + 2) >> 1;
        bf16x8 Ap[4];
#pragma unroll
        for (int ks = 0; ks < 4; ++ks) Ap[ks] = LFRAG(PS, fr, 32 * ks + 8 * fq);
#pragma unroll
        for (int ne = 0; ne < 8; ++ne) { bf16x8 Bv[4]; tr_frag4<RLD>(tr_addr(lds + L_T2, 16 * ne, lane), Bv);
#pragma unroll
            for (int ks = 0; ks < 4; ++ks) if (ks < kmax) oacc[ne] = MFMA16(Ap[ks], Bv[ks], oacc[ne]); }
        float qn[4];
        { const float* np = (const float*)(ws + WS_ML_NST) + (size_t)u * 128 + 8 * fr; const f32x4 n0 = *(const f32x4*)np, n1 = *(const f32x4*)(np + 4);
#pragma unroll
            for (int j = 0; j < 4; ++j) { const bf16x8 qq = LFRAG(lds + L_T0, 16 * wid + 4 * fq + j, 8 * fr); float s = 0.f;
#pragma unroll
                for (int d = 0; d < 4; ++d) s += bf2f((unsigned short)qq[d]) * n0[d] + bf2f((unsigned short)qq[4 + d]) * n1[d];
                qn[j] = red16(s); } }
        float inv[4], mean[4], rstd[4];
#pragma unroll
        for (int j = 0; j < 4; ++j) { const int t = 16 * wid + 4 * fq + j; const float den = rs[j] + winter[j] * qn[j]; inv[j] = frcp(fmaxf(fabsf(den), __expf(-(Gc[t * 8 + h] + mrow[j])))); }
#pragma unroll
        for (int ne = 0; ne < 8; ++ne)
#pragma unroll
            for (int j = 0; j < 4; ++j) oacc[ne][j] *= inv[j];
#pragma unroll
        for (int j = 0; j < 4; ++j) { float s = 0.f;
#pragma unroll
            for (int ne = 0; ne < 8; ++ne) s += oacc[ne][j];
            mean[j] = red16(s) * (1.0f / 128.0f); float q2 = 0.f;
#pragma unroll
            for (int ne = 0; ne < 8; ++ne) { const float d = oacc[ne][j] - mean[j]; q2 += d * d; }
            rstd[j] = __builtin_amdgcn_rsqf(red16(q2) * (1.0f / 128.0f) + EPS); }
        const int er = lane >> 2, esg = lane & 3; const size_t egrow = (size_t)(row0 + 16 * wid + er); const int ec0 = 128 * h + 32 * esg;
        u32x4 exw[4], ezw[4];
#pragma unroll
        for (int q = 0; q < 4; ++q) { exw[q] = *(const u32x4*)((const bf16*)(ws + WS_XC) + egrow * D + ec0 + 8 * q); ezw[q] = *(const u32x4*)(proj + egrow * EVEN_IN + 3072 + ec0 + 8 * q); }
        __syncthreads();
#pragma unroll
        for (int ne = 0; ne < 8; ++ne)
#pragma unroll
            for (int j = 0; j < 4; ++j) *(LAS float*)(HS + (4 * fq + j) * 528 + (16 * ne + fr) * 4) = (oacc[ne][j] - mean[j]) * rstd[j];
        asm volatile("s_waitcnt lgkmcnt(0)" ::: "memory");
        { const int r = er, sg = esg; const size_t grow = egrow; const int c0 = ec0;
#pragma unroll
            for (int q = 0; q < 4; ++q) { const int cc = c0 + 8 * q;
                const f32x4 h0 = *(const LAS f32x4*)(HS + r * 528 + (32 * sg + 8 * q) * 4), h1 = *(const LAS f32x4*)(HS + r * 528 + (32 * sg + 8 * q + 4) * 4);
                const u32x4 xw = exw[q]; const u32x4 zw = ezw[q];
                const f32x4 nw0 = *(const LAS f32x4*)(NWS + cc), nw1 = *(const LAS f32x4*)(NWS + cc + 4), sk0 = *(const LAS f32x4*)(NWS + 1024 + cc), sk1 = *(const LAS f32x4*)(NWS + 1024 + cc + 4);
                float o[8];
#pragma unroll
                for (int e = 0; e < 4; ++e) { const unsigned xa = (e < 2) ? xw.x : xw.y, xb_ = (e < 2) ? xw.z : xw.w, za = (e < 2) ? zw.x : zw.y, zb_ = (e < 2) ? zw.z : zw.w;
                    const float x0 = bf2f((e & 1) ? (xa >> 16) : (xa & 0xffffu)), x1 = bf2f((e & 1) ? (xb_ >> 16) : (xb_ & 0xffffu));
                    const float z0 = bf2f((e & 1) ? (za >> 16) : (za & 0xffffu)), z1 = bf2f((e & 1) ? (zb_ >> 16) : (zb_ & 0xffffu));
                    o[e] = (h0[e] * nw0[e] + sk0[e] * x0) * siluf_(z0); o[4 + e] = (h1[e] * nw1[e] + sk1[e] * x1) * siluf_(z1); }
                u32x4 w; w.x = pk2(o[0], o[1]); w.y = pk2(o[2], o[3]); w.z = pk2(o[4], o[5]); w.w = pk2(o[6], o[7]);
                *(u32x4*)(mix + grow * MIXW + 1024 + cc) = w; } }
        __syncthreads();
    }
}


template <bool OUT>
__device__ __forceinline__ void lru_unit2(const PArgs& a, Frame& F, int b, int c) {
    unsigned char* ws = F.ws; LAS unsigned char* lds = F.lds;
    const bf16* proj = (const bf16*)(ws + WS_PROJ);
    const int wid = F.wave, lane = F.lane, fr = lane & 15, fq = lane >> 4;
    const int n = F.tid & 31, tg = F.tid >> 5;
    const int row0 = b * SEQ + c * CH;
    __syncthreads();
    u32x4 pr[5];
    RAW_PF(pr, proj, EVEN_IN, row0, c * CH, 0);
    for (int h = 0; h < 8; ++h) {
        RAW_PW(pr);
        if (OUT) copy_tile(F, proj + (size_t)row0 * EVEN_IN + 1024 + 128 * h, EVEN_IN, L_T1);
        const int gc = 128 * h + 4 * n;
        f32x4 cw[4]; const f32x4 cb = *(const f32x4*)(a.in[8] + gc);
#pragma unroll
        for (int j = 0; j < 4; ++j) cw[j] = *(const f32x4*)(a.in[7] + (size_t)j * D + gc);
        const bf16* wr_ = (const bf16*)(ws + WS_LRUW) + (size_t)(h * 128 + 16 * wid + fr) * 128 + 8 * fq;
        const bf16* wi_ = wr_ + (size_t)8 * 128 * 128;
        bf16x8 Br[4], Bi[4];
#pragma unroll
        for (int ks = 0; ks < 4; ++ks) { Br[ks] = *(const bf16x8*)(wr_ + 32 * ks); Bi[ks] = *(const bf16x8*)(wi_ + 32 * ks); }
        const int ch = 128 * h + 16 * wid + fr;
        const float br = a.in[10][ch], bi = a.in[12][ch], ls8 = -8.0f * log1pf(__expf(-a.in[13][ch]));
        float hin = OUT ? ((const float*)(ws + WS_LRU_CARRY))[(size_t)(b * NCHUNK + c) * D + ch] : 0.f;
        __syncthreads();
        { float w0[4], w1[4], w2[4], w3[4]; const LAS unsigned char* rp = lds + L_RAW + (8 * tg) * RLD + 8 * n; u32x2 u;
          u = *(const LAS u32x2*)(rp); w0[0] = bf2f(u.x & 0xffffu); w0[1] = bf2f(u.x >> 16); w0[2] = bf2f(u.y & 0xffffu); w0[3] = bf2f(u.y >> 16);
          u = *(const LAS u32x2*)(rp + RLD); w1[0] = bf2f(u.x & 0xffffu); w1[1] = bf2f(u.x >> 16); w1[2] = bf2f(u.y & 0xffffu); w1[3] = bf2f(u.y >> 16);
          u = *(const LAS u32x2*)(rp + 2 * RLD); w2[0] = bf2f(u.x & 0xffffu); w2[1] = bf2f(u.x >> 16); w2[2] = bf2f(u.y & 0xffffu); w2[3] = bf2f(u.y >> 16);
#pragma unroll
          for (int i = 0; i < 8; ++i) { const int t = 8 * tg + i;
              u = *(const LAS u32x2*)(rp + (3 + i) * RLD); w3[0] = bf2f(u.x & 0xffffu); w3[1] = bf2f(u.x >> 16); w3[2] = bf2f(u.y & 0xffffu); w3[3] = bf2f(u.y >> 16);
              float y[4];
#pragma unroll
              for (int e = 0; e < 4; ++e) y[e] = cb[e] + cw[0][e] * w0[e] + cw[1][e] * w1[e] + cw[2][e] * w2[e] + cw[3][e] * w3[e];
              u32x2 o; o.x = pk2(y[0], y[1]); o.y = pk2(y[2], y[3]); *(LAS u32x2*)(lds + L_T0 + t * RLD + 8 * n) = o;
#pragma unroll
              for (int e = 0; e < 4; ++e) { w0[e] = w1[e]; w1[e] = w2[e]; w2[e] = w3[e]; } } }
        __syncthreads();
        if (h < 7) RAW_PF(pr, proj, EVEN_IN, row0, c * CH, 128 * (h + 1));
        float aprod = 1.f;
#pragma unroll 1
        for (int mt = 0; mt < 8; ++mt) {
            f32x4 ar = (f32x4){0.f, 0.f, 0.f, 0.f}, ai = ar;
#pragma unroll
            for (int ks = 0; ks < 4; ++ks) { const bf16x8 A = LFRAG(lds + L_T0, 16 * mt + fr, 32 * ks + 8 * fq); ar = MFMA16(A, Br[ks], ar); ai = MFMA16(A, Bi[ks], ai); }
            float av[4], uv[4];
#pragma unroll
            for (int j = 0; j < 4; ++j) { const float rr = sigmoidf_(ar[j] + br), ii = sigmoidf_(ai[j] + bi); av[j] = __expf(rr * ls8);
                const float x = bf2f(*(const LAS bf16*)(lds + L_T0 + (16 * mt + 4 * fq + j) * RLD + (16 * wid + fr) * 2));
                uv[j] = __builtin_amdgcn_sqrtf(fmaxf(1.0f - av[j] * av[j], 0.f)) * ii * x; }
            const float As = av[0] * av[1] * av[2] * av[3];
            const float Hs = ((uv[0] * av[1] + uv[1]) * av[2] + uv[2]) * av[3] + uv[3];
            const float A0 = __shfl(As, fr), H0 = __shfl(Hs, fr), A1 = __shfl(As, 16 + fr), H1 = __shfl(Hs, 16 + fr), A2 = __shfl(As, 32 + fr), H2 = __shfl(Hs, 32 + fr), A3 = __shfl(As, 48 + fr), H3 = __shfl(Hs, 48 + fr);
            const float h0 = hin, h1 = A0 * h0 + H0, h2 = A1 * h1 + H1, h3 = A2 * h2 + H2, hend = A3 * h3 + H3;
            if (OUT) { float hs = fq == 0 ? h0 : (fq == 1 ? h1 : (fq == 2 ? h2 : h3));
#pragma unroll
                for (int j = 0; j < 4; ++j) { hs = av[j] * hs + uv[j]; const int off = (16 * mt + 4 * fq + j) * RLD + (16 * wid + fr) * 2;
                    const float g = bf2f(*(const LAS bf16*)(lds + L_T1 + off)); *(LAS bf16*)(lds + L_T2 + off) = (bf16)f2bf(hs * gelu_tanh(g)); } }
            else { float hs = fq == 0 ? h0 : (fq == 1 ? h1 : (fq == 2 ? h2 : h3));
                float pp = aprod * (fq == 0 ? 1.0f : (fq == 1 ? A0 : (fq == 2 ? A0 * A1 : A0 * A1 * A2)));
#pragma unroll
                for (int j = 0; j < 4; ++j) { hs = av[j] * hs + uv[j]; pp *= av[j]; const int off = (16 * mt + 4 * fq + j) * RLD + (16 * wid + fr) * 2;
                    *(LAS bf16*)(lds + L_T1 + off) = (bf16)f2bf(hs); *(LAS bf16*)(lds + L_T2 + off) = (bf16)f2bf(pp); } }
            hin = hend; aprod *= (A0 * A1) * (A2 * A3);
        }
        if (!OUT && fq == 0) { ((float*)(ws + WS_LRU_AT))[(size_t)(b * NCHUNK + c) * D + ch] = aprod; ((float*)(ws + WS_LRU_HT))[(size_t)(b * NCHUNK + c) * D + ch] = hin; }
        __syncthreads();
        if (OUT) {
#pragma unroll
            for (int i = 0; i < 4; ++i) { const int q = F.tid + i * NTHR, r = q >> 4, cc = q & 15; *(u32x4*)((bf16*)(ws + WS_MIX) + (size_t)(row0 + r) * MIXW + 128 * h + 8 * cc) = *(const LAS u32x4*)(lds + L_T2 + r * RLD + cc * 16); }
        } else {
#pragma unroll
            for (int i = 0; i < 4; ++i) { const int q = F.tid + i * NTHR, r = q >> 4, cc = q & 15; const size_t go = (size_t)(row0 + r) * D + 128 * h + 8 * cc;
                *(u32x4*)((bf16*)(ws + WS_LRU_HL) + go) = *(const LAS u32x4*)(lds + L_T1 + r * RLD + cc * 16); *(u32x4*)((bf16*)(ws + WS_LRU_PC) + go) = *(const LAS u32x4*)(lds + L_T2 + r * RLD + cc * 16); }
        }
    }
    __syncthreads();
}

__device__ __forceinline__ void ph_ev_local(const PArgs& a, Frame& F) { for (int u = F.bid; u < NB * NCHUNK; u += F.G) { const int b = u / NCHUNK, c = u % NCHUNK; lru_unit2<false>(a, F, b, c); ml_pre(a, F, b, c); ml_local2_nl((const GAS unsigned char*)a.in.p, (GAS unsigned char*)F.ws, b, c); } }
__device__ __forceinline__ void ph_ev_out(const PArgs& a, Frame& F) { for (int u = F.bid; u < NB * NCHUNK; u += F.G) { const int b = u / NCHUNK, c = u % NCHUNK; lru_fix(a, F, b, c); ml_out2(a, F, b, c); } }
__device__ __forceinline__ void ph_ev_scan(const PArgs& a, Frame& F) {
    unsigned char* ws = F.ws; const size_t gt = (size_t)F.bid * NTHR + F.tid, NT = (size_t)F.G * NTHR;
    for (size_t i = gt; i < (size_t)NB * D; i += NT) { const int b = (int)(i / D), ch = (int)(i % D); float carry = 0.f;
        for (int c = 0; c < NCHUNK; ++c) { const size_t o = (size_t)(b * NCHUNK + c) * D + ch; ((float*)(ws + WS_LRU_CARRY))[o] = carry; carry = ((const float*)(ws + WS_LRU_AT))[o] * carry + ((const float*)(ws + WS_LRU_HT))[o]; } }
    for (size_t i = gt; i < (size_t)64 * 4096; i += NT) { const int bh = (int)(i >> 12), e4 = (int)(i & 4095);
        float m = -1.0e30f; f32x4 val = (f32x4){0.f, 0.f, 0.f, 0.f};
#pragma unroll 1
        for (int c0 = 0; c0 < NCHUNK; c0 += 8) { u32x2 loc[8]; float Gv[8], mlv[8];
#pragma unroll
            for (int k = 0; k < 8; ++k) { const int u = bh * NCHUNK + c0 + k; Gv[k] = ((const float*)(ws + WS_ML_GT))[u]; mlv[k] = ((const float*)(ws + WS_ML_ML))[u]; loc[k] = *(const u32x2*)((const bf16*)(ws + WS_CLOC) + (size_t)u * 16384 + 4 * e4); }
#pragma unroll
            for (int k = 0; k < 8; ++k) { const int u = bh * NCHUNK + c0 + k;
                u32x2 w; w.x = pk2(val[0], val[1]); w.y = pk2(val[2], val[3]); *(u32x2*)((bf16*)(ws + WS_CST) + (size_t)u * 16384 + 4 * e4) = w;
                if (e4 == 0) ((float*)(ws + WS_ML_MS))[u] = m;
                const float mn = fmaxf(m + Gv[k], mlv[k]); const float wc = __expf(m + Gv[k] - mn), wl = __expf(mlv[k] - mn);
                const f32x4 lv = (f32x4){bf2f(loc[k].x & 0xffffu), bf2f(loc[k].x >> 16), bf2f(loc[k].y & 0xffffu), bf2f(loc[k].y >> 16)};
                val = val * wc + lv * wl; m = mn; } } }
    for (size_t i = gt; i < (size_t)64 * 128; i += NT) { const int bh = (int)(i >> 7), e = (int)(i & 127);
        float m = -1.0e30f, val = 0.f;
#pragma unroll 1
        for (int c0 = 0; c0 < NCHUNK; c0 += 8) { float loc[8], Gv[8], mlv[8];
#pragma unroll
            for (int k = 0; k < 8; ++k) { const int u = bh * NCHUNK + c0 + k; Gv[k] = ((const float*)(ws + WS_ML_GT))[u]; mlv[k] = ((const float*)(ws + WS_ML_ML))[u]; loc[k] = ((const float*)(ws + WS_ML_NLOC))[(size_t)u * 128 + e]; }
#pragma unroll
            for (int k = 0; k < 8; ++k) { const int u = bh * NCHUNK + c0 + k;
                ((float*)(ws + WS_ML_NST))[(size_t)u * 128 + e] = val;
                const float mn = fmaxf(m + Gv[k], mlv[k]); const float wc = __expf(m + Gv[k] - mn), wl = __expf(mlv[k] - mn);
                val = wc * val + wl * loc[k]; m = mn; } } }
}

__device__ __forceinline__ void ssd_pre(const PArgs& a, Frame& F, int b, int c) {
    unsigned char* ws = F.ws; const bf16* proj = (const bf16*)(ws + WS_PROJ); bf16* xbc = (bf16*)(ws + WS_XBC);
    const int row0 = b * SEQ + c * CH, ch0 = 8 * F.tid;
    float cw[4][8], cb[8];
#pragma unroll
    for (int j = 0; j < 4; ++j) { const f32x4 lo = *(const f32x4*)(a.in[27] + (size_t)j * 4096 + ch0), hi = *(const f32x4*)(a.in[27] + (size_t)j * 4096 + ch0 + 4);
#pragma unroll
        for (int e = 0; e < 4; ++e) { cw[j][e] = lo[e]; cw[j][4 + e] = hi[e]; } }
    { const f32x4 lo = *(const f32x4*)(a.in[28] + ch0), hi = *(const f32x4*)(a.in[28] + ch0 + 4);
#pragma unroll
        for (int e = 0; e < 4; ++e) { cb[e] = lo[e]; cb[4 + e] = hi[e]; } }
    const bf16* src = proj + (size_t)row0 * OD_INP + 2048 + ch0;
    u32x4 r0 = (u32x4){0u, 0u, 0u, 0u}, r1 = r0, r2 = r0;
    if (c > 0) { r0 = *(const u32x4*)(src - 3 * (ptrdiff_t)OD_INP); r1 = *(const u32x4*)(src - 2 * (ptrdiff_t)OD_INP); r2 = *(const u32x4*)(src - (ptrdiff_t)OD_INP); }
#pragma unroll 1
    for (int t0 = 0; t0 < CH; t0 += 8) {
        u32x4 rr[8];
#pragma unroll
        for (int i = 0; i < 8; ++i) rr[i] = *(const u32x4*)(src + (size_t)(t0 + i) * OD_INP);
#pragma unroll
        for (int i = 0; i < 8; ++i) { const u32x4 r3 = rr[i]; float o[8];
#pragma unroll
            for (int e = 0; e < 8; ++e) { const unsigned w0 = (e < 2) ? r0.x : (e < 4) ? r0.y : (e < 6) ? r0.z : r0.w, w1 = (e < 2) ? r1.x : (e < 4) ? r1.y : (e < 6) ? r1.z : r1.w,
                    w2 = (e < 2) ? r2.x : (e < 4) ? r2.y : (e < 6) ? r2.z : r2.w, w3 = (e < 2) ? r3.x : (e < 4) ? r3.y : (e < 6) ? r3.z : r3.w;
                const float x0 = bf2f((e & 1) ? (w0 >> 16) : (w0 & 0xffffu)), x1 = bf2f((e & 1) ? (w1 >> 16) : (w1 & 0xffffu)), x2 = bf2f((e & 1) ? (w2 >> 16) : (w2 & 0xffffu)), x3 = bf2f((e & 1) ? (w3 >> 16) : (w3 & 0xffffu));
                o[e] = siluf_(cb[e] + cw[0][e] * x0 + cw[1][e] * x1 + cw[2][e] * x2 + cw[3][e] * x3); }
            u32x4 w; w.x = pk2(o[0], o[1]); w.y = pk2(o[2], o[3]); w.z = pk2(o[4], o[5]); w.w = pk2(o[6], o[7]);
            *(u32x4*)(xbc + (size_t)(row0 + t0 + i) * 4096 + ch0) = w;
            r0 = r1; r1 = r2; r2 = r3; }
    }
}
constexpr int L_DT2 = L_T2, L_AC2 = L_T2 + 16384;
constexpr int L_DT4 = L_SM, L_AC4 = L_SM + 2048;
__device__ __forceinline__ void ssd_local2(const PArgs& a, Frame& F, int b, int c) {
    unsigned char* ws = F.ws; LAS unsigned char* lds = F.lds;
    const bf16* proj = (const bf16*)(ws + WS_PROJ); const bf16* xbc = (const bf16*)(ws + WS_XBC);
    const int wid = F.wave, lane = F.lane, fr = lane & 15, fq = lane >> 4, row0 = b * SEQ + c * CH;
    LAS float* DT = (LAS float*)(lds + L_DT2); LAS float* AC = (LAS float*)(lds + L_AC2);
    __syncthreads();
    for (int q = F.tid; q < CH * 32; q += NTHR) { const int t = q >> 5, hd = q & 31; const float raw = bf2f(proj[(size_t)(row0 + t) * OD_INP + 6144 + hd]); DT[q] = softplusf_(raw + a.in[29][hd]); }
    __syncthreads();
    if (F.tid < 32) { const float A = -__expf(a.in[30][F.tid]); float acc = 0.f; for (int t = 0; t < CH; ++t) { acc += DT[t * 32 + F.tid] * A; AC[t * 32 + F.tid] = acc; }
        ((float*)(ws + WS_SSD_ALAST))[(size_t)(b * NCHUNK + c) * 32 + F.tid] = acc; }
    __syncthreads();
    for (int q = F.tid; q < CH * 32; q += NTHR) { ((float*)(ws + WS_DTG))[(size_t)row0 * 32 + q] = DT[q]; ((float*)(ws + WS_ACG))[(size_t)row0 * 32 + q] = AC[q]; }
    ssd_pre(a, F, b, c);
    WSYNC();
    for (int g = 0; g < 8; ++g) {
        copy_tile(F, xbc + (size_t)row0 * 4096 + 2048 + 128 * g, 4096, L_T1);
        for (int jp = 0; jp < 2; ++jp) { const int hd0 = 4 * g + 2 * jp;
            const bf16* xs = xbc + (size_t)row0 * 4096 + 64 * hd0;
#pragma unroll
            for (int i = 0; i < 4; ++i) { const int q = F.tid + i * NTHR, r = q >> 4, cc = q & 15, hd = hd0 + (cc >> 3);
                const float sc = __expf(AC[127 * 32 + hd] - AC[r * 32 + hd]) * DT[r * 32 + hd];
                *(LAS u32x4*)(lds + L_T0 + r * RLD + cc * 16) = scale8(*(const u32x4*)(xs + (size_t)r * 4096 + 8 * cc), sc); }
            __syncthreads();
            bf16x8 Ax[4]; tr_frag4<RLD>(tr_addr(lds + L_T0, 16 * wid, lane), Ax);
            bf16* sl = (bf16*)(ws + WS_SLOC) + ((size_t)(b * NCHUNK + c) * 32 + hd0 + (wid >> 2)) * 8192;
#pragma unroll
            for (int nt = 0; nt < 8; ++nt) { bf16x8 Bb[4]; tr_frag4<RLD>(tr_addr(lds + L_T1, 16 * nt, lane), Bb);
                f32x4 acc = (f32x4){0.f, 0.f, 0.f, 0.f};
#pragma unroll
                for (int ks = 0; ks < 4; ++ks) acc = MFMA16(Ax[ks], Bb[ks], acc);
#pragma unroll
                for (int jj = 0; jj < 4; ++jj) sl[(16 * (wid & 3) + 4 * fq + jj) * 128 + 16 * nt + fr] = (bf16)f2bf(acc[jj]); }
            __syncthreads();
        }
    }
}
constexpr int L_NW4 = L_SM + 4096, L_SS = L_SM + 5120;
__device__ __forceinline__ void ssd_out3(const PArgs& a, Frame& F, int b, int c) {
    unsigned char* ws = F.ws; LAS unsigned char* lds = F.lds;
    const bf16* proj = (const bf16*)(ws + WS_PROJ); const bf16* xbc = (const bf16*)(ws + WS_XBC); bf16* mix = (bf16*)(ws + WS_MIX);
    const int wid = F.wave, lane = F.lane, fr = lane & 15, fq = lane >> 4, row0 = b * SEQ + c * CH;
    LAS float* DT4 = (LAS float*)(lds + L_DT4); LAS float* AC4 = (LAS float*)(lds + L_AC4); LAS float* NW4 = (LAS float*)(lds + L_NW4);
    LAS unsigned char* PS = lds + L_RAW + wid * 16 * RLD;
    LAS unsigned char* YS = lds + L_T0 + wid * 8448;
    const bf16* sstb = (const bf16*)(ws + WS_SST) + (size_t)(b * NCHUNK + c) * 32 * 8192;
    u32x4 pss[2];
#define SS_PF(hd_) do { const bf16* sp_ = sstb + (size_t)(hd_) * 8192; _Pragma("unroll") for (int i_ = 0; i_ < 2; ++i_) { const int q_ = F.tid + i_ * NTHR; pss[i_] = *(const u32x4*)(sp_ + (size_t)(q_ >> 4) * 128 + 8 * (q_ & 15)); } } while (0)
#define SS_PW() do { _Pragma("unroll") for (int i_ = 0; i_ < 2; ++i_) { const int q_ = F.tid + i_ * NTHR; *(LAS u32x4*)(lds + L_SS + (q_ >> 4) * RLD + (q_ & 15) * 16) = pss[i_]; } } while (0)
    SS_PF(0);
    for (int g = 0; g < 8; ++g) {
        __syncthreads();
        const bf16* xb0 = xbc + (size_t)row0 * 4096;
        copy_tile(F, xb0 + 3072 + 128 * g, 4096, L_T0);
        copy_tile(F, xb0 + 2048 + 128 * g, 4096, L_T1);
        copy_tile(F, xb0 + 64 * (4 * g), 4096, L_T2);
        u32x4 px1[4];
#pragma unroll
        for (int i = 0; i < 4; ++i) { const int q = F.tid + i * NTHR; px1[i] = *(const u32x4*)(xb0 + 64 * (4 * g + 2) + (size_t)(q >> 4) * 4096 + 8 * (q & 15)); }
        { const int t = F.tid >> 2, j = F.tid & 3; DT4[F.tid] = ((const float*)(ws + WS_DTG))[(size_t)(row0 + t) * 32 + 4 * g + j]; AC4[F.tid] = ((const float*)(ws + WS_ACG))[(size_t)(row0 + t) * 32 + 4 * g + j]; }
        if (F.tid < 256) NW4[F.tid] = a.in[32][256 * g + F.tid];
        __syncthreads();
        bf16x8 Ac[4];
#pragma unroll
        for (int ks = 0; ks < 4; ++ks) Ac[ks] = LFRAG(lds + L_T0, 16 * wid + fr, 32 * ks + 8 * fq);
        f32x4 cb[8];
#pragma unroll
        for (int nt = 0; nt < 8; ++nt) { cb[nt] = (f32x4){0.f, 0.f, 0.f, 0.f};
            if (nt <= wid) {
#pragma unroll
                for (int ks = 0; ks < 4; ++ks) { const bf16x8 B = LFRAG(lds + L_T1, 16 * nt + fr, 32 * ks + 8 * fq); cb[nt] = MFMA16(Ac[ks], B, cb[nt]); } } }
        __syncthreads();
#pragma unroll
        for (int i = 0; i < 4; ++i) { const int q = F.tid + i * NTHR; *(LAS u32x4*)(lds + L_T1 + (q >> 4) * RLD + (q & 15) * 16) = px1[i]; }
        SS_PW();
        __syncthreads();
        unsigned yp[4][4][2];
#pragma unroll 1
        for (int j = 0; j < 4; ++j) { const int hd = 4 * g + j; const int xoff = (j < 2 ? L_T2 : L_T1), xcol = 64 * (j & 1);
            if (hd < 31) SS_PF(hd + 1);
            float at[4];
#pragma unroll
            for (int jj = 0; jj < 4; ++jj) at[jj] = AC4[(16 * wid + 4 * fq + jj) * 4 + j];
#pragma unroll
            for (int nt = 0; nt < 8; ++nt) {
                if (nt <= wid) { const int s_ = 16 * nt + fr; const float as = AC4[s_ * 4 + j], ds = DT4[s_ * 4 + j];
#pragma unroll
                    for (int jj = 0; jj < 4; ++jj) { const int t = 16 * wid + 4 * fq + jj; const float w = (s_ <= t) ? cb[nt][jj] * __expf(at[jj] - as) * ds : 0.f;
                        *(LAS bf16*)(PS + (4 * fq + jj) * RLD + s_ * 2) = (bf16)f2bf(w); }
                } else if (nt == wid + 1) {
#pragma unroll
                    for (int jj = 0; jj < 4; ++jj) *(LAS bf16*)(PS + (4 * fq + jj) * RLD + (16 * nt + fr) * 2) = (bf16)0;
                }
            }
            asm volatile("s_waitcnt lgkmcnt(0)" ::: "memory");
            f32x4 ya[4];
#pragma unroll
            for (int np = 0; np < 4; ++np) ya[np] = (f32x4){0.f, 0.f, 0.f, 0.f};
#pragma unroll
            for (int ks = 0; ks < 4; ++ks) {
#pragma unroll
                for (int np = 0; np < 4; ++np) { const bf16x8 B = LFRAG(lds + L_SS, 16 * np + fr, 32 * ks + 8 * fq); ya[np] = MFMA16(Ac[ks], B, ya[np]); } }
#pragma unroll
            for (int np = 0; np < 4; ++np)
#pragma unroll
                for (int jj = 0; jj < 4; ++jj) ya[np][jj] *= __expf(at[jj]);
            const int kmax = (wid + 2) >> 1;
            bf16x8 Ap[4];
#pragma unroll
            for (int ks = 0; ks < 4; ++ks) Ap[ks] = LFRAG(PS, fr, 32 * ks + 8 * fq);
            const float dsk = a.in[31][hd];
#pragma unroll
            for (int np = 0; np < 4; ++np) { bf16x8 Bx[4]; tr_frag4<RLD>(tr_addr(lds + xoff, xcol + 16 * np, lane), Bx);
#pragma unroll
                for (int ks = 0; ks < 4; ++ks) if (ks < kmax) ya[np] = MFMA16(Ap[ks], Bx[ks], ya[np]);
                float yg[4];
#pragma unroll
                for (int jj = 0; jj < 4; ++jj) { const int t = 16 * wid + 4 * fq + jj; const float x = bf2f(*(const LAS bf16*)(lds + xoff + t * RLD + (xcol + 16 * np + fr) * 2)); yg[jj] = ya[np][jj] + dsk * x; }
                const unsigned p0 = pk2(yg[0], yg[1]), p1 = pk2(yg[2], yg[3]);
                if (j == 0) { yp[0][np][0] = p0; yp[0][np][1] = p1; } else if (j == 1) { yp[1][np][0] = p0; yp[1][np][1] = p1; } else if (j == 2) { yp[2][np][0] = p0; yp[2][np][1] = p1; } else { yp[3][np][0] = p0; yp[3][np][1] = p1; } }
            __syncthreads();
            if (j < 3) { SS_PW(); __syncthreads(); }
        }
        const int er = lane >> 2, ej = lane & 3; const size_t egrow = (size_t)(row0 + 16 * wid + er); const int ehd = 4 * g + ej;
        u32x4 zw[8];
#pragma unroll
        for (int q = 0; q < 8; ++q) zw[q] = *(const u32x4*)(proj + egrow * OD_INP + 64 * ehd + 8 * q);
#pragma unroll
        for (int j = 0; j < 4; ++j)
#pragma unroll
            for (int np = 0; np < 4; ++np)
#pragma unroll
                for (int jj = 0; jj < 4; ++jj) { const unsigned pw = yp[j][np][jj >> 1]; *(LAS bf16*)(YS + (4 * fq + jj) * 528 + (64 * j + 16 * np + fr) * 2) = (bf16)((jj & 1) ? (pw >> 16) : (pw & 0xffffu)); }
        asm volatile("s_waitcnt lgkmcnt(0)" ::: "memory");
        { float ssq = 0.f;
#pragma unroll
            for (int q = 0; q < 8; ++q) { LAS u32x4* yp_ = (LAS u32x4*)(YS + er * 528 + (64 * ej + 8 * q) * 2); const u32x4 yw = *yp_; float o[8];
#pragma unroll
                for (int e = 0; e < 8; ++e) { const unsigned yy = (e < 2) ? yw.x : (e < 4) ? yw.y : (e < 6) ? yw.z : yw.w, zz = (e < 2) ? zw[q].x : (e < 4) ? zw[q].y : (e < 6) ? zw[q].z : zw[q].w;
                    const float y = bf2f((e & 1) ? (yy >> 16) : (yy & 0xffffu)), z = bf2f((e & 1) ? (zz >> 16) : (zz & 0xffffu)); o[e] = y * siluf_(z); ssq += o[e] * o[e]; }
                u32x4 w; w.x = pk2(o[0], o[1]); w.y = pk2(o[2], o[3]); w.z = pk2(o[4], o[5]); w.w = pk2(o[6], o[7]); *yp_ = w; }
            ssq += __shfl_xor(ssq, 1); ssq += __shfl_xor(ssq, 2);
            const float rstd = __builtin_amdgcn_rsqf(ssq * (1.0f / 256.0f) + EPS);
#pragma unroll
            for (int q = 0; q < 8; ++q) { const int cl = 64 * ej + 8 * q; const f32x4 n0 = *(const LAS f32x4*)(NW4 + cl), n1 = *(const LAS f32x4*)(NW4 + cl + 4); const u32x4 yw = *(const LAS u32x4*)(YS + er * 528 + cl * 2);
                u32x4 w; w.x = pk2(bf2f(yw.x & 0xffffu) * rstd * n0[0], bf2f(yw.x >> 16) * rstd * n0[1]); w.y = pk2(bf2f(yw.y & 0xffffu) * rstd * n0[2], bf2f(yw.y >> 16) * rstd * n0[3]);
                w.z = pk2(bf2f(yw.z & 0xffffu) * rstd * n1[0], bf2f(yw.z >> 16) * rstd * n1[1]); w.w = pk2(bf2f(yw.w & 0xffffu) * rstd * n1[2], bf2f(yw.w >> 16) * rstd * n1[3]);
                *(u32x4*)(mix + egrow * MIXW + 256 * g + cl) = w; } }
    }
    __syncthreads();
#undef SS_PF
#undef SS_PW
}
__device__ __forceinline__ void ph_od_local(const PArgs& a, Frame& F) { for (int u = F.bid; u < NB * NCHUNK; u += F.G) ssd_local2(a, F, u / NCHUNK, u % NCHUNK); }
__device__ __forceinline__ void ph_od_out(const PArgs& a, Frame& F) { for (int u = F.bid; u < NB * NCHUNK; u += F.G) ssd_out3(a, F, u / NCHUNK, u % NCHUNK); }
__device__ __forceinline__ void ph_od_scan(const PArgs& a, Frame& F) {
    unsigned char* ws = F.ws; const size_t gt = (size_t)F.bid * NTHR + F.tid, NT = (size_t)F.G * NTHR;
    for (size_t i = gt; i < (size_t)NB * 32 * 8192 / 4; i += NT) { const int b = (int)(i / (32 * 2048)), rem = (int)(i % (32 * 2048)), hd = rem / 2048, e4 = rem % 2048;
        f32x4 st = (f32x4){0.f, 0.f, 0.f, 0.f};
#pragma unroll 1
        for (int c0 = 0; c0 < NCHUNK; c0 += 8) { f32x4 loc[8]; float dec[8];
#pragma unroll
            for (int k = 0; k < 8; ++k) { const size_t u = (size_t)(b * NCHUNK + c0 + k) * 32 + hd; { const u32x2 lw = *(const u32x2*)((const bf16*)(ws + WS_SLOC) + u * 8192 + 4 * e4); loc[k] = (f32x4){bf2f(lw.x & 0xffffu), bf2f(lw.x >> 16), bf2f(lw.y & 0xffffu), bf2f(lw.y >> 16)}; } dec[k] = ((const float*)(ws + WS_SSD_ALAST))[u]; }
#pragma unroll
            for (int k = 0; k < 8; ++k) { const size_t u = (size_t)(b * NCHUNK + c0 + k) * 32 + hd;
                u32x2 w; w.x = pk2(st[0], st[1]); w.y = pk2(st[2], st[3]); *(u32x2*)((bf16*)(ws + WS_SST) + u * 8192 + 4 * e4) = w;
                st = st * __expf(dec[k]) + loc[k]; } } }
}

__device__ __forceinline__ int moe_tables(Frame& F, int l) {
    LAS int* tab = (LAS int*)(F.lds + L_SCHED);
    __syncthreads();
    if (F.tid == 0) { int o = 0, ts = 0; for (int e = 0; e < NE; ++e) { const int cnt = (int)F.ctl[CW_CNT + l * 2048 + e * 64]; tab[e] = cnt; tab[32 + e] = o; tab[65 + e] = ts; o += cnt; ts += (cnt + 255) >> 8; } tab[64] = o; tab[97] = ts; }
    __syncthreads();
    return tab[97];
}
__device__ __forceinline__ void ph_moe1(const PArgs& a, Frame& F, int l) {
    const int ntiles = moe_tables(F, l);
    pg8::MoeSched<true, 8, 4> S; S.A = (const void*)(F.ws + WS_U); S.Bt = (const void*)(F.ws + WS_WGU + (size_t)l * 32 * 2048 * D); S.rowtok = (const int*)(F.ws + WS_ROWTOK);
    S.PB = D; S.G = F.G; S.c = F.bid; S.ntiles = ntiles; S.tab = (const LAS int*)(F.lds + L_SCHED); S.bstride = 2048;
    pg8::EpiSwiglu E{(unsigned char*)(F.ws + WS_ACT), a.in[37] + (size_t)l * 32 * 2048, (unsigned char*)(F.ws + WS_DUMMY) + F.tid * 16};
    pg8::gemm_phase<pg8::EpiSwiglu, pg8::MoeSched<true, 8, 4>, true>(F.lds, S, E);
}
__device__ __forceinline__ void ph_moe2(const PArgs& a, Frame& F, int l) {
    const int ntiles = moe_tables(F, l);
    pg8::MoeSched<false, 4, 8> S; S.A = (const void*)(F.ws + WS_ACT); S.Bt = (const void*)(F.ws + WS_WDN + (size_t)l * 32 * D * DFF); S.rowtok = nullptr;
    S.PB = DFF; S.G = F.G; S.c = F.bid; S.ntiles = ntiles; S.tab = (const LAS int*)(F.lds + L_SCHED); S.bstride = 1024;
    pg8::EpiDown E{(unsigned char*)(F.ws + WS_YBUF), a.in[39] + (size_t)l * 32 * D, (const float*)(F.ws + WS_ROWGATE), (unsigned char*)(F.ws + WS_DUMMY) + F.tid * 16};
    pg8::gemm_phase<pg8::EpiDown, pg8::MoeSched<false, 4, 8>, true>(F.lds, S, E);
}
__device__ __forceinline__ void ph_gemm_plain_bf16(Frame& F, size_t wsA, size_t wsB, int N, int K, size_t wsO) {
    pg8::PlainSched S; S.init((const bf16*)(F.ws + wsA), (const bf16*)(F.ws + wsB), MTOK, N, K, F.G, F.bid);
    pg8::EpiBf16 E{(bf16*)(F.ws + wsO), N, 1.0f};
    pg8::gemm_phase<pg8::EpiBf16, pg8::PlainSched>(F.lds, S, E);
}
__device__ __forceinline__ void ph_gemm_plain_fp8(Frame& F, size_t wsA, size_t wsB, int N, int K, size_t wsO) {
    pg8::PlainSched S; S.init((const void*)(F.ws + wsA), (const void*)(F.ws + wsB), MTOK, N, K, F.G, F.bid, 1);
    pg8::EpiBf16 E{(bf16*)(F.ws + wsO), N, pg8::WINV8};
    pg8::gemm_phase<pg8::EpiBf16, pg8::PlainSched, true>(F.lds, S, E);
}
template <bool HIN_F32>
__device__ __forceinline__ void ph_gemm_resid(Frame& F, size_t wsB, const GAS void* hin, bf16* hout, int l) {
    pg8::PlainSched S; S.init((const bf16*)(F.ws + WS_MIX), (const bf16*)(F.ws + wsB), MTOK, D, MIXW, F.G, F.bid);
    pg8::EpiResid<HIN_F32> E{hin, hout, (const float*)(F.ws + WS_MODF) + (size_t)l * 8 * 6144 + 2048};
    pg8::gemm_phase<pg8::EpiResid<HIN_F32>, pg8::PlainSched>(F.lds, S, E);
}

__global__ void __launch_bounds__(NTHR, 2) mk_fwd(Args args) {
    extern __shared__ __attribute__((aligned(16))) unsigned char lds_[];
    Frame F;
    F.lds = (LAS unsigned char*)lds_; F.tid = threadIdx.x; F.lane = F.tid & 63; F.wave = __builtin_amdgcn_readfirstlane(F.tid >> 6);
    F.G = gridDim.x; F.bid = blockIdx.x; F.ws = args.ws; F.ctl = (unsigned*)(args.ws + WS_CTL);
    const int lo = args.ph_lo, hi = args.ph_hi;
    volatile LAS unsigned* misc = (volatile LAS unsigned*)(F.lds + L_MISC);
    if (F.tid < 4) misc[F.tid] = 0u;
    __syncthreads();
    XcdBarrier bar; bar.bar = F.ctl + CW_BAR; bar.x = 0; bar.st = misc;
    if (hi - lo > 1) bar = xcd_barrier_post(F.ctl + CW_BAR, misc);
#define IN(k) (lo <= (k) && (k) < hi)
#define SEAM(k) do { if (IN(k) && IN((k) + 1)) xcd_barrier(bar); } while (0)
    bf16* H1 = (bf16*)(F.ws + WS_H1); bf16* H2 = (bf16*)(F.ws + WS_H2);
    PArgs pa; pa.in.p = (const float* const*)(const GAS unsigned char*)(F.ws + WS_ARGTAB);
    if (IN(0)) ph_prep(args, F);
    SEAM(0);
    if (IN(1)) ph_rows<0>(pa, F, 0);
    SEAM(1);
    if (IN(2)) ph_gemm_plain_bf16(F, WS_U, WS_WEVIN, EVEN_IN, D, WS_PROJ);
    SEAM(2);
    if (IN(3)) ph_ev_local(pa, F);
    SEAM(3);
    if (IN(4)) ph_ev_scan(pa, F);
    SEAM(4);
    if (IN(5)) ph_ev_out(pa, F);
    SEAM(5);
    if (IN(6)) ph_gemm_resid<true>(F, WS_WEVOUT, (const GAS void*)pa.in[0], H1, 0);
    SEAM(6);
    if (IN(7)) ph_route(pa, F, 0);
    SEAM(7);
    if (IN(8)) ph_moe1(pa, F, 0);
    SEAM(8);
    if (IN(9)) ph_moe2(pa, F, 0);
    SEAM(9);
    if (IN(10)) ph_rows<1>(pa, F, 0);
    SEAM(10);
    if (IN(11)) ph_gemm_plain_fp8(F, WS_U, WS_WODIN, OD_INP, D, WS_PROJ);
    SEAM(11);
    if (IN(12)) ph_od_local(pa, F);
    SEAM(12);
    if (IN(13)) ph_od_scan(pa, F);
    SEAM(13);
    if (IN(14)) ph_od_out(pa, F);
    SEAM(14);
    if (IN(15)) ph_gemm_resid<false>(F, WS_WODOUT, (const GAS void*)H2, H1, 1);
    SEAM(15);
    if (IN(16)) ph_route(pa, F, 1);
    SEAM(16);
    if (IN(17)) ph_moe1(pa, F, 1);
    SEAM(17);
    if (IN(18)) ph_moe2(pa, F, 1);
    SEAM(18);
    if (IN(19)) ph_rows<2>(pa, F, 1);
#undef IN
#undef SEAM
}

extern "C" void kernel_launch(void* const* d_in, const int* in_sizes, int n_in, void* d_out, int out_size, void* d_ws, size_t ws_size, hipStream_t stream) {
    static int grid = 0;
    if (grid == 0) {
        if (n_in != 41 || out_size != MTOK * D || ws_size < WS_END) { fprintf(stderr, "kernel_launch: unexpected shapes (n_in %d, out %d, ws %zu < %zu)\n", n_in, out_size, ws_size, (size_t)WS_END); grid = -1; return; }
        int dev = 0, cus = 0, per_cu = 0;
        if (hipGetDevice(&dev) != hipSuccess || hipDeviceGetAttribute(&cus, hipDeviceAttributeMultiprocessorCount, dev) != hipSuccess) { grid = -1; return; }
        if (hipFuncSetAttribute((const void*)mk_fwd, hipFuncAttributeMaxDynamicSharedMemorySize, LDS_BYTES) != hipSuccess) { fprintf(stderr, "kernel_launch: hipFuncSetAttribute failed\n"); grid = -1; return; }
        if (hipOccupancyMaxActiveBlocksPerMultiprocessor(&per_cu, (const void*)mk_fwd, NTHR, LDS_BYTES) != hipSuccess || per_cu < 1) fprintf(stderr, "kernel_launch: occupancy query says %d\n", per_cu);
        (void)hipGetLastError();
        grid = cus;
    }
    if (grid < 0) return;
    (void)hipMemsetAsync((char*)d_ws + WS_CTL, 0, CTL_ZERO_BYTES, stream);
    Args a{};
    for (int i = 0; i < 41; ++i) a.in[i] = (const float*)d_in[i];
    a.out = (float*)d_out; a.ws = (unsigned char*)d_ws;
#if MK_ONE_LAUNCH
    a.ph_lo = 0; a.ph_hi = NPH;
    hipLaunchKernelGGL(mk_fwd, dim3(grid), dim3(NTHR), LDS_BYTES, stream, a);
#else
    for (int k = 0; k < NPH; ++k) { a.ph_lo = k; a.ph_hi = k + 1; hipLaunchKernelGGL(mk_fwd, dim3(grid), dim3(NTHR), LDS_BYTES, stream, a); }
#endif
}
```

```cpp
#include <hip/hip_runtime.h>
#include <cstdio>
#include <cstdint>

#ifndef MK_ONE_LAUNCH
#define MK_ONE_LAUNCH 1
#endif

#define GAS __attribute__((address_space(1)))
#define LAS __attribute__((address_space(3)))
typedef unsigned short bf16;
typedef short bf16x8 __attribute__((ext_vector_type(8)));
typedef float f32x4 __attribute__((ext_vector_type(4)));
typedef unsigned u32x4 __attribute__((ext_vector_type(4)));
typedef unsigned u32x2 __attribute__((ext_vector_type(2)));
typedef int i32x8 __attribute__((ext_vector_type(8)));
typedef int i32x4 __attribute__((ext_vector_type(4)));

constexpr int NB = 8, SEQ = 4096, D = 1024, MTOK = NB * SEQ, CH = 128, NCHUNK = SEQ / CH;
constexpr int EVEN_IN = 4096, OD_IN = 6176, OD_INP = 6400, MIXW = 2048;
constexpr int NE = 32, TOPK = 4, DFF = 1024, ECAP = MTOK;
constexpr float EPS = 1e-6f;
constexpr int NWAVES = 8, NTHR = 512;
constexpr int NPH = 20;

constexpr size_t MiB = 1u << 20;
constexpr size_t WS_CTL = 0, CTL_ZERO_BYTES = 128 * 1024;
constexpr size_t WS_MODP = 1 * MiB;
constexpr size_t WS_MODF = 7 * MiB;
constexpr size_t WS_LRUW = 8 * MiB;
constexpr size_t WS_GATEW = 8 * MiB + 512 * 1024;
constexpr size_t WS_ROUTW = 8 * MiB + 768 * 1024;
constexpr size_t WS_ROWTOK = 9 * MiB;
constexpr size_t WS_ROWGATE = 13 * MiB;
constexpr size_t WS_TOKSLOT = 17 * MiB;
constexpr size_t WS_LRU_AT = 18 * MiB, WS_LRU_HT = 19 * MiB, WS_LRU_CARRY = 20 * MiB;
constexpr size_t WS_ML_G = 21 * MiB, WS_ML_B = 22 * MiB;
constexpr size_t WS_ML_NLOC = 23 * MiB, WS_ML_NST = 24 * MiB;
constexpr size_t WS_ML_GT = 25 * MiB, WS_ML_ML = 25 * MiB + 65536, WS_ML_MS = 25 * MiB + 131072;
constexpr size_t WS_SSD_ALAST = 26 * MiB;
constexpr size_t WS_ARGTAB = 27 * MiB;
constexpr size_t WS_DUMMY = 27 * MiB + 65536;
constexpr size_t WS_WEVIN = 28 * MiB, WS_WEVOUT = 36 * MiB, WS_WODIN = 40 * MiB, WS_WODOUT = 53 * MiB;
constexpr size_t WS_WGU = 64 * MiB, WS_WDN = 320 * MiB;
constexpr size_t WS_U = 448 * MiB, WS_H1 = 512 * MiB, WS_H2 = 640 * MiB, WS_MIX = 768 * MiB;
constexpr size_t WS_PROJ = 896 * MiB, WS_ACT = WS_PROJ;
constexpr size_t WS_LRU_HL = 1152 * MiB, WS_LRU_PC = 1216 * MiB;
constexpr size_t WS_ST = 1296 * MiB;
constexpr size_t WS_CLOC = WS_ST, WS_CST = WS_ST + 128 * MiB;
constexpr size_t WS_SLOC = WS_ST, WS_SST = WS_ST + 256 * MiB;
constexpr size_t WS_YBUF = WS_ST;
constexpr size_t WS_XC = 1680 * MiB, WS_QG = 1744 * MiB, WS_KG = 1808 * MiB, WS_VG = 1872 * MiB;
constexpr size_t WS_XBC = 1680 * MiB;
constexpr size_t WS_DTG = 1936 * MiB, WS_ACG = 1940 * MiB;
constexpr size_t WS_END = 1944 * MiB;
constexpr int CW_BAR = 4096;
constexpr int CW_CNT = 16384;

constexpr int LDS_BYTES = 163840;
constexpr int L_MISC = LDS_BYTES - 256;
constexpr int L_SCHED = 135168;
constexpr int RLD = 272;
constexpr int L_RAW = 0, L_T0 = 35840, L_T1 = 70656, L_T2 = 105472, L_SM = 140288;
constexpr int L_DT = L_T2 + 17408, L_AC = L_DT + 16384;

typedef __bf16 bf16v2_t __attribute__((ext_vector_type(2)));
typedef float f32x2_t __attribute__((ext_vector_type(2)));
__device__ __forceinline__ unsigned pk2(float lo, float hi) { const f32x2_t f = {lo, hi}; return __builtin_bit_cast(unsigned, __builtin_convertvector(f, bf16v2_t)); }
__device__ __forceinline__ unsigned f2bf(float f) { return (unsigned)__builtin_bit_cast(unsigned short, (__bf16)f); }
__device__ __forceinline__ float bf2f(unsigned h) { return __builtin_bit_cast(float, h << 16); }
__device__ __forceinline__ float frcp(float x) { return __builtin_amdgcn_rcpf(x); }
__device__ __forceinline__ float sigmoidf_(float x) { return frcp(1.0f + __expf(-x)); }
__device__ __forceinline__ float siluf_(float x) { return x * frcp(1.0f + __expf(-x)); }
__device__ __forceinline__ float softplusf_(float x) { return x > 20.0f ? x : log1pf(__expf(x)); }
__device__ __forceinline__ float logsigmoidf_(float x) { return fminf(x, 0.0f) - log1pf(__expf(-fabsf(x))); }
__device__ __forceinline__ float gelu_tanh(float x) { const float y = 0.7978845608028654f * (x + 0.044715f * x * x * x); const float t = 1.0f - 2.0f * frcp(__expf(2.0f * y) + 1.0f); return 0.5f * x * (1.0f + t); }
__device__ __forceinline__ unsigned pk4_fp8(float a, float b, float c, float d) { int p = __builtin_amdgcn_cvt_pk_fp8_f32(a, b, 0, false); p = __builtin_amdgcn_cvt_pk_fp8_f32(c, d, p, true); return (unsigned)p; }
#define MFMA16(a, b, c) __builtin_amdgcn_mfma_f32_16x16x32_bf16((a), (b), (c), 0, 0, 0)
#define LFRAG(base, row, kel) (*(const LAS bf16x8*)((base) + (row) * RLD + (kel) * 2))
__device__ __forceinline__ float wave_sum(float v) {
#pragma unroll
    for (int o = 1; o < 64; o <<= 1) v += __shfl_xor(v, o);
    return v;
}
__device__ __forceinline__ float red16(float v) { v += __shfl_xor(v, 1); v += __shfl_xor(v, 2); v += __shfl_xor(v, 4); v += __shfl_xor(v, 8); return v; }

#define XB_TMO      128
#define XB_XCNT(j)  (256  + 64 * (j))
#define XB_XSUB(j)  (1280 + 64 * (j))
#define XB_XGEN(j)  (2304 + 64 * (j))
#define XB_TOP      3328
#define XB_TOPGEN   3392
#define XCD_BAR_WORDS 3456
#define XB_SPIN_CAP (1u << 18)
__device__ __forceinline__ unsigned xb_ld(unsigned* p)              { return __hip_atomic_load(p, __ATOMIC_RELAXED, __HIP_MEMORY_SCOPE_AGENT); }
__device__ __forceinline__ unsigned xb_add(unsigned* p, unsigned v) { return __hip_atomic_fetch_add(p, v, __ATOMIC_RELAXED, __HIP_MEMORY_SCOPE_AGENT); }
__device__ __forceinline__ unsigned xb_xcc_id() { return (unsigned)__builtin_amdgcn_s_getreg((3 << 11) | 20) & 0xFu; }
#define XB_SPIN(cond, bar) do { unsigned _sp = 0; while (cond) { __builtin_amdgcn_s_sleep(1); \
    if ((++_sp & 255u) == 0u) { if (xb_ld(&(bar)[XB_TMO])) break; if (_sp > XB_SPIN_CAP) { atomicAdd(&(bar)[XB_TMO], 1u); break; } } } } while (0)
struct XcdBarrier { unsigned* bar; unsigned x; volatile LAS unsigned* st; };
__device__ __forceinline__ XcdBarrier xcd_barrier_post(unsigned* bar, volatile LAS unsigned* st) {
    XcdBarrier b; b.bar = bar; b.x = xb_xcc_id(); b.st = st;
    if (threadIdx.x == 0) (void)xb_add(&bar[XB_XCNT(b.x)], 1u);
    return b;
}
__device__ __forceinline__ void xcd_barrier_complete(unsigned* bar, unsigned x, unsigned& nloc, unsigned& nx) {
    const unsigned G = gridDim.x * gridDim.y * gridDim.z;
    unsigned sum, cnt, mine, sp = 0u;
    for (;;) {
        sum = 0u; cnt = 0u; mine = 0u;
#pragma unroll
        for (unsigned j = 0; j < 16; ++j) { const unsigned c = xb_ld(&bar[XB_XCNT(j)]); sum += c; cnt += (c > 0u) ? 1u : 0u; mine = (j == x) ? c : mine; }
        if (sum == G) break;
        __builtin_amdgcn_s_sleep(1);
        if ((++sp & 255u) == 0u) { if (xb_ld(&bar[XB_TMO])) break; if (sp > XB_SPIN_CAP) { atomicAdd(&bar[XB_TMO], 1u); break; } }
    }
    nloc = mine > 0u ? mine : 1u; nx = cnt > 0u ? cnt : 1u;
}
__device__ __forceinline__ void xcd_barrier(const XcdBarrier& b) {
    asm volatile("s_waitcnt vmcnt(0)" ::: "memory");
    __syncthreads();
    if (threadIdx.x == 0) {
        unsigned* bar = b.bar;
        __builtin_amdgcn_s_waitcnt(0);
        unsigned nloc = b.st[0], nx = b.st[1];
        if (nloc == 0u) { xcd_barrier_complete(bar, b.x, nloc, nx); b.st[0] = nloc; b.st[1] = nx; }
        const unsigned old = xb_add(&bar[XB_XSUB(b.x)], 1u);
        const unsigned gen = old / nloc;
        if (old + 1u == (gen + 1u) * nloc) {
            __builtin_amdgcn_fence(__ATOMIC_RELEASE, "agent");
            asm volatile("s_waitcnt vmcnt(0)" ::: "memory");
            const unsigned og = xb_add(&bar[XB_TOP], 1u);
            const unsigned tg = og / nx;
            if (og + 1u == (tg + 1u) * nx) xb_add(&bar[XB_TOPGEN], 1u);
            else XB_SPIN(xb_ld(&bar[XB_TOPGEN]) == tg, bar);
            __builtin_amdgcn_fence(__ATOMIC_ACQUIRE, "agent");
            xb_add(&bar[XB_XGEN(b.x)], 1u);
            asm volatile("s_waitcnt vmcnt(0)" ::: "memory");
        } else {
            XB_SPIN(xb_ld(&bar[XB_XGEN(b.x)]) == gen, bar);
            __builtin_amdgcn_fence(__ATOMIC_ACQUIRE, "agent");
            asm volatile("s_waitcnt vmcnt(0)" ::: "memory");
        }
    }
    __syncthreads();
}

struct Args { const float* in[41]; float* out; unsigned char* ws; int ph_lo, ph_hi; };
struct InTab { const float* const* p; __device__ __forceinline__ const GAS float* operator[](int k) const { return (const GAS float*)p[k]; } };
__device__ __forceinline__ const GAS float* uptr(const GAS float* p) { const unsigned long long v = (unsigned long long)p; const unsigned lo = __builtin_amdgcn_readfirstlane((unsigned)v), hi = __builtin_amdgcn_readfirstlane((unsigned)(v >> 32)); return (const GAS float*)(((unsigned long long)hi << 32) | lo); }
struct PArgs { InTab in; };
struct Frame { LAS unsigned char* lds; int tid, lane, wave, G, bid; unsigned char* ws; unsigned* ctl; };
__device__ __forceinline__ Frame relaunder(const Frame& F0) { Frame F = F0; int tz = F0.tid; asm volatile("" : "+v"(tz)); F.tid = tz; F.lane = tz & 63; F.wave = __builtin_amdgcn_readfirstlane(tz >> 6); return F; }
extern __shared__ __attribute__((aligned(16))) unsigned char lds_nl[];
__device__ __forceinline__ Frame make_frame(unsigned char* ws) { Frame F; F.lds = (LAS unsigned char*)lds_nl; F.tid = threadIdx.x; F.lane = F.tid & 63; F.wave = __builtin_amdgcn_readfirstlane(F.tid >> 6); F.G = gridDim.x; F.bid = blockIdx.x; F.ws = ws; F.ctl = (unsigned*)(ws + WS_CTL); return F; }

namespace pg8 {
constexpr int BM = 256, BK = 64, HALF = 128, HTB = HALF * BK * 2, STAGE_BYTES = 8 * HTB, NXCD = 8, WGM = 8;
__host__ __device__ __forceinline__ int lds_byte(int r, int c) { const int ch = c >> 3; return (r >> 3) * 1024 + (r & 7) * 128 + ((ch ^ (r & 7)) << 4) + (c & 7) * 2; }
__host__ __device__ __forceinline__ void stage_rc(int b, int& R, int& C) { const int piece = b >> 10, rip = (b >> 7) & 7, slot = (b >> 4) & 7; R = piece * 8 + rip; C = ((slot ^ rip) << 3); }
__host__ __device__ __forceinline__ int perm32(int rho) { const int n = rho >> 4, i = rho & 15; return 8 * (i >> 2) + 4 * n + (i & 3); }
__device__ __forceinline__ unsigned cvt_pk_bf16(float lo, float hi) { return pk2(lo, hi); }

struct Unit { int pm, pn, e, valid, rowbase; };

struct PlainSched {
    static constexpr bool GATHER = false;
    const bf16* A; const bf16* Bt; int PB, nM, nN, nwg, G, c;
    __device__ void init(const void* A_, const void* Bt_, int M, int N, int K_, int G_, int c_, int elem_bytes = 2) { A = (const bf16*)A_; Bt = (const bf16*)Bt_; PB = elem_bytes * K_; nM = M / BM; nN = N / BM; nwg = nM * nN; G = G_; c = c_; }
    __device__ __forceinline__ bool next(int i, Unit& u) const {
        const long L = (long)i * G + c; if (L >= nwg) return false;
        int wgid = (int)L; { const int q = nwg / NXCD, r = nwg % NXCD, xcd = wgid % NXCD, off = wgid / NXCD; wgid = (xcd < r ? xcd * (q + 1) : r * (q + 1) + (xcd - r) * q) + off; }
        const int nig = WGM * nN, gid = wgid / nig, fm = gid * WGM, gsz = (nM - fm) < WGM ? (nM - fm) : WGM;
        u.pm = fm + ((wgid % nig) % gsz); u.pn = (wgid % nig) / gsz; u.e = 0; u.valid = 256; u.rowbase = u.pm * 256; return true;
    }
    __device__ __forceinline__ const char* abase(const Unit& u) const { return (const char*)A + (size_t)u.pm * 256 * PB; }
    __device__ __forceinline__ const char* bbase(const Unit& u) const { return (const char*)Bt + (size_t)u.pn * 256 * PB; }
};
template <bool GATHER_, int NT_  , int MB_  >
struct MoeSched {
    static constexpr bool GATHER = GATHER_;
    const void* A; const void* Bt; const int* rowtok; int PB, G, c, ntiles; const LAS int* tab; size_t bstride;
    __device__ __forceinline__ bool next(int i, Unit& u) const {
        int blk, j;
        if (G == 256) { blk = i * 8 + (c & 7); j = c >> 3; } else { const long U = (long)i * G + c; blk = (int)(U >> 5); j = (int)(U & 31); }
        const int nblk = (ntiles + MB_ - 1) / MB_;
        if (blk >= nblk) return false;
        const int mtg = blk * MB_ + (j % MB_); u.pn = j / MB_;
        if (mtg >= ntiles) { u.e = -1; u.pm = 0; u.valid = 0; u.rowbase = 0; return true; }
        int e = 0;
#pragma unroll 1
        for (int q = 1; q < 32; ++q) if (tab[65 + q] <= mtg) e = q;
        u.e = e; u.pm = mtg - tab[65 + e];
        const int cnt = tab[e]; const int v = cnt - u.pm * 256; u.valid = v < 256 ? v : 256; u.rowbase = tab[32 + e] + u.pm * 256; return true;
    }
    __device__ __forceinline__ const char* abase(const Unit& u) const { return GATHER_ ? (const char*)A : (const char*)A + (size_t)u.rowbase * PB; }
    __device__ __forceinline__ const char* bbase(const Unit& u) const { return (const char*)Bt + ((size_t)u.e * bstride + (size_t)u.pn * 256) * PB; }
};

struct EpiBf16 {
    static constexpr bool PERM = true;
    bf16* O; int ldc; float scale;
    __device__ __forceinline__ void operator()(const f32x4 (&acc)[2][2][4][2], const Unit& u, int wr, int wc, int fr, int fq) const {
        const int row0 = u.pm * BM + wr * 64 + fr, col0 = u.pn * BM + wc * 32 + 8 * fq;
#pragma unroll
        for (int ai = 0; ai < 2; ++ai)
#pragma unroll
            for (int m = 0; m < 4; ++m) { bf16* rowp = O + (size_t)(row0 + ai * HALF + m * 16) * ldc + col0;
#pragma unroll
                for (int bj = 0; bj < 2; ++bj) { const f32x4 v0 = acc[ai][bj][m][0] * scale, v1 = acc[ai][bj][m][1] * scale;
                    u32x4 w; w.x = cvt_pk_bf16(v0[0], v0[1]); w.y = cvt_pk_bf16(v0[2], v0[3]); w.z = cvt_pk_bf16(v1[0], v1[1]); w.w = cvt_pk_bf16(v1[2], v1[3]);
                    *(u32x4*)(rowp + bj * HALF) = w; } }
    }
};
template <bool HIN_F32>
struct EpiResid {
    static constexpr bool PERM = true;
    const GAS void* hin; bf16* out; const float* gvec;
    __device__ __forceinline__ void operator()(const f32x4 (&acc)[2][2][4][2], const Unit& u, int wr, int wc, int fr, int fq) const {
        const int row0 = u.pm * BM + wr * 64 + fr, col0 = u.pn * BM + wc * 32 + 8 * fq;
        const float* gb = gvec + (size_t)((u.pm * BM) / SEQ) * 6144 + col0;
        f32x4 gv[2][2];
#pragma unroll
        for (int bj = 0; bj < 2; ++bj)
#pragma unroll
            for (int n = 0; n < 2; ++n) gv[bj][n] = *(const f32x4*)(gb + bj * HALF + 4 * n);
#pragma unroll
        for (int ai = 0; ai < 2; ++ai)
#pragma unroll
            for (int m = 0; m < 4; ++m) { const size_t off = (size_t)(row0 + ai * HALF + m * 16) * D + col0;
#pragma unroll
                for (int bj = 0; bj < 2; ++bj) { f32x4 h0, h1;
                    if (HIN_F32) { h0 = *(const GAS f32x4*)((const GAS float*)hin + off + bj * HALF); h1 = *(const GAS f32x4*)((const GAS float*)hin + off + bj * HALF + 4); }
                    else { const u32x4 hw = *(const GAS u32x4*)((const GAS bf16*)hin + off + bj * HALF); h0 = (f32x4){bf2f(hw.x & 0xffffu), bf2f(hw.x >> 16), bf2f(hw.y & 0xffffu), bf2f(hw.y >> 16)}; h1 = (f32x4){bf2f(hw.z & 0xffffu), bf2f(hw.z >> 16), bf2f(hw.w & 0xffffu), bf2f(hw.w >> 16)}; }
                    const f32x4 v0 = h0 + gv[bj][0] * acc[ai][bj][m][0], v1 = h1 + gv[bj][1] * acc[ai][bj][m][1];
                    u32x4 w; w.x = cvt_pk_bf16(v0[0], v0[1]); w.y = cvt_pk_bf16(v0[2], v0[3]); w.z = cvt_pk_bf16(v1[0], v1[1]); w.w = cvt_pk_bf16(v1[2], v1[3]);
                    *(u32x4*)(out + off + bj * HALF) = w; } }
    }
};
constexpr float WSCALE8 = 32.0f, WINV8 = 1.0f / 32.0f;
struct EpiSwiglu {
    static constexpr bool PERM = true;
    unsigned char* act; const GAS float* bgu; unsigned char* sink;
    __device__ __forceinline__ void operator()(const f32x4 (&acc)[2][2][4][2], const Unit& u, int wr, int wc, int fr, int fq) const {
        const int cc = u.pn * 128 + wc * 32 + 8 * fq;
        const GAS float* bb = bgu + (size_t)u.e * 2048 + cc;
        const f32x4 bg0 = *(const f32x4*)(bb), bg1 = *(const f32x4*)(bb + 4), bl0 = *(const f32x4*)(bb + 1024), bl1 = *(const f32x4*)(bb + 1028);
#pragma unroll
        for (int ai = 0; ai < 2; ++ai)
#pragma unroll
            for (int m = 0; m < 4; ++m) { const int r = ai * HALF + wr * 64 + m * 16 + fr;
                float o[8];
#pragma unroll
                for (int n = 0; n < 2; ++n)
#pragma unroll
                    for (int j = 0; j < 4; ++j) { float g = acc[ai][0][m][n][j] * WINV8 + (n ? bg1[j] : bg0[j]); float li = acc[ai][1][m][n][j] * WINV8 + (n ? bl1[j] : bl0[j]);
                        g = fminf(g, 7.0f); li = fminf(fmaxf(li, -7.0f), 7.0f);
                        o[n * 4 + j] = g * __builtin_amdgcn_rcpf(1.0f + __expf(-1.702f * g)) * (li + 1.0f); }
                u32x2 w; w.x = pk4_fp8(o[0], o[1], o[2], o[3]); w.y = pk4_fp8(o[4], o[5], o[6], o[7]);
                unsigned char* dst = (r < u.valid) ? act + (size_t)(u.rowbase + r) * DFF + cc : sink;
                *(u32x2*)dst = w; }
    }
};
constexpr float YSCALE8 = 16.0f, YINV8 = 1.0f / 16.0f;
struct EpiDown {
    static constexpr bool PERM = true;
    unsigned char* y; const GAS float* bdn; const float* rowgate; unsigned char* sink;
    __device__ __forceinline__ void operator()(const f32x4 (&acc)[2][2][4][2], const Unit& u, int wr, int wc, int fr, int fq) const {
        const int col0 = u.pn * BM + wc * 32 + 8 * fq;
        const GAS float* bb = bdn + (size_t)u.e * D + col0;
        f32x4 bv[2][2];
#pragma unroll
        for (int bj = 0; bj < 2; ++bj)
#pragma unroll
            for (int n = 0; n < 2; ++n) bv[bj][n] = *(const f32x4*)(bb + bj * HALF + 4 * n);
        const float* gp = rowgate + (size_t)u.e * ECAP + u.pm * 256 + wr * 64 + fr;
        float gts[2][4];
#pragma unroll
        for (int ai = 0; ai < 2; ++ai)
#pragma unroll
            for (int m = 0; m < 4; ++m) gts[ai][m] = gp[ai * HALF + m * 16];
#pragma unroll
        for (int ai = 0; ai < 2; ++ai)
#pragma unroll
            for (int m = 0; m < 4; ++m) { const int r = ai * HALF + wr * 64 + m * 16 + fr; const float gt = gts[ai][m] * YSCALE8; unsigned char* rowp = y + (size_t)(u.rowbase + r) * D + col0;
#pragma unroll
                for (int bj = 0; bj < 2; ++bj) { const f32x4 v0 = (acc[ai][bj][m][0] * WINV8 + bv[bj][0]) * gt, v1 = (acc[ai][bj][m][1] * WINV8 + bv[bj][1]) * gt;
                    u32x2 w; w.x = pk4_fp8(v0[0], v0[1], v0[2], v0[3]); w.y = pk4_fp8(v1[0], v1[1], v1[2], v1[3]);
                    *(u32x2*)((r < u.valid) ? rowp + bj * HALF : sink + 8 * bj) = w; } }
    }
};

template <class Epi, class Sched, bool FP8 = false>
__device__ __forceinline__ void gemm_phase(LAS unsigned char* lds, const Sched& S, const Epi& E) {
    const int tid = threadIdx.x, wid = __builtin_amdgcn_readfirstlane(tid >> 6), lane = tid & 63, wr = wid >> 2, wc = wid & 3, fr = lane & 15, fq = lane >> 4;
    const int PB = S.PB, nt = PB / 128;
    unsigned voffB[2], voffA0[2];
#pragma unroll
    for (int i = 0; i < 2; ++i) { int R, C; stage_rc(tid * 16 + i * 8192, R, C); const int Rb = Epi::PERM ? ((R & ~31) + perm32(R & 31)) : R;
        voffA0[i] = (unsigned)(R * PB + 2 * C); voffB[i] = (unsigned)(Rb * PB + 2 * C); }
    const size_t kstep = (size_t)(BK * 2);
    const size_t hstep = (size_t)HALF * PB;
    const unsigned ldsw = (unsigned)wid * 1024u;
    const int aoff0 = FP8 ? lds_byte(wr * 64 + fr, 16 * fq) : lds_byte(wr * 64 + fr, fq * 8), boff0 = FP8 ? lds_byte(wc * 32 + fr, 16 * fq) : lds_byte(wc * 32 + fr, fq * 8);
    const int aoff1 = FP8 ? lds_byte(wr * 64 + fr, 16 * fq + 8) : lds_byte(wr * 64 + fr, fq * 8 + 32), boff1 = FP8 ? lds_byte(wc * 32 + fr, 16 * fq + 8) : lds_byte(wc * 32 + fr, fq * 8 + 32);
#define PG8_SA(b, h) (((b) * 2 + (h)) * HTB)
#define PG8_SB(b, h) ((4 + (b) * 2 + (h)) * HTB)
#define PG8_STAGE(bufoff, gbase, voff) do { _Pragma("unroll") for (int _i = 0; _i < 2; ++_i) \
        __builtin_amdgcn_global_load_lds((const unsigned*)((const char*)(gbase) + (voff)[_i]), (LAS unsigned*)(lds + (bufoff) + ldsw + _i * 8192), 16, 0, 0); } while (0)
#define PG8_LDA(dst, b, h) do { _Pragma("unroll") for (int m = 0; m < 4; ++m) { const i32x4 _l0 = *(const LAS i32x4*)(lds + PG8_SA(b, h) + aoff0 + m * 2048), _l1 = *(const LAS i32x4*)(lds + PG8_SA(b, h) + aoff1 + m * 2048); \
        dst[m] = __builtin_shufflevector(_l0, _l1, 0, 1, 2, 3, 4, 5, 6, 7); } } while (0)
#define PG8_LDB(dst, b, h) do { _Pragma("unroll") for (int n = 0; n < 2; ++n) { const i32x4 _l0 = *(const LAS i32x4*)(lds + PG8_SB(b, h) + boff0 + n * 2048), _l1 = *(const LAS i32x4*)(lds + PG8_SB(b, h) + boff1 + n * 2048); \
        dst[n] = __builtin_shufflevector(_l0, _l1, 0, 1, 2, 3, 4, 5, 6, 7); } } while (0)
#define PG8_MMA(ai, bj, At, Bt) do { __builtin_amdgcn_s_setprio(1); _Pragma("unroll") for (int m = 0; m < 4; ++m) _Pragma("unroll") for (int n = 0; n < 2; ++n) { \
        if constexpr (FP8) { asm volatile("v_mfma_scale_f32_16x16x128_f8f6f4 %0, %1, %2, %0, %3, %3 op_sel_hi:[0,0,0]" : "+v"(acc[ai][bj][m][n]) : "v"(Bt[n]), "v"(At[m]), "v"(scl8)); } \
        else { acc[ai][bj][m][n] = __builtin_amdgcn_mfma_f32_16x16x32_bf16(__builtin_bit_cast(bf16x8, __builtin_shufflevector(Bt[n], Bt[n], 0, 1, 2, 3)), __builtin_bit_cast(bf16x8, __builtin_shufflevector(At[m], At[m], 0, 1, 2, 3)), acc[ai][bj][m][n], 0, 0, 0); \
               acc[ai][bj][m][n] = __builtin_amdgcn_mfma_f32_16x16x32_bf16(__builtin_bit_cast(bf16x8, __builtin_shufflevector(Bt[n], Bt[n], 4, 5, 6, 7)), __builtin_bit_cast(bf16x8, __builtin_shufflevector(At[m], At[m], 4, 5, 6, 7)), acc[ai][bj][m][n], 0, 0, 0); } } \
        __builtin_amdgcn_s_setprio(0); } while (0)
#define PG8_WAIT_V(n) asm volatile("s_waitcnt vmcnt(" #n ")" ::: "memory")
#define PG8_WAIT_L(n) asm volatile("s_waitcnt lgkmcnt(" #n ")" ::: "memory")
#define PG8_BAR __builtin_amdgcn_s_barrier()
#define PG8_SCHED __builtin_amdgcn_sched_barrier(0)
#define PG8_AOFFS(u, dst) do { if constexpr (Sched::GATHER) { int _tz = threadIdx.x; asm volatile("" : "+v"(_tz)); _Pragma("unroll") for (int _h = 0; _h < 2; ++_h) _Pragma("unroll") for (int _i = 0; _i < 2; ++_i) { \
            int _R, _C; stage_rc(_tz * 16 + _i * 8192, _R, _C); const int _r = _h * HALF + _R; const int _tk = S.rowtok[(size_t)(u).e * ECAP + (u).pm * 256 + (_r < (u).valid ? _r : (u).valid - 1)]; dst[_h][_i] = (unsigned)(_tk * PB + 2 * _C); } } \
        else { _Pragma("unroll") for (int _i = 0; _i < 2; ++_i) { dst[0][_i] = voffA0[_i]; dst[1][_i] = voffA0[_i] + (unsigned)hstep; } } } while (0)
    Unit cur, nxt; int ui = 0;
    for (;;) { if (!S.next(ui, cur)) return; if (cur.e >= 0) break; ++ui; }
    f32x4 acc[2][2][4][2];
#pragma unroll
    for (int a = 0; a < 2; ++a)
#pragma unroll
        for (int b = 0; b < 2; ++b)
#pragma unroll
            for (int m = 0; m < 4; ++m)
#pragma unroll
                for (int n = 0; n < 2; ++n) { acc[a][b][m][n] = (f32x4){0.f, 0.f, 0.f, 0.f}; asm volatile("" : "+v"(acc[a][b][m][n])); }
    unsigned scl8 = 0x7f7f7f7fu; asm volatile("" : "+v"(scl8));
    i32x8 At[4], B0[2], B1[2];
    const char* cA = S.abase(cur); const char* cB = S.bbase(cur);
    unsigned cO[2][2];
    PG8_AOFFS(cur, cO);
    PG8_STAGE(PG8_SB(0, 0), cB, voffB); PG8_STAGE(PG8_SB(0, 1), cB + hstep, voffB); PG8_STAGE(PG8_SA(0, 0), cA, cO[0]); PG8_STAGE(PG8_SA(0, 1), cA, cO[1]);
    if (wr == 1) PG8_BAR;
    PG8_WAIT_V(2); PG8_BAR;
    PG8_STAGE(PG8_SB(1, 0), cB + kstep, voffB); PG8_STAGE(PG8_SA(1, 0), cA + kstep, cO[0]); PG8_STAGE(PG8_SB(1, 1), cB + hstep + kstep, voffB);
    PG8_WAIT_V(6); PG8_BAR;
    for (;;) {
        int uj = ui + 1; bool has_next;
        for (;;) { has_next = S.next(uj, nxt); if (!has_next || nxt.e >= 0) break; ++uj; }
        const char* nA = has_next ? S.abase(nxt) : cA; const char* nB = has_next ? S.bbase(nxt) : cB;
        unsigned nO[2][2];
#pragma unroll
        for (int h = 0; h < 2; ++h)
#pragma unroll
            for (int i = 0; i < 2; ++i) nO[h][i] = cO[h][i];
        if (has_next) { PG8_AOFFS(nxt, nO); }
#pragma unroll 1
        for (int t = 0; t < nt; t += 2) {
            const bool last = (t == nt - 2);
            const char* a1 = cA + (size_t)(t + 1) * kstep;
            const char* a2 = last ? nA : cA + (size_t)(t + 2) * kstep; const char* b2 = last ? nB : cB + (size_t)(t + 2) * kstep;
            const char* a3 = a2 + kstep; const char* b3 = b2 + kstep;
            PG8_LDB(B0, 0, 0); PG8_LDB(B1, 0, 1); PG8_SCHED; PG8_LDA(At, 0, 0); PG8_STAGE(PG8_SA(1, 1), a1, cO[1]);
            if (last) {
#pragma unroll
                for (int h = 0; h < 2; ++h)
#pragma unroll
                    for (int i = 0; i < 2; ++i) cO[h][i] = nO[h][i]; }
            PG8_WAIT_V(8); PG8_WAIT_L(0); PG8_BAR; PG8_MMA(0, 0, At, B0); PG8_MMA(0, 1, At, B1); PG8_BAR; PG8_SCHED;
            PG8_LDA(At, 0, 1); PG8_STAGE(PG8_SB(0, 0), b2, voffB); PG8_STAGE(PG8_SB(0, 1), b2 + hstep, voffB); PG8_STAGE(PG8_SA(0, 0), a2, cO[0]);
            PG8_WAIT_V(8); PG8_WAIT_L(0); PG8_BAR; PG8_MMA(1, 0, At, B0); PG8_MMA(1, 1, At, B1); PG8_BAR; PG8_SCHED;
            PG8_LDB(B0, 1, 0); PG8_LDB(B1, 1, 1); PG8_SCHED; PG8_LDA(At, 1, 0); PG8_STAGE(PG8_SA(0, 1), a2, cO[1]);
            PG8_WAIT_V(8); PG8_WAIT_L(0); PG8_BAR; PG8_MMA(0, 0, At, B0); PG8_MMA(0, 1, At, B1); PG8_BAR; PG8_SCHED;
            PG8_LDA(At, 1, 1); PG8_STAGE(PG8_SB(1, 0), b3, voffB); PG8_STAGE(PG8_SB(1, 1), b3 + hstep, voffB); PG8_STAGE(PG8_SA(1, 0), a3, cO[0]);
            PG8_WAIT_V(8); PG8_WAIT_L(0); PG8_BAR; PG8_MMA(1, 0, At, B0); PG8_MMA(1, 1, At, B1); PG8_BAR; PG8_SCHED;
        }
        if (wr == 0) PG8_BAR;
        if constexpr (FP8) asm volatile("s_nop 15\n\ts_nop 15" ::: "memory");
        { int tz = threadIdx.x; asm volatile("" : "+v"(tz));
          const int wid2 = tz >> 6, lane2 = tz & 63; E(acc, cur, wid2 >> 2, wid2 & 3, lane2 & 15, lane2 >> 4); }
        if (!has_next) break;
#pragma unroll
        for (int a = 0; a < 2; ++a)
#pragma unroll
            for (int b = 0; b < 2; ++b)
#pragma unroll
                for (int m = 0; m < 4; ++m)
#pragma unroll
                    for (int n = 0; n < 2; ++n) { acc[a][b][m][n] = (f32x4){0.f, 0.f, 0.f, 0.f}; asm volatile("" : "+v"(acc[a][b][m][n])); }
        cur = nxt; cA = nA; cB = nB; ui = uj;
        if (wr == 1) PG8_BAR;
    }
    PG8_WAIT_V(0);
    PG8_BAR;
#undef PG8_SA
#undef PG8_SB
#undef PG8_STAGE
#undef PG8_LDA
#undef PG8_LDB
#undef PG8_MMA
#undef PG8_WAIT_V
#undef PG8_WAIT_L
#undef PG8_BAR
#undef PG8_SCHED
#undef PG8_AOFFS
}
}

__device__ __forceinline__ void transpose_item(const float* W, int K, int N, bf16* WT, int dst_row0, LAS float* scr, int k0, int n0, int lane) {
#pragma unroll 8
    for (int i = 0; i < 32; ++i) { const int kk = 2 * i + (lane >> 5); scr[kk * 33 + (lane & 31)] = W[(size_t)(k0 + kk) * N + n0 + (lane & 31)]; }
    asm volatile("s_waitcnt lgkmcnt(0)" ::: "memory");
    const int c = lane & 7;
#pragma unroll
    for (int j = 0; j < 4; ++j) { const int n = (lane >> 3) + 8 * j; const LAS float* s = scr + (8 * c) * 33 + n;
        u32x4 o; o.x = pk2(s[0 * 33], s[1 * 33]); o.y = pk2(s[2 * 33], s[3 * 33]); o.z = pk2(s[4 * 33], s[5 * 33]); o.w = pk2(s[6 * 33], s[7 * 33]);
        *(u32x4*)(WT + (size_t)(dst_row0 + n) * K + k0 + 8 * c) = o; }
    asm volatile("s_waitcnt lgkmcnt(0)" ::: "memory");
}
__device__ __forceinline__ void transpose_item_fp8(const float* W, int K, int N, unsigned char* WT, int dst_row0, LAS float* scr, int k0, int n0, int lane) {
#pragma unroll 8
    for (int i = 0; i < 32; ++i) { const int kk = 2 * i + (lane >> 5); scr[kk * 33 + (lane & 31)] = W[(size_t)(k0 + kk) * N + n0 + (lane & 31)] * pg8::WSCALE8; }
    asm volatile("s_waitcnt lgkmcnt(0)" ::: "memory");
    const int c = lane & 7;
#pragma unroll
    for (int j = 0; j < 4; ++j) { const int n = (lane >> 3) + 8 * j; const LAS float* s = scr + (8 * c) * 33 + n;
        u32x2 o; o.x = pk4_fp8(s[0 * 33], s[1 * 33], s[2 * 33], s[3 * 33]); o.y = pk4_fp8(s[4 * 33], s[5 * 33], s[6 * 33], s[7 * 33]);
        *(u32x2*)(WT + (size_t)(dst_row0 + n) * K + k0 + 8 * c) = o; }
    asm volatile("s_waitcnt lgkmcnt(0)" ::: "memory");
}
__device__ __forceinline__ void ph_prep(const Args& a, Frame& F) {
    if (F.bid == 0 && F.tid == 0) { const float** tab = (const float**)(F.ws + WS_ARGTAB);
#pragma unroll
        for (int i = 0; i < 41; ++i) tab[i] = a.in[i];
        tab[41] = a.out; }
    LAS float* scr = (LAS float*)(F.lds + F.wave * 16384);
    const int gw = F.bid * NWAVES + F.wave, NGW = F.G * NWAVES, lane = F.lane;
    unsigned char* ws = F.ws;
    {
        const float* cin = a.in[1]; const float* mw = a.in[2]; float* modp = (float*)(ws + WS_MODP);
        for (int it = gw; it < 2 * 96 * 16; it += NGW) {
            const int l = it / 1536, rem = it % 1536, cb = rem / 16, ks = rem % 16, col = cb * 64 + lane;
#pragma unroll
            for (int b = 0; b < 8; ++b) { const float cv = cin[b * D + ks * 64 + lane]; scr[b * 64 + lane] = siluf_(cv); }
            asm volatile("s_waitcnt lgkmcnt(0)" ::: "memory");
            float acc[8];
#pragma unroll
            for (int b = 0; b < 8; ++b) acc[b] = 0.f;
            const float* wp = mw + ((size_t)l * D + ks * 64) * 6144 + col;
#pragma unroll 8
            for (int k = 0; k < 64; ++k) { const float w = wp[(size_t)k * 6144];
#pragma unroll
                for (int b = 0; b < 8; ++b) acc[b] += scr[b * 64 + k] * w; }
#pragma unroll
            for (int b = 0; b < 8; ++b) modp[(size_t)((ks * 2 + l) * 8 + b) * 6144 + col] = acc[b];
            asm volatile("s_waitcnt lgkmcnt(0)" ::: "memory");
        }
    }
    {
        constexpr int I_EVIN = 16 * 128, I_EVOUT = 32 * 32, I_ODIN = 16 * 193, I_ODOUT = 32 * 32, I_GU = 64 * 1024, I_DN = 64 * 512, I_LRU = 16 * 8;
        constexpr int NIT = I_EVIN + I_EVOUT + I_ODIN + I_ODOUT + I_GU + I_DN + I_LRU;
        for (int it = gw; it < NIT; it += NGW) {
            int r = it;
            if (r < I_EVIN) { const int kb = r / 128, nb = r % 128; transpose_item(a.in[6], D, EVEN_IN, (bf16*)(ws + WS_WEVIN), 32 * nb, scr, 64 * kb, 32 * nb, lane); continue; } r -= I_EVIN;
            if (r < I_EVOUT) { const int kb = r / 32, nb = r % 32; transpose_item(a.in[25], MIXW, D, (bf16*)(ws + WS_WEVOUT), 32 * nb, scr, 64 * kb, 32 * nb, lane); continue; } r -= I_EVOUT;
            if (r < I_ODIN) { const int kb = r / 193, nb = r % 193; transpose_item_fp8(a.in[26], D, OD_IN, (unsigned char*)(ws + WS_WODIN), 32 * nb, scr, 64 * kb, 32 * nb, lane); continue; } r -= I_ODIN;
            if (r < I_ODOUT) { const int kb = r / 32, nb = r % 32; transpose_item(a.in[33], MIXW, D, (bf16*)(ws + WS_WODOUT), 32 * nb, scr, 64 * kb, 32 * nb, lane); continue; } r -= I_ODOUT;
            if (r < I_GU) { const int mat = r / 1024, rr = r % 1024, kb = rr / 64, nb = rr % 64, n0 = 32 * nb;
                const int drow = n0 < 1024 ? (n0 / 128) * 256 + (n0 % 128) : ((n0 - 1024) / 128) * 256 + 128 + ((n0 - 1024) % 128);
                transpose_item_fp8(a.in[36] + (size_t)mat * D * 2048, D, 2048, (unsigned char*)(ws + WS_WGU) + (size_t)mat * 2048 * D, drow, scr, 64 * kb, n0, lane); continue; } r -= I_GU;
            if (r < I_DN) { const int mat = r / 512, rr = r % 512, kb = rr / 32, nb = rr % 32;
                transpose_item_fp8(a.in[38] + (size_t)mat * DFF * D, DFF, D, (unsigned char*)(ws + WS_WDN) + (size_t)mat * D * DFF, 32 * nb, scr, 64 * kb, 32 * nb, lane); continue; } r -= I_DN;
            { const int mat = r / 8, rr = r % 8, kb = rr / 4, nb = rr % 4, which = mat / 8, h = mat % 8;
                transpose_item((which ? a.in[11] : a.in[9]) + (size_t)h * 128 * 128, 128, 128, (bf16*)(ws + WS_LRUW) + (size_t)(which * 8 + h) * 128 * 128, 32 * nb, scr, 64 * kb, 32 * nb, lane); }
        }
    }
    {
        const size_t gt = (size_t)F.bid * NTHR + F.tid, NT = (size_t)F.G * NTHR;
        u32x4* z = (u32x4*)((unsigned char*)(ws + WS_WODIN) + (size_t)OD_IN * D);
        for (size_t i = gt; i < (size_t)(OD_INP - OD_IN) * D / 16; i += NT) z[i] = (u32x4){0u, 0u, 0u, 0u};
        bf16* gwt = (bf16*)(ws + WS_GATEW);
        for (size_t i = gt; i < 16 * 1024; i += NT) { const int j = (int)(i / 1024), cch = (int)(i % 1024), n = cch >> 2, d = cch & 3, jj = j & 7; const float* Wg = (j < 8 ? a.in[19] : a.in[21]);
            float sc = 0.f, sb = 0.f;
#pragma unroll
            for (int e = 0; e < 4; ++e) { sc += a.in[16][(n * 4 + d) * 4 + e] * Wg[(size_t)(4 * n + e) * 8 + jj] + a.in[17][(n * 4 + d) * 4 + e] * Wg[(size_t)(1024 + 4 * n + e) * 8 + jj];
                sb += a.in[18][(n * 4 + d) * 4 + e] * Wg[(size_t)(2048 + 4 * n + e) * 8 + jj]; }
            gwt[i] = (bf16)f2bf(sc); gwt[16 * 1024 + i] = (bf16)f2bf(sb); }
        bf16* rw = (bf16*)(ws + WS_ROUTW);
        for (size_t i = gt; i < 2 * 32 * 1024; i += NT) { const int l = (int)(i / 32768), e = (int)((i / 1024) % 32), k = (int)(i % 1024);
            const float v = a.in[34][((size_t)l * D + k) * 32 + e]; const unsigned hi = f2bf(v); const unsigned lo = f2bf(v - bf2f(hi));
            rw[((size_t)(l * 2 + 0) * 32 + e) * 1024 + k] = (bf16)hi; rw[((size_t)(l * 2 + 1) * 32 + e) * 1024 + k] = (bf16)lo; }
    }
}

template <int MODE>
__device__ __forceinline__ void ph_rows(const PArgs& a, Frame& F, int l  ) {
    unsigned char* ws = F.ws;
    LAS float* gm = (LAS float*)(F.lds); LAS float* ga = (LAS float*)(F.lds + 4096); LAS float* gf = (LAS float*)(F.lds + 8192); LAS int* offs = (LAS int*)(F.lds + 12288);
    const float* modp = (const float*)(ws + WS_MODP); float* modf = (float*)(ws + WS_MODF);
    if (MODE == 0) {
        for (size_t i = (size_t)F.bid * NTHR + F.tid; i < 2 * 8 * 6144; i += (size_t)F.G * NTHR) { const int l2 = (int)(i / 49152), b = (int)((i / 6144) % 8), n = (int)(i % 6144);
            float s = a.in[3][l2 * 6144 + n];
#pragma unroll
            for (int ks = 0; ks < 16; ++ks) s += modp[(size_t)((ks * 2 + l2) * 8 + b) * 6144 + n];
            modf[i] = s; }
    }
    if (MODE != 0) { if (F.tid == 0) { int o = 0; for (int e = 0; e < NE; ++e) { offs[e] = o; o += (int)F.ctl[CW_CNT + l * 2048 + e * 64]; } } }
    const GAS float* xin = uptr(a.in[0]); const GAS float* xout = uptr(a.in[41]);
    for (int tile = F.bid; tile < MTOK / 128; tile += F.G) {
        const int b = (tile * 128) / SEQ;
        __syncthreads();
        for (int k = F.tid; k < D; k += NTHR) {
            if (MODE == 0) { float sh = a.in[3][k], sc = a.in[3][1024 + k];
#pragma unroll
                for (int ks = 0; ks < 16; ++ks) { const float* p = modp + (size_t)((ks * 2 + 0) * 8 + b) * 6144; sh += p[k]; sc += p[1024 + k]; }
                gm[k] = a.in[4][k] * (1.0f + sc); ga[k] = sh; }
            else if (MODE == 1) { const float* mf = modf + (size_t)((l + 1) * 8 + b) * 6144; gm[k] = a.in[4][(l + 1) * D + k] * (1.0f + mf[1024 + k]); ga[k] = mf[k]; gf[k] = modf[(size_t)(l * 8 + b) * 6144 + 5120 + k]; }
            else { gm[k] = a.in[40][k]; ga[k] = 0.f; gf[k] = modf[(size_t)(l * 8 + b) * 6144 + 5120 + k]; }
        }
        __syncthreads();
        int slotv = 0;
        if (MODE != 0) slotv = ((const int*)(ws + WS_TOKSLOT))[(size_t)(tile * 128 + F.wave * 16) * 4 + F.lane];
#pragma unroll 1
        for (int i = 0; i < 16; i += 2) {
            f32x4 v[2][4]; unsigned yw[2][4][4];
#pragma unroll
            for (int rr = 0; rr < 2; ++rr) { const int row = tile * 128 + F.wave * 16 + i + rr;
#pragma unroll
                for (int j = 0; j < 4; ++j) { if (MODE == 0) v[rr][j] = *(const GAS f32x4*)((const GAS unsigned char*)xin + (unsigned)(row * D + 4 * F.lane) * 4u + 1024 * j);
                    else { const u32x2 hw = *(const u32x2*)(ws + WS_H1 + (unsigned)(row * D + 4 * F.lane) * 2u + 512 * j); v[rr][j] = (f32x4){bf2f(hw.x & 0xffffu), bf2f(hw.x >> 16), bf2f(hw.y & 0xffffu), bf2f(hw.y >> 16)}; } }
                if (MODE != 0) {
#pragma unroll
                    for (int kk = 0; kk < 4; ++kk) { const int sl = __shfl(slotv, 4 * (i + rr) + kk); const int e = sl >> 15, pos = sl & 32767; const unsigned yr = (unsigned)(offs[e] + pos);
                        const unsigned char* yp = ws + WS_YBUF + (yr * (unsigned)D + 4u * (unsigned)F.lane);
#pragma unroll
                        for (int j = 0; j < 4; ++j) yw[rr][kk][j] = *(const unsigned*)(yp + 256 * j); } } }
#pragma unroll
            for (int rr = 0; rr < 2; ++rr) { const int row = tile * 128 + F.wave * 16 + i + rr;
                if (MODE != 0) {
#pragma unroll
                    for (int j = 0; j < 4; ++j) { f32x4 sm = (f32x4){0.f, 0.f, 0.f, 0.f};
#pragma unroll
                        for (int kk = 0; kk < 4; ++kk) { const int w = (int)yw[rr][kk][j]; sm[0] += __builtin_amdgcn_cvt_f32_fp8(w, 0); sm[1] += __builtin_amdgcn_cvt_f32_fp8(w, 1); sm[2] += __builtin_amdgcn_cvt_f32_fp8(w, 2); sm[3] += __builtin_amdgcn_cvt_f32_fp8(w, 3); }
                        const f32x4 g = *(const LAS f32x4*)(gf + 4 * F.lane + 256 * j); v[rr][j] = v[rr][j] + g * (sm * pg8::YINV8); }
                    if (MODE == 1) {
#pragma unroll
                        for (int j = 0; j < 4; ++j) { u32x2 hw; hw.x = pk2(v[rr][j][0], v[rr][j][1]); hw.y = pk2(v[rr][j][2], v[rr][j][3]); *(u32x2*)(ws + WS_H2 + (unsigned)(row * D + 4 * F.lane) * 2u + 512 * j) = hw; } }
                }
                float ss = 0.f;
#pragma unroll
                for (int j = 0; j < 4; ++j) ss += (v[rr][j][0] * v[rr][j][0] + v[rr][j][1] * v[rr][j][1]) + (v[rr][j][2] * v[rr][j][2] + v[rr][j][3] * v[rr][j][3]);
                const float rstd = __builtin_amdgcn_rsqf(wave_sum(ss) * (1.0f / D) + EPS);
#pragma unroll
                for (int j = 0; j < 4; ++j) { const f32x4 m = *(const LAS f32x4*)(gm + 4 * F.lane + 256 * j); const f32x4 ad = *(const LAS f32x4*)(ga + 4 * F.lane + 256 * j);
                    const f32x4 o = v[rr][j] * rstd * m + ad;
                    if (MODE == 2) *(GAS f32x4*)((GAS unsigned char*)xout + (unsigned)(row * D + 4 * F.lane) * 4u + 1024 * j) = o;
                    else if (MODE == 1) *(unsigned*)(ws + WS_U + (unsigned)(row * D + 4 * F.lane) + 256 * j) = pk4_fp8(o[0], o[1], o[2], o[3]);
                    else { u32x2 w; w.x = pk2(o[0], o[1]); w.y = pk2(o[2], o[3]); *(u32x2*)(ws + WS_U + (unsigned)(row * D + 4 * F.lane) * 2u + 512 * j) = w; } } }
        }
    }
}

__device__ __forceinline__ void ph_route(const PArgs& a, Frame& F, int l) {
    unsigned char* ws = F.ws;
    LAS float* gm = (LAS float*)(F.lds); LAS float* ga = (LAS float*)(F.lds + 4096); LAS float* LG = (LAS float*)(F.lds + 8192);
    LAS int* lcnt = (LAS int*)(F.lds + 25600); LAS int* lbase = (LAS int*)(F.lds + 25728);
    const float* modf = (const float*)(ws + WS_MODF); const bf16* h1 = (const bf16*)(ws + WS_H1);
    const bf16* rw = (const bf16*)(ws + WS_ROUTW) + (size_t)l * 2 * 32 * 1024;
    const int r = F.lane & 15, kg = F.lane >> 4;
    for (int tile = F.bid; tile < MTOK / 128; tile += F.G) {
        const int b = (tile * 128) / SEQ;
        __syncthreads();
        for (int k = F.tid; k < D; k += NTHR) { const float* mf = modf + (size_t)(l * 8 + b) * 6144; gm[k] = a.in[5][l * D + k] * (1.0f + mf[4096 + k]); ga[k] = mf[3072 + k]; }
        if (F.tid < 32) lcnt[F.tid] = 0;
        __syncthreads();
        const int row = tile * 128 + F.wave * 16 + r;
        const bf16* hp = h1 + (size_t)row * D + 8 * kg;
        float ss = 0.f;
#pragma unroll 4
        for (int s = 0; s < 32; ++s) { const u32x4 hw = *(const u32x4*)(hp + 32 * s);
            const f32x4 x0 = (f32x4){bf2f(hw.x & 0xffffu), bf2f(hw.x >> 16), bf2f(hw.y & 0xffffu), bf2f(hw.y >> 16)}, x1 = (f32x4){bf2f(hw.z & 0xffffu), bf2f(hw.z >> 16), bf2f(hw.w & 0xffffu), bf2f(hw.w >> 16)};
            ss += (x0[0] * x0[0] + x0[1] * x0[1]) + (x0[2] * x0[2] + x0[3] * x0[3]) + (x1[0] * x1[0] + x1[1] * x1[1]) + (x1[2] * x1[2] + x1[3] * x1[3]); }
        ss += __shfl_xor(ss, 16); ss += __shfl_xor(ss, 32);
        const float rstd = __builtin_amdgcn_rsqf(ss * (1.0f / D) + EPS);
        f32x4 acc[2]; acc[0] = (f32x4){0.f, 0.f, 0.f, 0.f}; acc[1] = acc[0];
        unsigned char* up = (unsigned char*)(ws + WS_U) + (size_t)row * D + 8 * kg;
#pragma unroll 2
        for (int s = 0; s < 32; ++s) {
            const u32x4 hw = *(const u32x4*)(hp + 32 * s);
            const f32x4 x0 = (f32x4){bf2f(hw.x & 0xffffu), bf2f(hw.x >> 16), bf2f(hw.y & 0xffffu), bf2f(hw.y >> 16)}, x1 = (f32x4){bf2f(hw.z & 0xffffu), bf2f(hw.z >> 16), bf2f(hw.w & 0xffffu), bf2f(hw.w >> 16)};
            const f32x4 m0 = *(const LAS f32x4*)(gm + 32 * s + 8 * kg), m1 = *(const LAS f32x4*)(gm + 32 * s + 8 * kg + 4);
            const f32x4 a0 = *(const LAS f32x4*)(ga + 32 * s + 8 * kg), a1 = *(const LAS f32x4*)(ga + 32 * s + 8 * kg + 4);
            const f32x4 u0 = x0 * rstd * m0 + a0, u1 = x1 * rstd * m1 + a1;
            bf16x8 ahi, alo;
#pragma unroll
            for (int j = 0; j < 4; ++j) { const unsigned h0 = f2bf(u0[j]), h1b = f2bf(u1[j]); ahi[j] = (short)h0; ahi[4 + j] = (short)h1b; alo[j] = (short)f2bf(u0[j] - bf2f(h0)); alo[4 + j] = (short)f2bf(u1[j] - bf2f(h1b)); }
            { u32x2 w8; w8.x = pk4_fp8(u0[0], u0[1], u0[2], u0[3]); w8.y = pk4_fp8(u1[0], u1[1], u1[2], u1[3]); *(u32x2*)(up + 32 * s) = w8; }
#pragma unroll
            for (int nt = 0; nt < 2; ++nt) { const bf16x8 bhi = *(const bf16x8*)(rw + (size_t)(16 * nt + r) * 1024 + 32 * s + 8 * kg); const bf16x8 blo = *(const bf16x8*)(rw + (size_t)(32 + 16 * nt + r) * 1024 + 32 * s + 8 * kg);
                acc[nt] = MFMA16(ahi, bhi, acc[nt]); acc[nt] = MFMA16(ahi, blo, acc[nt]); acc[nt] = MFMA16(alo, bhi, acc[nt]); }
        }
#pragma unroll
        for (int nt = 0; nt < 2; ++nt)
#pragma unroll
            for (int j = 0; j < 4; ++j) LG[(F.wave * 16 + 4 * kg + j) * 33 + 16 * nt + r] = acc[nt][j] + a.in[35][l * 32 + 16 * nt + r];
        __syncthreads();
        int pe[4]; float pg[4]; int prank[4];
        if (F.tid < 128) {
            float lv[32];
#pragma unroll
            for (int e = 0; e < 32; ++e) lv[e] = LG[F.tid * 33 + e];
#pragma unroll
            for (int k = 0; k < 4; ++k) { float best = -3.0e38f; int bi = 0;
#pragma unroll
                for (int e = 0; e < 32; ++e) { const bool tk = lv[e] > best; best = tk ? lv[e] : best; bi = tk ? e : bi; }
                pe[k] = bi; pg[k] = best;
#pragma unroll
                for (int e = 0; e < 32; ++e) lv[e] = (e == bi) ? -3.0e38f : lv[e]; }
            const float mx = pg[0]; float sm = 0.f;
#pragma unroll
            for (int k = 0; k < 4; ++k) { pg[k] = __expf(pg[k] - mx); sm += pg[k]; }
            const float inv = 1.0f / sm;
#pragma unroll
            for (int k = 0; k < 4; ++k) { pg[k] *= inv; prank[k] = __hip_atomic_fetch_add(&lcnt[pe[k]], 1, __ATOMIC_RELAXED, __HIP_MEMORY_SCOPE_WORKGROUP); }
        }
        __syncthreads();
        if (F.tid < 32) { const int c = lcnt[F.tid]; lbase[F.tid] = c ? (int)atomicAdd(&F.ctl[CW_CNT + l * 2048 + F.tid * 64], (unsigned)c) : 0; }
        __syncthreads();
        if (F.tid < 128) {
            const int trow = tile * 128 + F.tid;
#pragma unroll
            for (int k = 0; k < 4; ++k) { const int pos = lbase[pe[k]] + prank[k]; const size_t li = (size_t)pe[k] * ECAP + pos;
                ((int*)(ws + WS_ROWTOK))[li] = trow; ((float*)(ws + WS_ROWGATE))[li] = pg[k]; ((int*)(ws + WS_TOKSLOT))[(size_t)trow * 4 + k] = pe[k] * 32768 + pos; }
        }
    }
}

#define RAW_PF(pr, src, ld, grow0, tseq0, c0) do { _Pragma("unroll") for (int i_ = 0; i_ < 5; ++i_) { const int q0_ = F.tid + i_ * NTHR, q_ = q0_ < 131 * 16 ? q0_ : 131 * 16 - 1, r_ = q_ >> 4, cc_ = q_ & 15; \
        const int back_ = (tseq0) - 3 + r_ >= 0 ? 3 - r_ : (tseq0);     \
        const u32x4 v_ = *(const u32x4*)((const unsigned char*)(src) + (unsigned)(((grow0) - back_) * (ld) + (c0) + 8 * cc_) * 2u); pr[i_] = ((tseq0) - 3 + r_ >= 0) ? v_ : (u32x4){0u, 0u, 0u, 0u}; } } while (0)
#define RAW_PW(pr) do { _Pragma("unroll") for (int i_ = 0; i_ < 5; ++i_) { const int q_ = F.tid + i_ * NTHR, r_ = q_ >> 4, cc_ = q_ & 15; if (q_ < 131 * 16) *(LAS u32x4*)(F.lds + L_RAW + r_ * RLD + cc_ * 16) = pr[i_]; } } while (0)
template <int RLDB>
__device__ __forceinline__ void tr_frag4(unsigned a, bf16x8 (&out)[4]) {
    u32x2 r0, r1, r2, r3, r4, r5, r6, r7;
    asm volatile(
        "ds_read_b64_tr_b16 %0, %8 offset:%9\n\t"
        "ds_read_b64_tr_b16 %1, %8 offset:%10\n\t"
        "ds_read_b64_tr_b16 %2, %8 offset:%11\n\t"
        "ds_read_b64_tr_b16 %3, %8 offset:%12\n\t"
        "ds_read_b64_tr_b16 %4, %8 offset:%13\n\t"
        "ds_read_b64_tr_b16 %5, %8 offset:%14\n\t"
        "ds_read_b64_tr_b16 %6, %8 offset:%15\n\t"
        "ds_read_b64_tr_b16 %7, %8 offset:%16\n\t"
        "s_waitcnt lgkmcnt(0)"
        : "=&v"(r0), "=&v"(r1), "=&v"(r2), "=&v"(r3), "=&v"(r4), "=&v"(r5), "=&v"(r6), "=&v"(r7)
        : "v"(a), "i"(0), "i"(4 * RLDB), "i"(32 * RLDB), "i"(36 * RLDB), "i"(64 * RLDB), "i"(68 * RLDB), "i"(96 * RLDB), "i"(100 * RLDB)
        : "memory");
    out[0] = __builtin_bit_cast(bf16x8, (u32x4){r0.x, r0.y, r1.x, r1.y});
    out[1] = __builtin_bit_cast(bf16x8, (u32x4){r2.x, r2.y, r3.x, r3.y});
    out[2] = __builtin_bit_cast(bf16x8, (u32x4){r4.x, r4.y, r5.x, r5.y});
    out[3] = __builtin_bit_cast(bf16x8, (u32x4){r6.x, r6.y, r7.x, r7.y});
}
__device__ __forceinline__ unsigned tr_addr(const LAS unsigned char* tile, int n0, int lane) { return (unsigned)(size_t)tile + (unsigned)((8 * (lane >> 4) + ((lane & 15) >> 2)) * RLD + (n0 + 4 * (lane & 3)) * 2); }
__device__ __forceinline__ void copy_tile(Frame& F, const bf16* src, int ld, int dstoff) {
#pragma unroll
    for (int i = 0; i < 4; ++i) { const int q = F.tid + i * NTHR, r = q >> 4, cc = q & 15; *(LAS u32x4*)(F.lds + dstoff + r * RLD + cc * 16) = *(const u32x4*)(src + (size_t)r * ld + 8 * cc); }
}
__device__ __forceinline__ u32x4 scale8(u32x4 v, float s) { u32x4 o; o.x = pk2(bf2f(v.x & 0xffffu) * s, bf2f(v.x >> 16) * s); o.y = pk2(bf2f(v.y & 0xffffu) * s, bf2f(v.y >> 16) * s); o.z = pk2(bf2f(v.z & 0xffffu) * s, bf2f(v.z >> 16) * s); o.w = pk2(bf2f(v.w & 0xffffu) * s, bf2f(v.w >> 16) * s); return o; }
#define WSYNC() do { asm volatile("s_waitcnt vmcnt(0)" ::: "memory"); __syncthreads(); } while (0)

constexpr int L_GT = L_SM, L_GC = L_SM + 8192, L_BC = L_GC + 4096, L_MV = L_BC + 4096, L_BM = L_MV + 4096, L_MP = L_BM + 32;
constexpr int L_WS = L_MP + 32;
__device__ __forceinline__ void ml_pre(const PArgs& a, Frame& F0, int b, int c) { Frame F = relaunder(F0);
    unsigned char* ws = F.ws; LAS unsigned char* lds = F.lds;
    const bf16* proj = (const bf16*)(ws + WS_PROJ);
    const int wid = F.wave, lane = F.lane, fr = lane & 15, fq = lane >> 4, row0 = b * SEQ + c * CH;
    const int n = F.tid & 31, tg = F.tid >> 5;
    LAS float* GT = (LAS float*)(lds + L_GT); LAS float* Gc = (LAS float*)(lds + L_GC); LAS float* Bc = (LAS float*)(lds + L_BC); LAS float* BM = (LAS float*)(lds + L_BM);
    const float kscale = 0.08838834764831845f;
    f32x4 gacc = (f32x4){0.f, 0.f, 0.f, 0.f};
    constexpr int GWLD = 2064;
    { u32x4 gw[8];
#pragma unroll
      for (int i = 0; i < 8; ++i) gw[i] = *(const u32x4*)(ws + WS_GATEW + (unsigned)((F.tid + i * NTHR) * 16));
#pragma unroll
      for (int i = 0; i < 8; ++i) { const int q = F.tid + i * NTHR; *(LAS u32x4*)(lds + L_T1 + (q >> 7) * GWLD + (q & 127) * 16) = gw[i]; } }
    const LAS unsigned char* gwl = lds + L_T1 + fr * GWLD + 16 * fq;
    u32x4 pr[5];
    RAW_PF(pr, proj, EVEN_IN, row0, c * CH, 2048);
    const GAS float* p14 = uptr(a.in[14]); const GAS float* p15 = uptr(a.in[15]); const GAS float* p16 = uptr(a.in[16]); const GAS float* p17 = uptr(a.in[17]); const GAS float* p18 = uptr(a.in[18]);
    for (int h = 0; h < 8; ++h) {
        const int gc = 128 * h + 4 * n;
        f32x4 cw[4], wq[4], wk[4], wv[4];
        const f32x4 cb = *(const GAS f32x4*)(p15 + gc);
#pragma unroll
        for (int j = 0; j < 4; ++j) { cw[j] = *(const GAS f32x4*)(p14 + (size_t)j * D + gc); wq[j] = *(const GAS f32x4*)(p16 + (size_t)(32 * h + n) * 16 + 4 * j);
            wk[j] = *(const GAS f32x4*)(p17 + (size_t)(32 * h + n) * 16 + 4 * j); wv[j] = *(const GAS f32x4*)(p18 + (size_t)(32 * h + n) * 16 + 4 * j); }
        RAW_PW(pr);
#pragma unroll
        for (int j = 0; j < 4; ++j) wk[j] *= kscale;
        __syncthreads();
        if (h < 7) RAW_PF(pr, proj, EVEN_IN, row0, c * CH, 2048 + 128 * (h + 1));
        float w0[4], w1[4], w2[4], w3[4];
        { const LAS unsigned char* rp = lds + L_RAW + (8 * tg) * RLD + 8 * n; u32x2 u;
          u = *(const LAS u32x2*)(rp); w0[0] = bf2f(u.x & 0xffffu); w0[1] = bf2f(u.x >> 16); w0[2] = bf2f(u.y & 0xffffu); w0[3] = bf2f(u.y >> 16);
          u = *(const LAS u32x2*)(rp + RLD); w1[0] = bf2f(u.x & 0xffffu); w1[1] = bf2f(u.x >> 16); w1[2] = bf2f(u.y & 0xffffu); w1[3] = bf2f(u.y >> 16);
          u = *(const LAS u32x2*)(rp + 2 * RLD); w2[0] = bf2f(u.x & 0xffffu); w2[1] = bf2f(u.x >> 16); w2[2] = bf2f(u.y & 0xffffu); w2[3] = bf2f(u.y >> 16); }
#pragma unroll
        for (int i = 0; i < 8; ++i) { const int t = 8 * tg + i;
            { const u32x2 u = *(const LAS u32x2*)(lds + L_RAW + (t + 3) * RLD + 8 * n); w3[0] = bf2f(u.x & 0xffffu); w3[1] = bf2f(u.x >> 16); w3[2] = bf2f(u.y & 0xffffu); w3[3] = bf2f(u.y >> 16); }
            float xc[4], q[4], k[4], v[4];
#pragma unroll
            for (int e = 0; e < 4; ++e) xc[e] = siluf_(cb[e] + cw[0][e] * w0[e] + cw[1][e] * w1[e] + cw[2][e] * w2[e] + cw[3][e] * w3[e]);
#pragma unroll
            for (int e = 0; e < 4; ++e) { q[e] = xc[0] * wq[0][e] + xc[1] * wq[1][e] + xc[2] * wq[2][e] + xc[3] * wq[3][e]; k[e] = xc[0] * wk[0][e] + xc[1] * wk[1][e] + xc[2] * wk[2][e] + xc[3] * wk[3][e];
                v[e] = w3[0] * wv[0][e] + w3[1] * wv[1][e] + w3[2] * wv[2][e] + w3[3] * wv[3][e]; }
            u32x2 o; o.x = pk2(xc[0], xc[1]); o.y = pk2(xc[2], xc[3]);
            *(LAS u32x2*)(lds + L_T0 + t * RLD + 8 * n) = o;
            const unsigned go = (unsigned)((row0 + t) * D + gc) * 2u;
            *(u32x2*)(ws + WS_XC + go) = o;
            o.x = pk2(q[0], q[1]); o.y = pk2(q[2], q[3]); *(u32x2*)(ws + WS_QG + go) = o;
            o.x = pk2(k[0], k[1]); o.y = pk2(k[2], k[3]); *(u32x2*)(ws + WS_KG + go) = o;
            o.x = pk2(v[0], v[1]); o.y = pk2(v[2], v[3]); *(u32x2*)(ws + WS_VG + go) = o;
#pragma unroll
            for (int e = 0; e < 4; ++e) { w0[e] = w1[e]; w1[e] = w2[e]; w2[e] = w3[e]; } }
        __syncthreads();
#pragma unroll
        for (int ks = 0; ks < 4; ++ks) { const bf16x8 A1 = LFRAG(lds + L_T0, 16 * wid + fr, 32 * ks + 8 * fq); const bf16x8 B1 = *(const LAS bf16x8*)(gwl + (128 * h + 32 * ks) * 2); gacc = MFMA16(A1, B1, gacc);
            const bf16x8 A2 = LFRAG(lds + L_RAW, 16 * wid + fr + 3, 32 * ks + 8 * fq); const bf16x8 B2 = *(const LAS bf16x8*)(gwl + 16 * GWLD + (128 * h + 32 * ks) * 2); gacc = MFMA16(A2, B2, gacc); }
        __syncthreads();
    }
    const float gbias = *(fr < 8 ? a.in[20] + fr : a.in[22] + (fr - 8));
#pragma unroll
    for (int j = 0; j < 4; ++j) { float v = gacc[j] + gbias; if (fr >= 8) v = logsigmoidf_(v); GT[(16 * wid + 4 * fq + j) * 16 + fr] = v; }
    __syncthreads();
    if (F.tid < 8) { const int h = F.tid; float g = 0.f, bmax = -3.0e38f;
        for (int t = 0; t < CH; ++t) { g += GT[t * 16 + 8 + h]; const float bb = GT[t * 16 + h] - g; Gc[t * 8 + h] = g; Bc[t * 8 + h] = bb; bmax = fmaxf(bmax, bb); }
        BM[h] = bmax; const int u = (b * 8 + h) * NCHUNK + c; ((float*)(ws + WS_ML_GT))[u] = g; ((float*)(ws + WS_ML_ML))[u] = g + bmax; }
    __syncthreads();
    for (int i = F.tid; i < CH * 8; i += NTHR) { ((float*)(ws + WS_ML_G))[(size_t)row0 * 8 + i] = Gc[i]; ((float*)(ws + WS_ML_B))[(size_t)row0 * 8 + i] = Bc[i]; }
}
__device__ __forceinline__ void ml_local2(const PArgs& a, Frame& F, int b, int c) {
    unsigned char* ws = F.ws; LAS unsigned char* lds = F.lds;
    const int wid = F.wave, lane = F.lane, fr = lane & 15, fq = lane >> 4, row0 = b * SEQ + c * CH;
    LAS float* Bc = (LAS float*)(lds + L_BC); LAS float* BM = (LAS float*)(lds + L_BM);
    WSYNC();
    u32x4 pk[4], pv[4];
#define KV_PF(hh) do { _Pragma("unroll") for (int i_ = 0; i_ < 4; ++i_) { const int q_ = F.tid + i_ * NTHR; const size_t o_ = (size_t)(row0 + (q_ >> 4)) * D + 128 * (hh) + 8 * (q_ & 15); pk[i_] = *(const u32x4*)((const bf16*)(ws + WS_KG) + o_); pv[i_] = *(const u32x4*)((const bf16*)(ws + WS_VG) + o_); } } while (0)
    KV_PF(0);
    for (int h = 0; h < 8; ++h) {
        const float bm = BM[h];
#pragma unroll
        for (int i = 0; i < 4; ++i) { const int q = F.tid + i * NTHR, r = q >> 4, cc = q & 15; const float sc = __expf(Bc[r * 8 + h] - bm);
            *(LAS u32x4*)(lds + L_T1 + r * RLD + cc * 16) = scale8(pk[i], sc);
            *(LAS u32x4*)(lds + L_T2 + r * RLD + cc * 16) = pv[i]; }
        __syncthreads();
        if (h < 7) KV_PF(h + 1);
        const int u = (b * 8 + h) * NCHUNK + c;
        bf16x8 Av[4]; tr_frag4<RLD>(tr_addr(lds + L_T2, 16 * wid, lane), Av);
        bf16* cl = (bf16*)(ws + WS_CLOC) + (size_t)u * 16384;
#pragma unroll
        for (int nt = 0; nt < 8; ++nt) { bf16x8 Bk[4]; tr_frag4<RLD>(tr_addr(lds + L_T1, 16 * nt, lane), Bk);
            f32x4 acc = (f32x4){0.f, 0.f, 0.f, 0.f};
#pragma unroll
            for (int ks = 0; ks < 4; ++ks) acc = MFMA16(Av[ks], Bk[ks], acc);
#pragma unroll
            for (int j = 0; j < 4; ++j) cl[(16 * wid + 4 * fq + j) * 128 + 16 * nt + fr] = (bf16)f2bf(acc[j]); }
        if (F.tid < 128) { float s0 = 0.f, s1 = 0.f;
#pragma unroll 8
            for (int t = 0; t < CH; t += 2) { s0 += bf2f(*(const LAS bf16*)(lds + L_T1 + t * RLD + F.tid * 2)); s1 += bf2f(*(const LAS bf16*)(lds + L_T1 + (t + 1) * RLD + F.tid * 2)); }
            ((float*)(ws + WS_ML_NLOC))[(size_t)u * 128 + F.tid] = s0 + s1; }
        __syncthreads();
    }
}

__device__ __forceinline__ void lru_fix(const PArgs& a, Frame& F0, int b, int c) { Frame F = relaunder(F0);
    unsigned char* ws = F.ws; const bf16* proj = (const bf16*)(ws + WS_PROJ);
    const int row0 = b * SEQ + c * CH, cc = F.tid & 127, tg = F.tid >> 7;
    const float* cp = (const float*)(ws + WS_LRU_CARRY) + (size_t)(b * NCHUNK + c) * D + 8 * cc;
    const f32x4 c0 = *(const f32x4*)cp, c1 = *(const f32x4*)(cp + 4);
#pragma unroll 1
    for (int t0 = 0; t0 < 32; t0 += 4) { u32x4 hw[4], pw[4], gw[4];
#pragma unroll
        for (int i = 0; i < 4; ++i) { const size_t r = (size_t)(row0 + 32 * tg + t0 + i); hw[i] = *(const u32x4*)((const bf16*)(ws + WS_LRU_HL) + r * D + 8 * cc); pw[i] = *(const u32x4*)((const bf16*)(ws + WS_LRU_PC) + r * D + 8 * cc); gw[i] = *(const u32x4*)(proj + r * EVEN_IN + 1024 + 8 * cc); }
#pragma unroll
        for (int i = 0; i < 4; ++i) { const size_t r = (size_t)(row0 + 32 * tg + t0 + i); float o[8];
#pragma unroll
            for (int e = 0; e < 8; ++e) { const unsigned hh = (e < 2) ? hw[i].x : (e < 4) ? hw[i].y : (e < 6) ? hw[i].z : hw[i].w, pq = (e < 2) ? pw[i].x : (e < 4) ? pw[i].y : (e < 6) ? pw[i].z : pw[i].w, gg = (e < 2) ? gw[i].x : (e < 4) ? gw[i].y : (e < 6) ? gw[i].z : gw[i].w;
                const float hl = bf2f((e & 1) ? (hh >> 16) : (hh & 0xffffu)), pc = bf2f((e & 1) ? (pq >> 16) : (pq & 0xffffu)), g = bf2f((e & 1) ? (gg >> 16) : (gg & 0xffffu));
                o[e] = (hl + pc * (e < 4 ? c0[e] : c1[e - 4])) * gelu_tanh(g); }
            u32x4 w; w.x = pk2(o[0], o[1]); w.y = pk2(o[2], o[3]); w.z = pk2(o[4], o[5]); w.w = pk2(o[6], o[7]);
            *(u32x4*)((bf16*)(ws + WS_MIX) + r * MIXW + 8 * cc) = w; } }
}
#undef KV_PF
__device__ __attribute__((noinline)) void ml_local2_nl(const GAS unsigned char* tab, GAS unsigned char* ws, int b, int c) { Frame F = make_frame((unsigned char*)ws); PArgs pa; pa.in.p = (const float* const*)tab; ml_local2(pa, F, b, c); }
__device__ __forceinline__ void ml_out2(const PArgs& a, Frame& F0, int b, int c) { Frame F = relaunder(F0);
    unsigned char* ws = F.ws; LAS unsigned char* lds = F.lds;
    const bf16* proj = (const bf16*)(ws + WS_PROJ); bf16* mix = (bf16*)(ws + WS_MIX);
    const int wid = F.wave, lane = F.lane, fr = lane & 15, fq = lane >> 4, row0 = b * SEQ + c * CH;
    LAS float* Gc = (LAS float*)(lds + L_GC); LAS float* Bc = (LAS float*)(lds + L_BC); LAS float* Mv = (LAS float*)(lds + L_MV); LAS float* MP = (LAS float*)(lds + L_MP);
    u32x4 tq[4], tk[4];
#define QKV_PF(hh) do { _Pragma("unroll") for (int i_ = 0; i_ < 4; ++i_) { const int q_ = F.tid + i_ * NTHR; const size_t o_ = (size_t)(row0 + (q_ >> 4)) * D + 128 * (hh) + 8 * (q_ & 15); \
        tq[i_] = *(const u32x4*)((const bf16*)(ws + WS_QG) + o_); tk[i_] = *(const u32x4*)((const bf16*)(ws + WS_KG) + o_); } } while (0)
    __syncthreads();
    QKV_PF(0);
    LAS float* NWS = (LAS float*)(lds + L_GT);
    {
        const GAS float* nwp = a.in[23]; const GAS float* skp = a.in[24];
        const float g0 = ((const float*)(ws + WS_ML_G))[(size_t)row0 * 8 + F.tid], g1 = ((const float*)(ws + WS_ML_G))[(size_t)row0 * 8 + F.tid + NTHR];
        const float b0 = ((const float*)(ws + WS_ML_B))[(size_t)row0 * 8 + F.tid], b1 = ((const float*)(ws + WS_ML_B))[(size_t)row0 * 8 + F.tid + NTHR];
        const float n0 = nwp[F.tid], n1 = nwp[F.tid + NTHR], s0 = skp[F.tid], s1 = skp[F.tid + NTHR];
        const float mp0 = ((const float*)(ws + WS_ML_MS))[(b * 8 + (F.tid & 7)) * NCHUNK + c];
        Gc[F.tid] = g0; Gc[F.tid + NTHR] = g1; Bc[F.tid] = b0; Bc[F.tid + NTHR] = b1; NWS[F.tid] = n0; NWS[F.tid + NTHR] = n1; NWS[1024 + F.tid] = s0; NWS[1024 + F.tid + NTHR] = s1;
        if (F.tid < 8) MP[F.tid] = mp0; }
    __syncthreads();
    if (F.tid < 8) { const int h = F.tid; float pm = -3.0e38f; const float mp = MP[h]; for (int t = 0; t < CH; ++t) { pm = fmaxf(pm, Bc[t * 8 + h]); Mv[t * 8 + h] = fmaxf(mp, pm); } }
    __syncthreads();
    LAS unsigned char* PS = lds + L_RAW + wid * 16 * RLD;
    LAS unsigned char* HS = lds + L_T0 + wid * 8448;
    for (int h = 0; h < 8; ++h) {
#pragma unroll
        for (int i = 0; i < 4; ++i) { const int q = F.tid + i * NTHR; const int lo = (q >> 4) * RLD + (q & 15) * 16; *(LAS u32x4*)(lds + L_T0 + lo) = tq[i]; *(LAS u32x4*)(lds + L_T1 + lo) = tk[i]; }
        const int u = (b * 8 + h) * NCHUNK + c;
        u32x4 pc[4], tv[4];
#pragma unroll
        for (int i = 0; i < 4; ++i) { const int q = F.tid + i * NTHR; pc[i] = *(const u32x4*)((const bf16*)(ws + WS_CST) + (size_t)u * 16384 + (size_t)(q >> 4) * 128 + 8 * (q & 15));
            tv[i] = *(const u32x4*)((const bf16*)(ws + WS_VG) + (size_t)(row0 + (q >> 4)) * D + 128 * h + 8 * (q & 15)); }
        __syncthreads();
        float rs[4] = {0.f, 0.f, 0.f, 0.f};
        float mrow[4];
#pragma unroll
        for (int j = 0; j < 4; ++j) mrow[j] = Mv[(16 * wid + 4 * fq + j) * 8 + h];
        bf16x8 Aq[4];
#pragma unroll
        for (int ks = 0; ks < 4; ++ks) Aq[ks] = LFRAG(lds + L_T0, 16 * wid + fr, 32 * ks + 8 * fq);
#pragma unroll
        for (int nt = 0; nt < 8; ++nt) {
            if (nt <= wid) {
                f32x4 sacc = (f32x4){0.f, 0.f, 0.f, 0.f};
#pragma unroll
                for (int ks = 0; ks < 4; ++ks) { const bf16x8 B = LFRAG(lds + L_T1, 16 * nt + fr, 32 * ks + 8 * fq); sacc = MFMA16(Aq[ks], B, sacc); }
                const int s_ = 16 * nt + fr; const float bs = Bc[s_ * 8 + h];
#pragma unroll
                for (int j = 0; j < 4; ++j) { const int t = 16 * wid + 4 * fq + j; const float p = (s_ <= t) ? sacc[j] * __expf(bs - mrow[j]) : 0.f; rs[j] += p;
                    *(LAS bf16*)(PS + (4 * fq + j) * RLD + s_ * 2) = (bf16)f2bf(p); }
            } else if (nt == wid + 1) {
#pragma unroll
                for (int j = 0; j < 4; ++j) *(LAS bf16*)(PS + (4 * fq + j) * RLD + (16 * nt + fr) * 2) = (bf16)0;
            }
        }
#pragma unroll
        for (int j = 0; j < 4; ++j) rs[j] = red16(rs[j]);
        __syncthreads();
#pragma unroll
        for (int i = 0; i < 4; ++i) { const int q = F.tid + i * NTHR; *(LAS u32x4*)(lds + L_T1 + (q >> 4) * RLD + (q & 15) * 16) = pc[i]; *(LAS u32x4*)(lds + L_T2 + (q >> 4) * RLD + (q & 15) * 16) = tv[i]; }
        __syncthreads();
        if (h < 7) QKV_PF(h + 1);
        f32x4 oacc[8];
#pragma unroll
        for (int ne = 0; ne < 8; ++ne) oacc[ne] = (f32x4){0.f, 0.f, 0.f, 0.f};
#pragma unroll
        for (int ks = 0; ks < 4; ++ks) {
#pragma unroll
            for (int ne = 0; ne < 8; ++ne) { const bf16x8 B = LFRAG(lds + L_T1, 16 * ne + fr, 32 * ks + 8 * fq); oacc[ne] = MFMA16(Aq[ks], B, oacc[ne]); } }
        const float mp = MP[h];
        float winter[4];
#pragma unroll
        for (int j = 0; j < 4; ++j) winter[j] = __expf(mp - mrow[j]);
#pragma unroll
        for (int ne = 0; ne < 8; ++ne)
#pragma unroll
            for (int j = 0; j < 4; ++j) oacc[ne][j] *= winter[j];
        const int kmax = (wid + 2) >> 1;
        bf16x8 Ap[4];
#pragma unroll
        for (int ks = 0; ks < 4; ++ks) Ap[ks] = LFRAG(PS, fr, 32 * ks + 8 * fq);
#pragma unroll
        for (int ne = 0; ne < 8; ++ne) { bf16x8 Bv[4]; tr_frag4<RLD>(tr_addr(lds + L_T2, 16 * ne, lane), Bv);
#pragma unroll
            for (int ks = 0; ks < 4; ++ks) if (ks < kmax) oacc[ne] = MFMA16(Ap[ks], Bv[ks], oacc[ne]); }
        float qn[4];
        { const float* np = (const float*)(ws + WS_ML_NST) + (size_t)u * 128 + 8 * fr; const f32x4 n0 = *(const f32x4*)np, n1 = *(const f32x4*)(np + 4);
#pragma unroll
            for (int j = 0; j < 4; ++j) { const bf16x8 qq = LFRAG(lds + L_T0, 16 * wid + 4 * fq + j, 8 * fr); float s = 0.f;
#pragma unroll
                for (int d = 0; d < 4; ++d) s += bf2f((unsigned short)qq[d]) * n0[d] + bf2f((unsigned short)qq[4 + d]) * n1[d];
                qn[j] = red16(s); } }
        float inv[4], mean[4], rstd[4];
#pragma unroll
        for (int j = 0; j < 4; ++j) { const int t = 16 * wid + 4 * fq + j; const float den = rs[j] + winter[j] * qn[j]; inv[j] = frcp(fmaxf(fabsf(den), __expf(-(Gc[t * 8 + h] + mrow[j])))); }
#pragma unroll
        for (int ne = 0; ne < 8; ++ne)
#pragma unroll
            for (int j = 0; j < 4; ++j) oacc[ne][j] *= inv[j];
#pragma unroll
        for (int j = 0; j < 4; ++j) { float s = 0.f;
#pragma unroll
            for (int ne = 0; ne < 8; ++ne) s += oacc[ne][j];
            mean[j] = red16(s) * (1.0f / 128.0f); float q2 = 0.f;
#pragma unroll
            for (int ne = 0; ne < 8; ++ne) { const float d = oacc[ne][j] - mean[j]; q2 += d * d; }
            rstd[j] = __builtin_amdgcn_rsqf(red16(q2) * (1.0f / 128.0f) + EPS); }
        const int er = lane >> 2, esg = lane & 3; const size_t egrow = (size_t)(row0 + 16 * wid + er); const int ec0 = 128 * h + 32 * esg;
        u32x4 exw[4], ezw[4];
#pragma unroll
        for (int q = 0; q < 4; ++q) { exw[q] = *(const u32x4*)((const bf16*)(ws + WS_XC) + egrow * D + ec0 + 8 * q); ezw[q] = *(const u32x4*)(proj + egrow * EVEN_IN + 3072 + ec0 + 8 * q); }
        __syncthreads();
#pragma unroll
        for (int ne = 0; ne < 8; ++ne)
#pragma unroll
            for (int j = 0; j < 4; ++j) *(LAS float*)(HS + (4 * fq + j) * 528 + (16 * ne + fr) * 4) = (oacc[ne][j] - mean[j]) * rstd[j];
        asm volatile("s_waitcnt lgkmcnt(0)" ::: "memory");
        { const int r = er, sg = esg; const size_t grow = egrow; const int c0 = ec0;
#pragma unroll
            for (int q = 0; q < 4; ++q) { const int cc = c0 + 8 * q;
                const f32x4 h0 = *(const LAS f32x4*)(HS + r * 528 + (32 * sg + 8 * q) * 4), h1 = *(const LAS f32x4*)(HS + r * 528 + (32 * sg + 8 * q + 4) * 4);
                const u32x4 xw = exw[q]; const u32x4 zw = ezw[q];
                const f32x4 nw0 = *(const LAS f32x4*)(NWS + cc), nw1 = *(const LAS f32x4*)(NWS + cc + 4), sk0 = *(const LAS f32x4*)(NWS + 1024 + cc), sk1 = *(const LAS f32x4*)(NWS + 1024 + cc + 4);
                float o[8];
#pragma unroll
                for (int e = 0; e < 4; ++e) { const unsigned xa = (e < 2) ? xw.x : xw.y, xb_ = (e < 2) ? xw.z : xw.w, za = (e < 2) ? zw.x : zw.y, zb_ = (e < 2) ? zw.z : zw.w;
                    const float x0 = bf2f((e & 1) ? (xa >> 16) : (xa & 0xffffu)), x1 = bf2f((e & 1) ? (xb_ >> 16) : (xb_ & 0xffffu));
                    const float z0 = bf2f((e & 1) ? (za >> 16) : (za & 0xffffu)), z1 = bf2f((e & 1) ? (zb_ >> 16) : (zb_ & 0xffffu));
                    o[e] = (h0[e] * nw0[e] + sk0[e] * x0) * siluf_(z0); o[4 + e] = (h1[e] * nw1[e] + sk1[e] * x1) * siluf_(z1); }
                u32x4 w; w.x = pk2(o[0], o[1]); w.y = pk2(o[2], o[3]); w.z = pk2(o[4], o[5]); w.w = pk2(o[6], o[7]);
                *(u32x4*)(mix + grow * MIXW + 1024 + cc) = w; } }
        __syncthreads();
    }
#undef QKV_PF
}


template <bool OUT>
__device__ __forceinline__ void lru_unit2(const PArgs& a, Frame& F0, int b, int c) { Frame F = relaunder(F0);
    unsigned char* ws = F.ws; LAS unsigned char* lds = F.lds;
    const bf16* proj = (const bf16*)(ws + WS_PROJ);
    const int wid = F.wave, lane = F.lane, fr = lane & 15, fq = lane >> 4;
    const int n = F.tid & 31, tg = F.tid >> 5;
    const int row0 = b * SEQ + c * CH;
    __syncthreads();
    u32x4 pr[5];
    RAW_PF(pr, proj, EVEN_IN, row0, c * CH, 0);
    for (int h = 0; h < 8; ++h) {
        RAW_PW(pr);
        if (OUT) copy_tile(F, proj + (size_t)row0 * EVEN_IN + 1024 + 128 * h, EVEN_IN, L_T1);
        const int gc = 128 * h + 4 * n;
        f32x4 cw[4]; const f32x4 cb = *(const f32x4*)(a.in[8] + gc);
#pragma unroll
        for (int j = 0; j < 4; ++j) cw[j] = *(const f32x4*)(a.in[7] + (size_t)j * D + gc);
        const bf16* wr_ = (const bf16*)(ws + WS_LRUW) + (size_t)(h * 128 + 16 * wid + fr) * 128 + 8 * fq;
        const bf16* wi_ = wr_ + (size_t)8 * 128 * 128;
        bf16x8 Br[4], Bi[4];
#pragma unroll
        for (int ks = 0; ks < 4; ++ks) { Br[ks] = *(const bf16x8*)(wr_ + 32 * ks); Bi[ks] = *(const bf16x8*)(wi_ + 32 * ks); }
        const int ch = 128 * h + 16 * wid + fr;
        const float br = a.in[10][ch], bi = a.in[12][ch], ls8 = -8.0f * log1pf(__expf(-a.in[13][ch]));
        float hin = OUT ? ((const float*)(ws + WS_LRU_CARRY))[(size_t)(b * NCHUNK + c) * D + ch] : 0.f;
        __syncthreads();
        { float w0[4], w1[4], w2[4], w3[4]; const LAS unsigned char* rp = lds + L_RAW + (8 * tg) * RLD + 8 * n; u32x2 u;
          u = *(const LAS u32x2*)(rp); w0[0] = bf2f(u.x & 0xffffu); w0[1] = bf2f(u.x >> 16); w0[2] = bf2f(u.y & 0xffffu); w0[3] = bf2f(u.y >> 16);
          u = *(const LAS u32x2*)(rp + RLD); w1[0] = bf2f(u.x & 0xffffu); w1[1] = bf2f(u.x >> 16); w1[2] = bf2f(u.y & 0xffffu); w1[3] = bf2f(u.y >> 16);
          u = *(const LAS u32x2*)(rp + 2 * RLD); w2[0] = bf2f(u.x & 0xffffu); w2[1] = bf2f(u.x >> 16); w2[2] = bf2f(u.y & 0xffffu); w2[3] = bf2f(u.y >> 16);
#pragma unroll
          for (int i = 0; i < 8; ++i) { const int t = 8 * tg + i;
              u = *(const LAS u32x2*)(rp + (3 + i) * RLD); w3[0] = bf2f(u.x & 0xffffu); w3[1] = bf2f(u.x >> 16); w3[2] = bf2f(u.y & 0xffffu); w3[3] = bf2f(u.y >> 16);
              float y[4];
#pragma unroll
              for (int e = 0; e < 4; ++e) y[e] = cb[e] + cw[0][e] * w0[e] + cw[1][e] * w1[e] + cw[2][e] * w2[e] + cw[3][e] * w3[e];
              u32x2 o; o.x = pk2(y[0], y[1]); o.y = pk2(y[2], y[3]); *(LAS u32x2*)(lds + L_T0 + t * RLD + 8 * n) = o;
#pragma unroll
              for (int e = 0; e < 4; ++e) { w0[e] = w1[e]; w1[e] = w2[e]; w2[e] = w3[e]; } } }
        __syncthreads();
        if (h < 7) RAW_PF(pr, proj, EVEN_IN, row0, c * CH, 128 * (h + 1));
        float aprod = 1.f;
#pragma unroll 1
        for (int mt = 0; mt < 8; ++mt) {
            f32x4 ar = (f32x4){0.f, 0.f, 0.f, 0.f}, ai = ar;
#pragma unroll
            for (int ks = 0; ks < 4; ++ks) { const bf16x8 A = LFRAG(lds + L_T0, 16 * mt + fr, 32 * ks + 8 * fq); ar = MFMA16(A, Br[ks], ar); ai = MFMA16(A, Bi[ks], ai); }
            float av[4], uv[4];
#pragma unroll
            for (int j = 0; j < 4; ++j) { const float rr = sigmoidf_(ar[j] + br), ii = sigmoidf_(ai[j] + bi); av[j] = __expf(rr * ls8);
                const float x = bf2f(*(const LAS bf16*)(lds + L_T0 + (16 * mt + 4 * fq + j) * RLD + (16 * wid + fr) * 2));
                uv[j] = __builtin_amdgcn_sqrtf(fmaxf(1.0f - av[j] * av[j], 0.f)) * ii * x; }
            const float As = av[0] * av[1] * av[2] * av[3];
            const float Hs = ((uv[0] * av[1] + uv[1]) * av[2] + uv[2]) * av[3] + uv[3];
            const float A0 = __shfl(As, fr), H0 = __shfl(Hs, fr), A1 = __shfl(As, 16 + fr), H1 = __shfl(Hs, 16 + fr), A2 = __shfl(As, 32 + fr), H2 = __shfl(Hs, 32 + fr), A3 = __shfl(As, 48 + fr), H3 = __shfl(Hs, 48 + fr);
            const float h0 = hin, h1 = A0 * h0 + H0, h2 = A1 * h1 + H1, h3 = A2 * h2 + H2, hend = A3 * h3 + H3;
            if (OUT) { float hs = fq == 0 ? h0 : (fq == 1 ? h1 : (fq == 2 ? h2 : h3));
#pragma unroll
                for (int j = 0; j < 4; ++j) { hs = av[j] * hs + uv[j]; const int off = (16 * mt + 4 * fq + j) * RLD + (16 * wid + fr) * 2;
                    const float g = bf2f(*(const LAS bf16*)(lds + L_T1 + off)); *(LAS bf16*)(lds + L_T2 + off) = (bf16)f2bf(hs * gelu_tanh(g)); } }
            else { float hs = fq == 0 ? h0 : (fq == 1 ? h1 : (fq == 2 ? h2 : h3));
                float pp = aprod * (fq == 0 ? 1.0f : (fq == 1 ? A0 : (fq == 2 ? A0 * A1 : A0 * A1 * A2)));
#pragma unroll
                for (int j = 0; j < 4; ++j) { hs = av[j] * hs + uv[j]; pp *= av[j]; const int off = (16 * mt + 4 * fq + j) * RLD + (16 * wid + fr) * 2;
                    *(LAS bf16*)(lds + L_T1 + off) = (bf16)f2bf(hs); *(LAS bf16*)(lds + L_T2 + off) = (bf16)f2bf(pp); } }
            hin = hend; aprod *= (A0 * A1) * (A2 * A3);
        }
        if (!OUT && fq == 0) { ((float*)(ws + WS_LRU_AT))[(size_t)(b * NCHUNK + c) * D + ch] = aprod; ((float*)(ws + WS_LRU_HT))[(size_t)(b * NCHUNK + c) * D + ch] = hin; }
        __syncthreads();
        if (OUT) {
#pragma unroll
            for (int i = 0; i < 4; ++i) { const int q = F.tid + i * NTHR, r = q >> 4, cc = q & 15; *(u32x4*)((bf16*)(ws + WS_MIX) + (size_t)(row0 + r) * MIXW + 128 * h + 8 * cc) = *(const LAS u32x4*)(lds + L_T2 + r * RLD + cc * 16); }
        } else {
#pragma unroll
            for (int i = 0; i < 4; ++i) { const int q = F.tid + i * NTHR, r = q >> 4, cc = q & 15; const size_t go = (size_t)(row0 + r) * D + 128 * h + 8 * cc;
                *(u32x4*)((bf16*)(ws + WS_LRU_HL) + go) = *(const LAS u32x4*)(lds + L_T1 + r * RLD + cc * 16); *(u32x4*)((bf16*)(ws + WS_LRU_PC) + go) = *(const LAS u32x4*)(lds + L_T2 + r * RLD + cc * 16); }
        }
    }
    __syncthreads();
}

__device__ __forceinline__ void ph_ev_local(const PArgs& a, Frame& F) { for (int u = F.bid; u < NB * NCHUNK; u += F.G) { const int b = u / NCHUNK, c = u % NCHUNK; lru_unit2<false>(a, F, b, c); ml_pre(a, F, b, c); ml_local2_nl((const GAS unsigned char*)a.in.p, (GAS unsigned char*)F.ws, b, c); } }
__device__ __forceinline__ void ph_ev_out(const PArgs& a, Frame& F) { for (int u = F.bid; u < NB * NCHUNK; u += F.G) { const int b = u / NCHUNK, c = u % NCHUNK; lru_fix(a, F, b, c); ml_out2(a, F, b, c); } }
__device__ __forceinline__ void ph_ev_scan(const PArgs& a, Frame& F) {
    unsigned char* ws = F.ws; const size_t gt = (size_t)F.bid * NTHR + F.tid, NT = (size_t)F.G * NTHR;
    for (size_t i = gt; i < (size_t)NB * D; i += NT) { const int b = (int)(i / D), ch = (int)(i % D); float carry = 0.f;
        for (int c = 0; c < NCHUNK; ++c) { const size_t o = (size_t)(b * NCHUNK + c) * D + ch; ((float*)(ws + WS_LRU_CARRY))[o] = carry; carry = ((const float*)(ws + WS_LRU_AT))[o] * carry + ((const float*)(ws + WS_LRU_HT))[o]; } }
    for (size_t i = gt; i < (size_t)64 * 4096; i += NT) { const int bh = (int)(i >> 12), e4 = (int)(i & 4095);
        float m = -1.0e30f; f32x4 val = (f32x4){0.f, 0.f, 0.f, 0.f};
#pragma unroll 1
        for (int c0 = 0; c0 < NCHUNK; c0 += 8) { u32x2 loc[8]; float Gv[8], mlv[8];
#pragma unroll
            for (int k = 0; k < 8; ++k) { const int u = bh * NCHUNK + c0 + k; Gv[k] = ((const float*)(ws + WS_ML_GT))[u]; mlv[k] = ((const float*)(ws + WS_ML_ML))[u]; loc[k] = *(const u32x2*)((const bf16*)(ws + WS_CLOC) + (size_t)u * 16384 + 4 * e4); }
#pragma unroll
            for (int k = 0; k < 8; ++k) { const int u = bh * NCHUNK + c0 + k;
                u32x2 w; w.x = pk2(val[0], val[1]); w.y = pk2(val[2], val[3]); *(u32x2*)((bf16*)(ws + WS_CST) + (size_t)u * 16384 + 4 * e4) = w;
                if (e4 == 0) ((float*)(ws + WS_ML_MS))[u] = m;
                const float mn = fmaxf(m + Gv[k], mlv[k]); const float wc = __expf(m + Gv[k] - mn), wl = __expf(mlv[k] - mn);
                const f32x4 lv = (f32x4){bf2f(loc[k].x & 0xffffu), bf2f(loc[k].x >> 16), bf2f(loc[k].y & 0xffffu), bf2f(loc[k].y >> 16)};
                val = val * wc + lv * wl; m = mn; } } }
    for (size_t i = gt; i < (size_t)64 * 128; i += NT) { const int bh = (int)(i >> 7), e = (int)(i & 127);
        float m = -1.0e30f, val = 0.f;
#pragma unroll 1
        for (int c0 = 0; c0 < NCHUNK; c0 += 8) { float loc[8], Gv[8], mlv[8];
#pragma unroll
            for (int k = 0; k < 8; ++k) { const int u = bh * NCHUNK + c0 + k; Gv[k] = ((const float*)(ws + WS_ML_GT))[u]; mlv[k] = ((const float*)(ws + WS_ML_ML))[u]; loc[k] = ((const float*)(ws + WS_ML_NLOC))[(size_t)u * 128 + e]; }
#pragma unroll
            for (int k = 0; k < 8; ++k) { const int u = bh * NCHUNK + c0 + k;
                ((float*)(ws + WS_ML_NST))[(size_t)u * 128 + e] = val;
                const float mn = fmaxf(m + Gv[k], mlv[k]); const float wc = __expf(m + Gv[k] - mn), wl = __expf(mlv[k] - mn);
                val = wc * val + wl * loc[k]; m = mn; } } }
}

__device__ __forceinline__ void ssd_pre(const PArgs& a, Frame& F0, int b, int c) { Frame F = relaunder(F0);
    unsigned char* ws = F.ws; const bf16* proj = (const bf16*)(ws + WS_PROJ); bf16* xbc = (bf16*)(ws + WS_XBC);
    const int row0 = b * SEQ + c * CH, ch0 = 8 * F.tid;
    float cw[4][8], cb[8];
#pragma unroll
    for (int j = 0; j < 4; ++j) { const f32x4 lo = *(const f32x4*)(a.in[27] + (size_t)j * 4096 + ch0), hi = *(const f32x4*)(a.in[27] + (size_t)j * 4096 + ch0 + 4);
#pragma unroll
        for (int e = 0; e < 4; ++e) { cw[j][e] = lo[e]; cw[j][4 + e] = hi[e]; } }
    { const f32x4 lo = *(const f32x4*)(a.in[28] + ch0), hi = *(const f32x4*)(a.in[28] + ch0 + 4);
#pragma unroll
        for (int e = 0; e < 4; ++e) { cb[e] = lo[e]; cb[4 + e] = hi[e]; } }
    const bf16* src = proj + (size_t)row0 * OD_INP + 2048 + ch0;
    u32x4 r0 = (u32x4){0u, 0u, 0u, 0u}, r1 = r0, r2 = r0;
    if (c > 0) { r0 = *(const u32x4*)(src - 3 * (ptrdiff_t)OD_INP); r1 = *(const u32x4*)(src - 2 * (ptrdiff_t)OD_INP); r2 = *(const u32x4*)(src - (ptrdiff_t)OD_INP); }
#pragma unroll 1
    for (int t0 = 0; t0 < CH; t0 += 8) {
        u32x4 rr[8];
#pragma unroll
        for (int i = 0; i < 8; ++i) rr[i] = *(const u32x4*)(src + (size_t)(t0 + i) * OD_INP);
#pragma unroll
        for (int i = 0; i < 8; ++i) { const u32x4 r3 = rr[i]; float o[8];
#pragma unroll
            for (int e = 0; e < 8; ++e) { const unsigned w0 = (e < 2) ? r0.x : (e < 4) ? r0.y : (e < 6) ? r0.z : r0.w, w1 = (e < 2) ? r1.x : (e < 4) ? r1.y : (e < 6) ? r1.z : r1.w,
                    w2 = (e < 2) ? r2.x : (e < 4) ? r2.y : (e < 6) ? r2.z : r2.w, w3 = (e < 2) ? r3.x : (e < 4) ? r3.y : (e < 6) ? r3.z : r3.w;
                const float x0 = bf2f((e & 1) ? (w0 >> 16) : (w0 & 0xffffu)), x1 = bf2f((e & 1) ? (w1 >> 16) : (w1 & 0xffffu)), x2 = bf2f((e & 1) ? (w2 >> 16) : (w2 & 0xffffu)), x3 = bf2f((e & 1) ? (w3 >> 16) : (w3 & 0xffffu));
                o[e] = siluf_(cb[e] + cw[0][e] * x0 + cw[1][e] * x1 + cw[2][e] * x2 + cw[3][e] * x3); }
            u32x4 w; w.x = pk2(o[0], o[1]); w.y = pk2(o[2], o[3]); w.z = pk2(o[4], o[5]); w.w = pk2(o[6], o[7]);
            *(u32x4*)(xbc + (size_t)(row0 + t0 + i) * 4096 + ch0) = w;
            r0 = r1; r1 = r2; r2 = r3; }
    }
}
constexpr int L_DT2 = L_T2, L_AC2 = L_T2 + 16384;
constexpr int L_DT4 = L_SM, L_AC4 = L_SM + 2048;
__device__ __forceinline__ void ssd_local2(const PArgs& a, Frame& F0, int b, int c) { Frame F = relaunder(F0);
    unsigned char* ws = F.ws; LAS unsigned char* lds = F.lds;
    const bf16* proj = (const bf16*)(ws + WS_PROJ); const bf16* xbc = (const bf16*)(ws + WS_XBC);
    const int wid = F.wave, lane = F.lane, fr = lane & 15, fq = lane >> 4, row0 = b * SEQ + c * CH;
    LAS float* DT = (LAS float*)(lds + L_DT2); LAS float* AC = (LAS float*)(lds + L_AC2);
    __syncthreads();
    for (int q = F.tid; q < CH * 32; q += NTHR) { const int t = q >> 5, hd = q & 31; const float raw = bf2f(proj[(size_t)(row0 + t) * OD_INP + 6144 + hd]); DT[q] = softplusf_(raw + a.in[29][hd]); }
    __syncthreads();
    if (F.tid < 32) { const float A = -__expf(a.in[30][F.tid]); float acc = 0.f; for (int t = 0; t < CH; ++t) { acc += DT[t * 32 + F.tid] * A; AC[t * 32 + F.tid] = acc; }
        ((float*)(ws + WS_SSD_ALAST))[(size_t)(b * NCHUNK + c) * 32 + F.tid] = acc; }
    __syncthreads();
    for (int q = F.tid; q < CH * 32; q += NTHR) { ((float*)(ws + WS_DTG))[(size_t)row0 * 32 + q] = DT[q]; ((float*)(ws + WS_ACG))[(size_t)row0 * 32 + q] = AC[q]; }
    ssd_pre(a, F, b, c);
    WSYNC();
    for (int g = 0; g < 8; ++g) {
        copy_tile(F, xbc + (size_t)row0 * 4096 + 2048 + 128 * g, 4096, L_T1);
        for (int jp = 0; jp < 2; ++jp) { const int hd0 = 4 * g + 2 * jp;
            const bf16* xs = xbc + (size_t)row0 * 4096 + 64 * hd0;
#pragma unroll
            for (int i = 0; i < 4; ++i) { const int q = F.tid + i * NTHR, r = q >> 4, cc = q & 15, hd = hd0 + (cc >> 3);
                const float sc = __expf(AC[127 * 32 + hd] - AC[r * 32 + hd]) * DT[r * 32 + hd];
                *(LAS u32x4*)(lds + L_T0 + r * RLD + cc * 16) = scale8(*(const u32x4*)(xs + (size_t)r * 4096 + 8 * cc), sc); }
            __syncthreads();
            bf16x8 Ax[4]; tr_frag4<RLD>(tr_addr(lds + L_T0, 16 * wid, lane), Ax);
            bf16* sl = (bf16*)(ws + WS_SLOC) + ((size_t)(b * NCHUNK + c) * 32 + hd0 + (wid >> 2)) * 8192;
#pragma unroll
            for (int nt = 0; nt < 8; ++nt) { bf16x8 Bb[4]; tr_frag4<RLD>(tr_addr(lds + L_T1, 16 * nt, lane), Bb);
                f32x4 acc = (f32x4){0.f, 0.f, 0.f, 0.f};
#pragma unroll
                for (int ks = 0; ks < 4; ++ks) acc = MFMA16(Ax[ks], Bb[ks], acc);
#pragma unroll
                for (int jj = 0; jj < 4; ++jj) sl[(16 * (wid & 3) + 4 * fq + jj) * 128 + 16 * nt + fr] = (bf16)f2bf(acc[jj]); }
            __syncthreads();
        }
    }
}
constexpr int L_NW4 = L_SM + 4096, L_SS = L_SM + 5120;
__device__ __forceinline__ void ssd_out3(const PArgs& a, Frame& F0, int b, int c) { Frame F = relaunder(F0);
    unsigned char* ws = F.ws; LAS unsigned char* lds = F.lds;
    const bf16* proj = (const bf16*)(ws + WS_PROJ); const bf16* xbc = (const bf16*)(ws + WS_XBC); bf16* mix = (bf16*)(ws + WS_MIX);
    const int wid = F.wave, lane = F.lane, fr = lane & 15, fq = lane >> 4, row0 = b * SEQ + c * CH;
    LAS float* DT4 = (LAS float*)(lds + L_DT4); LAS float* AC4 = (LAS float*)(lds + L_AC4); LAS float* NW4 = (LAS float*)(lds + L_NW4);
    LAS unsigned char* PS = lds + L_RAW + wid * 16 * RLD;
    LAS unsigned char* YS = lds + L_T0 + wid * 8448;
    const bf16* sstb = (const bf16*)(ws + WS_SST) + (size_t)(b * NCHUNK + c) * 32 * 8192;
    u32x4 pss[2];
#define SS_PF(hd_) do { const bf16* sp_ = sstb + (size_t)(hd_) * 8192; _Pragma("unroll") for (int i_ = 0; i_ < 2; ++i_) { const int q_ = F.tid + i_ * NTHR; pss[i_] = *(const u32x4*)(sp_ + (size_t)(q_ >> 4) * 128 + 8 * (q_ & 15)); } } while (0)
#define SS_PW() do { _Pragma("unroll") for (int i_ = 0; i_ < 2; ++i_) { const int q_ = F.tid + i_ * NTHR; *(LAS u32x4*)(lds + L_SS + (q_ >> 4) * RLD + (q_ & 15) * 16) = pss[i_]; } } while (0)
    SS_PF(0);
    for (int g = 0; g < 8; ++g) {
        __syncthreads();
        const bf16* xb0 = xbc + (size_t)row0 * 4096;
        copy_tile(F, xb0 + 3072 + 128 * g, 4096, L_T0);
        copy_tile(F, xb0 + 2048 + 128 * g, 4096, L_T1);
        copy_tile(F, xb0 + 64 * (4 * g), 4096, L_T2);
        u32x4 px1[4];
#pragma unroll
        for (int i = 0; i < 4; ++i) { const int q = F.tid + i * NTHR; px1[i] = *(const u32x4*)(xb0 + 64 * (4 * g + 2) + (size_t)(q >> 4) * 4096 + 8 * (q & 15)); }
        { const int t = F.tid >> 2, j = F.tid & 3; DT4[F.tid] = ((const float*)(ws + WS_DTG))[(size_t)(row0 + t) * 32 + 4 * g + j]; AC4[F.tid] = ((const float*)(ws + WS_ACG))[(size_t)(row0 + t) * 32 + 4 * g + j]; }
        if (F.tid < 256) NW4[F.tid] = a.in[32][256 * g + F.tid];
        __syncthreads();
        bf16x8 Ac[4];
#pragma unroll
        for (int ks = 0; ks < 4; ++ks) Ac[ks] = LFRAG(lds + L_T0, 16 * wid + fr, 32 * ks + 8 * fq);
        f32x4 cb[8];
#pragma unroll
        for (int nt = 0; nt < 8; ++nt) { cb[nt] = (f32x4){0.f, 0.f, 0.f, 0.f};
            if (nt <= wid) {
#pragma unroll
                for (int ks = 0; ks < 4; ++ks) { const bf16x8 B = LFRAG(lds + L_T1, 16 * nt + fr, 32 * ks + 8 * fq); cb[nt] = MFMA16(Ac[ks], B, cb[nt]); } } }
        __syncthreads();
#pragma unroll
        for (int i = 0; i < 4; ++i) { const int q = F.tid + i * NTHR; *(LAS u32x4*)(lds + L_T1 + (q >> 4) * RLD + (q & 15) * 16) = px1[i]; }
        SS_PW();
        __syncthreads();
        unsigned yp[4][4][2];
#pragma unroll 1
        for (int j = 0; j < 4; ++j) { const int hd = 4 * g + j; const int xoff = (j < 2 ? L_T2 : L_T1), xcol = 64 * (j & 1);
            if (hd < 31) SS_PF(hd + 1);
            float at[4];
#pragma unroll
            for (int jj = 0; jj < 4; ++jj) at[jj] = AC4[(16 * wid + 4 * fq + jj) * 4 + j];
#pragma unroll
            for (int nt = 0; nt < 8; ++nt) {
                if (nt <= wid) { const int s_ = 16 * nt + fr; const float as = AC4[s_ * 4 + j], ds = DT4[s_ * 4 + j];
#pragma unroll
                    for (int jj = 0; jj < 4; ++jj) { const int t = 16 * wid + 4 * fq + jj; const float w = (s_ <= t) ? cb[nt][jj] * __expf(at[jj] - as) * ds : 0.f;
                        *(LAS bf16*)(PS + (4 * fq + jj) * RLD + s_ * 2) = (bf16)f2bf(w); }
                } else if (nt == wid + 1) {
#pragma unroll
                    for (int jj = 0; jj < 4; ++jj) *(LAS bf16*)(PS + (4 * fq + jj) * RLD + (16 * nt + fr) * 2) = (bf16)0;
                }
            }
            asm volatile("s_waitcnt lgkmcnt(0)" ::: "memory");
            f32x4 ya[4];
#pragma unroll
            for (int np = 0; np < 4; ++np) ya[np] = (f32x4){0.f, 0.f, 0.f, 0.f};
#pragma unroll
            for (int ks = 0; ks < 4; ++ks) {
#pragma unroll
                for (int np = 0; np < 4; ++np) { const bf16x8 B = LFRAG(lds + L_SS, 16 * np + fr, 32 * ks + 8 * fq); ya[np] = MFMA16(Ac[ks], B, ya[np]); } }
#pragma unroll
            for (int np = 0; np < 4; ++np)
#pragma unroll
                for (int jj = 0; jj < 4; ++jj) ya[np][jj] *= __expf(at[jj]);
            const int kmax = (wid + 2) >> 1;
            bf16x8 Ap[4];
#pragma unroll
            for (int ks = 0; ks < 4; ++ks) Ap[ks] = LFRAG(PS, fr, 32 * ks + 8 * fq);
            const float dsk = a.in[31][hd];
#pragma unroll
            for (int np = 0; np < 4; ++np) { bf16x8 Bx[4]; tr_frag4<RLD>(tr_addr(lds + xoff, xcol + 16 * np, lane), Bx);
#pragma unroll
                for (int ks = 0; ks < 4; ++ks) if (ks < kmax) ya[np] = MFMA16(Ap[ks], Bx[ks], ya[np]);
                float yg[4];
#pragma unroll
                for (int jj = 0; jj < 4; ++jj) { const int t = 16 * wid + 4 * fq + jj; const float x = bf2f(*(const LAS bf16*)(lds + xoff + t * RLD + (xcol + 16 * np + fr) * 2)); yg[jj] = ya[np][jj] + dsk * x; }
                const unsigned p0 = pk2(yg[0], yg[1]), p1 = pk2(yg[2], yg[3]);
                if (j == 0) { yp[0][np][0] = p0; yp[0][np][1] = p1; } else if (j == 1) { yp[1][np][0] = p0; yp[1][np][1] = p1; } else if (j == 2) { yp[2][np][0] = p0; yp[2][np][1] = p1; } else { yp[3][np][0] = p0; yp[3][np][1] = p1; } }
            __syncthreads();
            if (j < 3) { SS_PW(); __syncthreads(); }
        }
        const int er = lane >> 2, ej = lane & 3; const size_t egrow = (size_t)(row0 + 16 * wid + er); const int ehd = 4 * g + ej;
        u32x4 zw[8];
#pragma unroll
        for (int q = 0; q < 8; ++q) zw[q] = *(const u32x4*)(proj + egrow * OD_INP + 64 * ehd + 8 * q);
#pragma unroll
        for (int j = 0; j < 4; ++j)
#pragma unroll
            for (int np = 0; np < 4; ++np)
#pragma unroll
                for (int jj = 0; jj < 4; ++jj) { const unsigned pw = yp[j][np][jj >> 1]; *(LAS bf16*)(YS + (4 * fq + jj) * 528 + (64 * j + 16 * np + fr) * 2) = (bf16)((jj & 1) ? (pw >> 16) : (pw & 0xffffu)); }
        asm volatile("s_waitcnt lgkmcnt(0)" ::: "memory");
        { float ssq = 0.f;
#pragma unroll
            for (int q = 0; q < 8; ++q) { LAS u32x4* yp_ = (LAS u32x4*)(YS + er * 528 + (64 * ej + 8 * q) * 2); const u32x4 yw = *yp_; float o[8];
#pragma unroll
                for (int e = 0; e < 8; ++e) { const unsigned yy = (e < 2) ? yw.x : (e < 4) ? yw.y : (e < 6) ? yw.z : yw.w, zz = (e < 2) ? zw[q].x : (e < 4) ? zw[q].y : (e < 6) ? zw[q].z : zw[q].w;
                    const float y = bf2f((e & 1) ? (yy >> 16) : (yy & 0xffffu)), z = bf2f((e & 1) ? (zz >> 16) : (zz & 0xffffu)); o[e] = y * siluf_(z); ssq += o[e] * o[e]; }
                u32x4 w; w.x = pk2(o[0], o[1]); w.y = pk2(o[2], o[3]); w.z = pk2(o[4], o[5]); w.w = pk2(o[6], o[7]); *yp_ = w; }
            ssq += __shfl_xor(ssq, 1); ssq += __shfl_xor(ssq, 2);
            const float rstd = __builtin_amdgcn_rsqf(ssq * (1.0f / 256.0f) + EPS);
#pragma unroll
            for (int q = 0; q < 8; ++q) { const int cl = 64 * ej + 8 * q; const f32x4 n0 = *(const LAS f32x4*)(NW4 + cl), n1 = *(const LAS f32x4*)(NW4 + cl + 4); const u32x4 yw = *(const LAS u32x4*)(YS + er * 528 + cl * 2);
                u32x4 w; w.x = pk2(bf2f(yw.x & 0xffffu) * rstd * n0[0], bf2f(yw.x >> 16) * rstd * n0[1]); w.y = pk2(bf2f(yw.y & 0xffffu) * rstd * n0[2], bf2f(yw.y >> 16) * rstd * n0[3]);
                w.z = pk2(bf2f(yw.z & 0xffffu) * rstd * n1[0], bf2f(yw.z >> 16) * rstd * n1[1]); w.w = pk2(bf2f(yw.w & 0xffffu) * rstd * n1[2], bf2f(yw.w >> 16) * rstd * n1[3]);
                *(u32x4*)(mix + egrow * MIXW + 256 * g + cl) = w; } }
    }
    __syncthreads();
#undef SS_PF
#undef SS_PW
}
__device__ __forceinline__ void ph_od_local(const PArgs& a, Frame& F) { for (int u = F.bid; u < NB * NCHUNK; u += F.G) ssd_local2(a, F, u / NCHUNK, u % NCHUNK); }
__device__ __forceinline__ void ph_od_out(const PArgs& a, Frame& F) { for (int u = F.bid; u < NB * NCHUNK; u += F.G) ssd_out3(a, F, u / NCHUNK, u % NCHUNK); }
__device__ __forceinline__ void ph_od_scan(const PArgs& a, Frame& F) {
    unsigned char* ws = F.ws; const size_t gt = (size_t)F.bid * NTHR + F.tid, NT = (size_t)F.G * NTHR;
    for (size_t i = gt; i < (size_t)NB * 32 * 8192 / 4; i += NT) { const int b = (int)(i / (32 * 2048)), rem = (int)(i % (32 * 2048)), hd = rem / 2048, e4 = rem % 2048;
        f32x4 st = (f32x4){0.f, 0.f, 0.f, 0.f};
#pragma unroll 1
        for (int c0 = 0; c0 < NCHUNK; c0 += 8) { f32x4 loc[8]; float dec[8];
#pragma unroll
            for (int k = 0; k < 8; ++k) { const size_t u = (size_t)(b * NCHUNK + c0 + k) * 32 + hd; { const u32x2 lw = *(const u32x2*)((const bf16*)(ws + WS_SLOC) + u * 8192 + 4 * e4); loc[k] = (f32x4){bf2f(lw.x & 0xffffu), bf2f(lw.x >> 16), bf2f(lw.y & 0xffffu), bf2f(lw.y >> 16)}; } dec[k] = ((const float*)(ws + WS_SSD_ALAST))[u]; }
#pragma unroll
            for (int k = 0; k < 8; ++k) { const size_t u = (size_t)(b * NCHUNK + c0 + k) * 32 + hd;
                u32x2 w; w.x = pk2(st[0], st[1]); w.y = pk2(st[2], st[3]); *(u32x2*)((bf16*)(ws + WS_SST) + u * 8192 + 4 * e4) = w;
                st = st * __expf(dec[k]) + loc[k]; } } }
}

__device__ __forceinline__ int moe_tables(Frame& F, int l) {
    LAS int* tab = (LAS int*)(F.lds + L_SCHED);
    __syncthreads();
    if (F.tid == 0) { int o = 0, ts = 0; for (int e = 0; e < NE; ++e) { const int cnt = (int)F.ctl[CW_CNT + l * 2048 + e * 64]; tab[e] = cnt; tab[32 + e] = o; tab[65 + e] = ts; o += cnt; ts += (cnt + 255) >> 8; } tab[64] = o; tab[97] = ts; }
    __syncthreads();
    return tab[97];
}
__device__ __forceinline__ void ph_moe1(const PArgs& a, Frame& F, int l) {
    const int ntiles = moe_tables(F, l);
    pg8::MoeSched<true, 8, 4> S; S.A = (const void*)(F.ws + WS_U); S.Bt = (const void*)(F.ws + WS_WGU + (size_t)l * 32 * 2048 * D); S.rowtok = (const int*)(F.ws + WS_ROWTOK);
    S.PB = D; S.G = F.G; S.c = F.bid; S.ntiles = ntiles; S.tab = (const LAS int*)(F.lds + L_SCHED); S.bstride = 2048;
    pg8::EpiSwiglu E{(unsigned char*)(F.ws + WS_ACT), a.in[37] + (size_t)l * 32 * 2048, (unsigned char*)(F.ws + WS_DUMMY) + F.tid * 16};
    pg8::gemm_phase<pg8::EpiSwiglu, pg8::MoeSched<true, 8, 4>, true>(F.lds, S, E);
}
__device__ __forceinline__ void ph_moe2(const PArgs& a, Frame& F, int l) {
    const int ntiles = moe_tables(F, l);
    pg8::MoeSched<false, 4, 8> S; S.A = (const void*)(F.ws + WS_ACT); S.Bt = (const void*)(F.ws + WS_WDN + (size_t)l * 32 * D * DFF); S.rowtok = nullptr;
    S.PB = DFF; S.G = F.G; S.c = F.bid; S.ntiles = ntiles; S.tab = (const LAS int*)(F.lds + L_SCHED); S.bstride = 1024;
    pg8::EpiDown E{(unsigned char*)(F.ws + WS_YBUF), a.in[39] + (size_t)l * 32 * D, (const float*)(F.ws + WS_ROWGATE), (unsigned char*)(F.ws + WS_DUMMY) + F.tid * 16};
    pg8::gemm_phase<pg8::EpiDown, pg8::MoeSched<false, 4, 8>, true>(F.lds, S, E);
}
__device__ __forceinline__ void ph_gemm_plain_bf16(Frame& F, size_t wsA, size_t wsB, int N, int K, size_t wsO) {
    pg8::PlainSched S; S.init((const bf16*)(F.ws + wsA), (const bf16*)(F.ws + wsB), MTOK, N, K, F.G, F.bid);
    pg8::EpiBf16 E{(bf16*)(F.ws + wsO), N, 1.0f};
    pg8::gemm_phase<pg8::EpiBf16, pg8::PlainSched>(F.lds, S, E);
}
__device__ __forceinline__ void ph_gemm_plain_fp8(Frame& F, size_t wsA, size_t wsB, int N, int K, size_t wsO) {
    pg8::PlainSched S; S.init((const void*)(F.ws + wsA), (const void*)(F.ws + wsB), MTOK, N, K, F.G, F.bid, 1);
    pg8::EpiBf16 E{(bf16*)(F.ws + wsO), N, pg8::WINV8};
    pg8::gemm_phase<pg8::EpiBf16, pg8::PlainSched, true>(F.lds, S, E);
}
template <bool HIN_F32>
__device__ __forceinline__ void ph_gemm_resid(Frame& F, size_t wsB, const GAS void* hin, bf16* hout, int l) {
    pg8::PlainSched S; S.init((const bf16*)(F.ws + WS_MIX), (const bf16*)(F.ws + wsB), MTOK, D, MIXW, F.G, F.bid);
    pg8::EpiResid<HIN_F32> E{hin, hout, (const float*)(F.ws + WS_MODF) + (size_t)l * 8 * 6144 + 2048};
    pg8::gemm_phase<pg8::EpiResid<HIN_F32>, pg8::PlainSched>(F.lds, S, E);
}

__global__ void __launch_bounds__(NTHR, 2) mk_fwd(Args args) {
    extern __shared__ __attribute__((aligned(16))) unsigned char lds_[];
    Frame F;
    F.lds = (LAS unsigned char*)lds_; F.tid = threadIdx.x; F.lane = F.tid & 63; F.wave = __builtin_amdgcn_readfirstlane(F.tid >> 6);
    F.G = gridDim.x; F.bid = blockIdx.x; F.ws = args.ws; F.ctl = (unsigned*)(args.ws + WS_CTL);
    const int lo = args.ph_lo, hi = args.ph_hi;
    volatile LAS unsigned* misc = (volatile LAS unsigned*)(F.lds + L_MISC);
    if (F.tid < 4) misc[F.tid] = 0u;
    __syncthreads();
    XcdBarrier bar; bar.bar = F.ctl + CW_BAR; bar.x = 0; bar.st = misc;
    if (hi - lo > 1) bar = xcd_barrier_post(F.ctl + CW_BAR, misc);
#define IN(k) (lo <= (k) && (k) < hi)
#define SEAM(k) do { if (IN(k) && IN((k) + 1)) xcd_barrier(bar); } while (0)
    bf16* H1 = (bf16*)(F.ws + WS_H1); bf16* H2 = (bf16*)(F.ws + WS_H2);
    PArgs pa; pa.in.p = (const float* const*)(const GAS unsigned char*)(F.ws + WS_ARGTAB);
    if (IN(0)) ph_prep(args, F);
    SEAM(0);
    if (IN(1)) ph_rows<0>(pa, F, 0);
    SEAM(1);
    if (IN(2)) ph_gemm_plain_bf16(F, WS_U, WS_WEVIN, EVEN_IN, D, WS_PROJ);
    SEAM(2);
    if (IN(3)) ph_ev_local(pa, F);
    SEAM(3);
    if (IN(4)) ph_ev_scan(pa, F);
    SEAM(4);
    if (IN(5)) ph_ev_out(pa, F);
    SEAM(5);
    if (IN(6)) ph_gemm_resid<true>(F, WS_WEVOUT, (const GAS void*)pa.in[0], H1, 0);
    SEAM(6);
    if (IN(7)) ph_route(pa, F, 0);
    SEAM(7);
    if (IN(8)) ph_moe1(pa, F, 0);
    SEAM(8);
    if (IN(9)) ph_moe2(pa, F, 0);
    SEAM(9);
    if (IN(10)) ph_rows<1>(pa, F, 0);
    SEAM(10);
    if (IN(11)) ph_gemm_plain_fp8(F, WS_U, WS_WODIN, OD_INP, D, WS_PROJ);
    SEAM(11);
    if (IN(12)) ph_od_local(pa, F);
    SEAM(12);
    if (IN(13)) ph_od_scan(pa, F);
    SEAM(13);
    if (IN(14)) ph_od_out(pa, F);
    SEAM(14);
    if (IN(15)) ph_gemm_resid<false>(F, WS_WODOUT, (const GAS void*)H2, H1, 1);
    SEAM(15);
    if (IN(16)) ph_route(pa, F, 1);
    SEAM(16);
    if (IN(17)) ph_moe1(pa, F, 1);
    SEAM(17);
    if (IN(18)) ph_moe2(pa, F, 1);
    SEAM(18);
    if (IN(19)) ph_rows<2>(pa, F, 1);
#undef IN
#undef SEAM
}

extern "C" void kernel_launch(void* const* d_in, const int* in_sizes, int n_in, void* d_out, int out_size, void* d_ws, size_t ws_size, hipStream_t stream) {
    static int grid = 0;
    if (grid == 0) {
        if (n_in != 41 || out_size != MTOK * D || ws_size < WS_END) { fprintf(stderr, "kernel_launch: unexpected shapes (n_in %d, out %d, ws %zu < %zu)\n", n_in, out_size, ws_size, (size_t)WS_END); grid = -1; return; }
        int dev = 0, cus = 0, per_cu = 0;
        if (hipGetDevice(&dev) != hipSuccess || hipDeviceGetAttribute(&cus, hipDeviceAttributeMultiprocessorCount, dev) != hipSuccess) { grid = -1; return; }
        if (hipFuncSetAttribute((const void*)mk_fwd, hipFuncAttributeMaxDynamicSharedMemorySize, LDS_BYTES) != hipSuccess) { fprintf(stderr, "kernel_launch: hipFuncSetAttribute failed\n"); grid = -1; return; }
        if (hipOccupancyMaxActiveBlocksPerMultiprocessor(&per_cu, (const void*)mk_fwd, NTHR, LDS_BYTES) != hipSuccess || per_cu < 1) fprintf(stderr, "kernel_launch: occupancy query says %d\n", per_cu);
        (void)hipGetLastError();
        grid = cus;
    }
    if (grid < 0) return;
    (void)hipMemsetAsync((char*)d_ws + WS_CTL, 0, CTL_ZERO_BYTES, stream);
    Args a{};
    for (int i = 0; i < 41; ++i) a.in[i] = (const float*)d_in[i];
    a.out = (float*)d_out; a.ws = (unsigned char*)d_ws;
#if MK_ONE_LAUNCH
    a.ph_lo = 0; a.ph_hi = NPH;
    hipLaunchKernelGGL(mk_fwd, dim3(grid), dim3(NTHR), LDS_BYTES, stream, a);
#else
    for (int k = 0; k < NPH; ++k) { a.ph_lo = k; a.ph_hi = k + 1; hipLaunchKernelGGL(mk_fwd, dim3(grid), dim3(NTHR), LDS_BYTES, stream, a); }
#endif
}
```

```cpp
#include <hip/hip_runtime.h>
#include <cstdio>
#include <cstdint>

#ifndef MK_ONE_LAUNCH
#define MK_ONE_LAUNCH 1
#endif

#define GAS __attribute__((address_space(1)))
#define LAS __attribute__((address_space(3)))
typedef unsigned short bf16;
typedef short bf16x8 __attribute__((ext_vector_type(8)));
typedef float f32x4 __attribute__((ext_vector_type(4)));
typedef unsigned u32x4 __attribute__((ext_vector_type(4)));
typedef unsigned u32x2 __attribute__((ext_vector_type(2)));
typedef int i32x8 __attribute__((ext_vector_type(8)));
typedef int i32x4 __attribute__((ext_vector_type(4)));

constexpr int NB = 8, SEQ = 4096, D = 1024, MTOK = NB * SEQ, CH = 128, NCHUNK = SEQ / CH;
constexpr int EVEN_IN = 4096, OD_IN = 6176, OD_INP = 6400, MIXW = 2048;
constexpr int NE = 32, TOPK = 4, DFF = 1024, ECAP = MTOK;
constexpr float EPS = 1e-6f;
constexpr int NWAVES = 8, NTHR = 512;
constexpr int NPH = 20;

constexpr size_t MiB = 1u << 20;
constexpr size_t WS_CTL = 0, CTL_ZERO_BYTES = 128 * 1024;
constexpr size_t WS_MODP = 1 * MiB;
constexpr size_t WS_MODF = 7 * MiB;
constexpr size_t WS_LRUW = 8 * MiB;
constexpr size_t WS_GATEW = 8 * MiB + 512 * 1024;
constexpr size_t WS_ROUTW = 8 * MiB + 768 * 1024;
constexpr size_t WS_ROWTOK = 9 * MiB;
constexpr size_t WS_ROWGATE = 13 * MiB;
constexpr size_t WS_TOKSLOT = 17 * MiB;
constexpr size_t WS_LRU_AT = 18 * MiB, WS_LRU_HT = 19 * MiB, WS_LRU_CARRY = 20 * MiB;
constexpr size_t WS_ML_G = 21 * MiB, WS_ML_B = 22 * MiB;
constexpr size_t WS_ML_NLOC = 23 * MiB, WS_ML_NST = 24 * MiB;
constexpr size_t WS_ML_GT = 25 * MiB, WS_ML_ML = 25 * MiB + 65536, WS_ML_MS = 25 * MiB + 131072;
constexpr size_t WS_SSD_ALAST = 26 * MiB;
constexpr size_t WS_ARGTAB = 27 * MiB;
constexpr size_t WS_DUMMY = 27 * MiB + 65536;
constexpr size_t WS_WEVIN = 28 * MiB, WS_WEVOUT = 36 * MiB, WS_WODIN = 40 * MiB, WS_WODOUT = 53 * MiB;
constexpr size_t WS_WGU = 64 * MiB, WS_WDN = 320 * MiB;
constexpr size_t WS_U = 448 * MiB, WS_H1 = 512 * MiB, WS_H2 = 640 * MiB, WS_MIX = 768 * MiB;
constexpr size_t WS_PROJ = 896 * MiB, WS_ACT = WS_PROJ;
constexpr size_t WS_LRU_HL = 1152 * MiB, WS_LRU_PC = 1216 * MiB;
constexpr size_t WS_ST = 1296 * MiB;
constexpr size_t WS_CLOC = WS_ST, WS_CST = WS_ST + 128 * MiB;
constexpr size_t WS_SLOC = WS_ST, WS_SST = WS_ST + 256 * MiB;
constexpr size_t WS_YBUF = WS_ST;
constexpr size_t WS_XC = 1680 * MiB, WS_QG = 1744 * MiB, WS_KG = 1808 * MiB, WS_VG = 1872 * MiB;
constexpr size_t WS_XBC = 1680 * MiB;
constexpr size_t WS_DTG = 1936 * MiB, WS_ACG = 1940 * MiB;
constexpr size_t WS_END = 1944 * MiB;
constexpr int CW_BAR = 4096;
constexpr int CW_CNT = 16384;

constexpr int LDS_BYTES = 163840;
constexpr int L_MISC = LDS_BYTES - 256;
constexpr int L_SCHED = 135168;
constexpr int RLD = 272;
constexpr int L_RAW = 0, L_T0 = 35840, L_T1 = 70656, L_T2 = 105472, L_SM = 140288;
constexpr int L_TOK = 136192, L_EPI = 144384;
constexpr int L_DT = L_T2 + 17408, L_AC = L_DT + 16384;

typedef __bf16 bf16v2_t __attribute__((ext_vector_type(2)));
typedef float f32x2_t __attribute__((ext_vector_type(2)));
__device__ __forceinline__ unsigned pk2(float lo, float hi) { const f32x2_t f = {lo, hi}; return __builtin_bit_cast(unsigned, __builtin_convertvector(f, bf16v2_t)); }
__device__ __forceinline__ unsigned f2bf(float f) { return (unsigned)__builtin_bit_cast(unsigned short, (__bf16)f); }
__device__ __forceinline__ float bf2f(unsigned h) { return __builtin_bit_cast(float, h << 16); }
__device__ __forceinline__ float frcp(float x) { return __builtin_amdgcn_rcpf(x); }
__device__ __forceinline__ float sigmoidf_(float x) { return frcp(1.0f + __expf(-x)); }
__device__ __forceinline__ float siluf_(float x) { return x * frcp(1.0f + __expf(-x)); }
__device__ __forceinline__ float softplusf_(float x) { return x > 20.0f ? x : log1pf(__expf(x)); }
__device__ __forceinline__ float logsigmoidf_(float x) { return fminf(x, 0.0f) - log1pf(__expf(-fabsf(x))); }
__device__ __forceinline__ float gelu_tanh(float x) { const float y = 0.7978845608028654f * (x + 0.044715f * x * x * x); const float t = 1.0f - 2.0f * frcp(__expf(2.0f * y) + 1.0f); return 0.5f * x * (1.0f + t); }
__device__ __forceinline__ unsigned pk4_fp8(float a, float b, float c, float d) { int p = __builtin_amdgcn_cvt_pk_fp8_f32(a, b, 0, false); p = __builtin_amdgcn_cvt_pk_fp8_f32(c, d, p, true); return (unsigned)p; }
#define MFMA16(a, b, c) __builtin_amdgcn_mfma_f32_16x16x32_bf16((a), (b), (c), 0, 0, 0)
#define LFRAG(base, row, kel) (*(const LAS bf16x8*)((base) + (row) * RLD + (kel) * 2))
__device__ __forceinline__ float wave_sum(float v) {
#pragma unroll
    for (int o = 1; o < 64; o <<= 1) v += __shfl_xor(v, o);
    return v;
}
__device__ __forceinline__ float red16(float v) { v += __shfl_xor(v, 1); v += __shfl_xor(v, 2); v += __shfl_xor(v, 4); v += __shfl_xor(v, 8); return v; }

#define XB_TMO      128
#define XB_XCNT(j)  (256  + 64 * (j))
#define XB_XSUB(j)  (1280 + 64 * (j))
#define XB_XGEN(j)  (2304 + 64 * (j))
#define XB_TOP      3328
#define XB_TOPGEN   3392
#define XCD_BAR_WORDS 3456
#define XB_SPIN_CAP (1u << 18)
__device__ __forceinline__ unsigned xb_ld(unsigned* p)              { return __hip_atomic_load(p, __ATOMIC_RELAXED, __HIP_MEMORY_SCOPE_AGENT); }
__device__ __forceinline__ unsigned xb_add(unsigned* p, unsigned v) { return __hip_atomic_fetch_add(p, v, __ATOMIC_RELAXED, __HIP_MEMORY_SCOPE_AGENT); }
__device__ __forceinline__ unsigned xb_xcc_id() { return (unsigned)__builtin_amdgcn_s_getreg((3 << 11) | 20) & 0xFu; }
#define XB_SPIN(cond, bar) do { unsigned _sp = 0; while (cond) { __builtin_amdgcn_s_sleep(1); \
    if ((++_sp & 255u) == 0u) { if (xb_ld(&(bar)[XB_TMO])) break; if (_sp > XB_SPIN_CAP) { atomicAdd(&(bar)[XB_TMO], 1u); break; } } } } while (0)
struct XcdBarrier { unsigned* bar; unsigned x; volatile LAS unsigned* st; };
__device__ __forceinline__ XcdBarrier xcd_barrier_post(unsigned* bar, volatile LAS unsigned* st) {
    XcdBarrier b; b.bar = bar; b.x = xb_xcc_id(); b.st = st;
    if (threadIdx.x == 0) (void)xb_add(&bar[XB_XCNT(b.x)], 1u);
    return b;
}
__device__ __forceinline__ void xcd_barrier_complete(unsigned* bar, unsigned x, unsigned& nloc, unsigned& nx) {
    const unsigned G = gridDim.x * gridDim.y * gridDim.z;
    unsigned sum, cnt, mine, sp = 0u;
    for (;;) {
        sum = 0u; cnt = 0u; mine = 0u;
#pragma unroll
        for (unsigned j = 0; j < 16; ++j) { const unsigned c = xb_ld(&bar[XB_XCNT(j)]); sum += c; cnt += (c > 0u) ? 1u : 0u; mine = (j == x) ? c : mine; }
        if (sum == G) break;
        __builtin_amdgcn_s_sleep(1);
        if ((++sp & 255u) == 0u) { if (xb_ld(&bar[XB_TMO])) break; if (sp > XB_SPIN_CAP) { atomicAdd(&bar[XB_TMO], 1u); break; } }
    }
    nloc = mine > 0u ? mine : 1u; nx = cnt > 0u ? cnt : 1u;
}
__device__ __forceinline__ void xcd_barrier(const XcdBarrier& b) {
    asm volatile("s_waitcnt vmcnt(0)" ::: "memory");
    __syncthreads();
    if (threadIdx.x == 0) {
        unsigned* bar = b.bar;
        __builtin_amdgcn_s_waitcnt(0);
        unsigned nloc = b.st[0], nx = b.st[1];
        if (nloc == 0u) { xcd_barrier_complete(bar, b.x, nloc, nx); b.st[0] = nloc; b.st[1] = nx; }
        const unsigned old = xb_add(&bar[XB_XSUB(b.x)], 1u);
        const unsigned gen = old / nloc;
        if (old + 1u == (gen + 1u) * nloc) {
            __builtin_amdgcn_fence(__ATOMIC_RELEASE, "agent");
            asm volatile("s_waitcnt vmcnt(0)" ::: "memory");
            const unsigned og = xb_add(&bar[XB_TOP], 1u);
            const unsigned tg = og / nx;
            if (og + 1u == (tg + 1u) * nx) xb_add(&bar[XB_TOPGEN], 1u);
            else XB_SPIN(xb_ld(&bar[XB_TOPGEN]) == tg, bar);
            __builtin_amdgcn_fence(__ATOMIC_ACQUIRE, "agent");
            xb_add(&bar[XB_XGEN(b.x)], 1u);
            asm volatile("s_waitcnt vmcnt(0)" ::: "memory");
        } else {
            XB_SPIN(xb_ld(&bar[XB_XGEN(b.x)]) == gen, bar);
            __builtin_amdgcn_fence(__ATOMIC_ACQUIRE, "agent");
            asm volatile("s_waitcnt vmcnt(0)" ::: "memory");
        }
    }
    __syncthreads();
}

struct Args { const float* in[41]; float* out; unsigned char* ws; int ph_lo, ph_hi; };
struct InTab { const float* const* p; __device__ __forceinline__ const GAS float* operator[](int k) const { return (const GAS float*)p[k]; } };
__device__ __forceinline__ const GAS float* uptr(const GAS float* p) { const unsigned long long v = (unsigned long long)p; const unsigned lo = __builtin_amdgcn_readfirstlane((unsigned)v), hi = __builtin_amdgcn_readfirstlane((unsigned)(v >> 32)); return (const GAS float*)(((unsigned long long)hi << 32) | lo); }
struct PArgs { InTab in; };
struct Frame { LAS unsigned char* lds; int tid, lane, wave, G, bid; unsigned char* ws; unsigned* ctl; };
__device__ __forceinline__ Frame relaunder(const Frame& F0) { Frame F = F0; int tz = F0.tid; asm volatile("" : "+v"(tz)); F.tid = tz; F.lane = tz & 63; F.wave = __builtin_amdgcn_readfirstlane(tz >> 6); return F; }
extern __shared__ __attribute__((aligned(16))) unsigned char lds_nl[];
__device__ __forceinline__ Frame make_frame(unsigned char* ws) { Frame F; F.lds = (LAS unsigned char*)lds_nl; F.tid = threadIdx.x; F.lane = F.tid & 63; F.wave = __builtin_amdgcn_readfirstlane(F.tid >> 6); F.G = gridDim.x; F.bid = blockIdx.x; F.ws = ws; F.ctl = (unsigned*)(ws + WS_CTL); return F; }

namespace pg8 {
constexpr int BM = 256, BK = 64, HALF = 128, HTB = HALF * BK * 2, STAGE_BYTES = 8 * HTB, NXCD = 8, WGM = 8;
__host__ __device__ __forceinline__ int lds_byte(int r, int c) { const int ch = c >> 3; return (r >> 3) * 1024 + (r & 7) * 128 + ((ch ^ (r & 7)) << 4) + (c & 7) * 2; }
__host__ __device__ __forceinline__ void stage_rc(int b, int& R, int& C) { const int piece = b >> 10, rip = (b >> 7) & 7, slot = (b >> 4) & 7; R = piece * 8 + rip; C = ((slot ^ rip) << 3); }
__host__ __device__ __forceinline__ int perm32(int rho) { const int n = rho >> 4, i = rho & 15; return 8 * (i >> 2) + 4 * n + (i & 3); }
__device__ __forceinline__ unsigned cvt_pk_bf16(float lo, float hi) { return pk2(lo, hi); }

struct Unit { int pm, pn, e, valid, rowbase; };

struct PlainSched {
    static constexpr bool GATHER = false;
    const bf16* A; const bf16* Bt; int PB, nM, nN, nwg, G, c;
    __device__ void init(const void* A_, const void* Bt_, int M, int N, int K_, int G_, int c_, int elem_bytes = 2) { A = (const bf16*)A_; Bt = (const bf16*)Bt_; PB = elem_bytes * K_; nM = M / BM; nN = N / BM; nwg = nM * nN; G = G_; c = c_; }
    __device__ __forceinline__ bool next(int i, Unit& u) const {
        const long L = (long)i * G + c; if (L >= nwg) return false;
        int wgid = (int)L; { const int q = nwg / NXCD, r = nwg % NXCD, xcd = wgid % NXCD, off = wgid / NXCD; wgid = (xcd < r ? xcd * (q + 1) : r * (q + 1) + (xcd - r) * q) + off; }
        const int nig = WGM * nN, gid = wgid / nig, fm = gid * WGM, gsz = (nM - fm) < WGM ? (nM - fm) : WGM;
        u.pm = fm + ((wgid % nig) % gsz); u.pn = (wgid % nig) / gsz; u.e = 0; u.valid = 256; u.rowbase = u.pm * 256; return true;
    }
    __device__ __forceinline__ const char* abase(const Unit& u) const { return (const char*)A + (size_t)u.pm * 256 * PB; }
    __device__ __forceinline__ const char* bbase(const Unit& u) const { return (const char*)Bt + (size_t)u.pn * 256 * PB; }
};
template <bool GATHER_, int NT_  , int MB_  >
struct MoeSched {
    static constexpr bool GATHER = GATHER_;
    const void* A; const void* Bt; const int* rowtok; int PB, G, c, ntiles; const LAS int* tab; size_t bstride;
    __device__ __forceinline__ bool next(int i, Unit& u) const {
        int blk, j;
        if (G == 256) { blk = i * 8 + (c & 7); j = c >> 3; } else { const long U = (long)i * G + c; blk = (int)(U >> 5); j = (int)(U & 31); }
        const int nblk = (ntiles + MB_ - 1) / MB_;
        if (blk >= nblk) return false;
        const int mtg = blk * MB_ + (j % MB_); u.pn = j / MB_;
        if (mtg >= ntiles) { u.e = -1; u.pm = 0; u.valid = 0; u.rowbase = 0; return true; }
        const int lane31 = (int)__builtin_amdgcn_mbcnt_lo(~0u, 0u) & 31;
        const unsigned mle = (unsigned)__ballot(tab[65 + lane31] <= mtg);
        const int e = 31 - __builtin_clz(mle);
        u.e = e; u.pm = mtg - __builtin_amdgcn_readfirstlane(tab[65 + e]);
        const int cnt = __builtin_amdgcn_readfirstlane(tab[e]); const int v = cnt - u.pm * 256; u.valid = v < 256 ? v : 256; u.rowbase = __builtin_amdgcn_readfirstlane(tab[32 + e]) + u.pm * 256; return true;
    }
    __device__ __forceinline__ const char* abase(const Unit& u) const { return GATHER_ ? (const char*)A : (const char*)A + (size_t)u.rowbase * PB; }
    __device__ __forceinline__ const char* bbase(const Unit& u) const { return (const char*)Bt + ((size_t)u.e * bstride + (size_t)u.pn * 256) * PB; }
};

struct EpiBf16 {
    static constexpr bool PERM = true; static constexpr int NSTORES = 16;
    bf16* O; int ldc; float scale;
    __device__ __forceinline__ void operator()(const f32x4 (&acc)[2][2][4][2], const Unit& u, int wr, int wc, int fr, int fq) const {
        const int row0 = u.pm * BM + wr * 64 + fr, col0 = u.pn * BM + wc * 32 + 8 * fq;
#pragma unroll
        for (int ai = 0; ai < 2; ++ai)
#pragma unroll
            for (int m = 0; m < 4; ++m) { bf16* rowp = O + (size_t)(row0 + ai * HALF + m * 16) * ldc + col0;
#pragma unroll
                for (int bj = 0; bj < 2; ++bj) { const f32x4 v0 = acc[ai][bj][m][0] * scale, v1 = acc[ai][bj][m][1] * scale;
                    u32x4 w; w.x = cvt_pk_bf16(v0[0], v0[1]); w.y = cvt_pk_bf16(v0[2], v0[3]); w.z = cvt_pk_bf16(v1[0], v1[1]); w.w = cvt_pk_bf16(v1[2], v1[3]);
                    *(u32x4*)(rowp + bj * HALF) = w; } }
    }
};
template <bool HIN_F32>
struct EpiResid {
    static constexpr bool PERM = true; static constexpr int NSTORES = 16;
    const GAS void* hin; bf16* out; const float* gvec;
    __device__ __forceinline__ void operator()(const f32x4 (&acc)[2][2][4][2], const Unit& u, int wr, int wc, int fr, int fq) const {
        const int row0 = u.pm * BM + wr * 64 + fr, col0 = u.pn * BM + wc * 32 + 8 * fq;
        const float* gb = gvec + (size_t)((u.pm * BM) / SEQ) * 6144 + col0;
        f32x4 gv[2][2];
#pragma unroll
        for (int bj = 0; bj < 2; ++bj)
#pragma unroll
            for (int n = 0; n < 2; ++n) gv[bj][n] = *(const f32x4*)(gb + bj * HALF + 4 * n);
#pragma unroll
        for (int ai = 0; ai < 2; ++ai)
#pragma unroll
            for (int m = 0; m < 4; ++m) { const size_t off = (size_t)(row0 + ai * HALF + m * 16) * D + col0;
#pragma unroll
                for (int bj = 0; bj < 2; ++bj) { f32x4 h0, h1;
                    if (HIN_F32) { h0 = *(const GAS f32x4*)((const GAS float*)hin + off + bj * HALF); h1 = *(const GAS f32x4*)((const GAS float*)hin + off + bj * HALF + 4); }
                    else { const u32x4 hw = *(const GAS u32x4*)((const GAS bf16*)hin + off + bj * HALF); h0 = (f32x4){bf2f(hw.x & 0xffffu), bf2f(hw.x >> 16), bf2f(hw.y & 0xffffu), bf2f(hw.y >> 16)}; h1 = (f32x4){bf2f(hw.z & 0xffffu), bf2f(hw.z >> 16), bf2f(hw.w & 0xffffu), bf2f(hw.w >> 16)}; }
                    const f32x4 v0 = h0 + gv[bj][0] * acc[ai][bj][m][0], v1 = h1 + gv[bj][1] * acc[ai][bj][m][1];
                    u32x4 w; w.x = cvt_pk_bf16(v0[0], v0[1]); w.y = cvt_pk_bf16(v0[2], v0[3]); w.z = cvt_pk_bf16(v1[0], v1[1]); w.w = cvt_pk_bf16(v1[2], v1[3]);
                    *(u32x4*)(out + off + bj * HALF) = w; } }
    }
};
constexpr float WSCALE8 = 32.0f, WINV8 = 1.0f / 32.0f;
struct EpiSwiglu {
    static constexpr bool PERM = true; static constexpr int NSTORES = 8;
    unsigned char* act; const GAS float* bgu; unsigned char* sink;
    __device__ __forceinline__ void operator()(const f32x4 (&acc)[2][2][4][2], const Unit& u, int wr, int wc, int fr, int fq) const {
        const int cc = u.pn * 128 + wc * 32 + 8 * fq;
        const GAS float* bb = bgu + (size_t)u.e * 2048 + cc;
        const f32x4 bg0 = *(const f32x4*)(bb), bg1 = *(const f32x4*)(bb + 4), bl0 = *(const f32x4*)(bb + 1024), bl1 = *(const f32x4*)(bb + 1028);
#pragma unroll
        for (int ai = 0; ai < 2; ++ai)
#pragma unroll
            for (int m = 0; m < 4; ++m) { const int r = ai * HALF + wr * 64 + m * 16 + fr;
                float o[8];
#pragma unroll
                for (int n = 0; n < 2; ++n)
#pragma unroll
                    for (int j = 0; j < 4; ++j) { float g = acc[ai][0][m][n][j] * WINV8 + (n ? bg1[j] : bg0[j]); float li = acc[ai][1][m][n][j] * WINV8 + (n ? bl1[j] : bl0[j]);
                        g = fminf(g, 7.0f); li = fminf(fmaxf(li, -7.0f), 7.0f);
                        o[n * 4 + j] = g * __builtin_amdgcn_rcpf(1.0f + __expf(-1.702f * g)) * (li + 1.0f); }
                u32x2 w; w.x = pk4_fp8(o[0], o[1], o[2], o[3]); w.y = pk4_fp8(o[4], o[5], o[6], o[7]);
                unsigned char* dst = (r < u.valid) ? act + (size_t)(u.rowbase + r) * DFF + cc : sink;
                *(u32x2*)dst = w; }
    }
};
constexpr float YSCALE8 = 16.0f, YINV8 = 1.0f / 16.0f;
struct EpiDown {
    static constexpr bool PERM = true; static constexpr int NSTORES = 16;
    unsigned char* y; const GAS float* bdn; const float* rowgate; unsigned char* sink;
    __device__ __forceinline__ void operator()(const f32x4 (&acc)[2][2][4][2], const Unit& u, int wr, int wc, int fr, int fq) const {
        const int col0 = u.pn * BM + wc * 32 + 8 * fq;
        const GAS float* bb = bdn + (size_t)u.e * D + col0;
        f32x4 bv[2][2];
#pragma unroll
        for (int bj = 0; bj < 2; ++bj)
#pragma unroll
            for (int n = 0; n < 2; ++n) bv[bj][n] = *(const f32x4*)(bb + bj * HALF + 4 * n);
        const float* gp = rowgate + (size_t)u.e * ECAP + u.pm * 256 + wr * 64 + fr;
        float gts[2][4];
#pragma unroll
        for (int ai = 0; ai < 2; ++ai)
#pragma unroll
            for (int m = 0; m < 4; ++m) gts[ai][m] = gp[ai * HALF + m * 16];
#pragma unroll
        for (int ai = 0; ai < 2; ++ai)
#pragma unroll
            for (int m = 0; m < 4; ++m) { const int r = ai * HALF + wr * 64 + m * 16 + fr; const float gt = gts[ai][m] * YSCALE8; unsigned char* rowp = y + (size_t)(u.rowbase + r) * D + col0;
#pragma unroll
                for (int bj = 0; bj < 2; ++bj) { const f32x4 v0 = (acc[ai][bj][m][0] * WINV8 + bv[bj][0]) * gt, v1 = (acc[ai][bj][m][1] * WINV8 + bv[bj][1]) * gt;
                    u32x2 w; w.x = pk4_fp8(v0[0], v0[1], v0[2], v0[3]); w.y = pk4_fp8(v1[0], v1[1], v1[2], v1[3]);
                    *(u32x2*)((r < u.valid) ? rowp + bj * HALF : sink + 8 * bj) = w; } }
    }
};

template <class Epi, class Sched, bool FP8 = false>
__device__ __forceinline__ void gemm_phase(LAS unsigned char* lds, const Sched& S, const Epi& E) {
    const int tid = threadIdx.x, wid = __builtin_amdgcn_readfirstlane(tid >> 6), lane = tid & 63, wr = wid >> 2, wc = wid & 3, fr = lane & 15, fq = lane >> 4;
    const int PB = S.PB, nt = PB / 128;
    unsigned voffB[2], voffA0[2];
#pragma unroll
    for (int i = 0; i < 2; ++i) { int R, C; stage_rc(tid * 16 + i * 8192, R, C); const int Rb = Epi::PERM ? ((R & ~31) + perm32(R & 31)) : R;
        voffA0[i] = (unsigned)(R * PB + 2 * C); voffB[i] = (unsigned)(Rb * PB + 2 * C); }
    const size_t kstep = (size_t)(BK * 2);
    const size_t hstep = (size_t)HALF * PB;
    const unsigned ldsw = (unsigned)wid * 1024u;
    const int aoff0 = FP8 ? lds_byte(wr * 64 + fr, 16 * fq) : lds_byte(wr * 64 + fr, fq * 8), boff0 = FP8 ? lds_byte(wc * 32 + fr, 16 * fq) : lds_byte(wc * 32 + fr, fq * 8);
    const int aoff1 = FP8 ? lds_byte(wr * 64 + fr, 16 * fq + 8) : lds_byte(wr * 64 + fr, fq * 8 + 32), boff1 = FP8 ? lds_byte(wc * 32 + fr, 16 * fq + 8) : lds_byte(wc * 32 + fr, fq * 8 + 32);
#define PG8_SA(b, h) (((b) * 2 + (h)) * HTB)
#define PG8_SB(b, h) ((4 + (b) * 2 + (h)) * HTB)
#define PG8_STAGE(bufoff, gbase, voff) do { _Pragma("unroll") for (int _i = 0; _i < 2; ++_i) \
        __builtin_amdgcn_global_load_lds((const unsigned*)((const char*)(gbase) + (voff)[_i]), (LAS unsigned*)(lds + (bufoff) + ldsw + _i * 8192), 16, 0, 0); } while (0)
#define PG8_LDA(dst, b, h) do { _Pragma("unroll") for (int m = 0; m < 4; ++m) { const i32x4 _l0 = *(const LAS i32x4*)(lds + PG8_SA(b, h) + aoff0 + m * 2048), _l1 = *(const LAS i32x4*)(lds + PG8_SA(b, h) + aoff1 + m * 2048); \
        dst[m] = __builtin_shufflevector(_l0, _l1, 0, 1, 2, 3, 4, 5, 6, 7); } } while (0)
#define PG8_LDB(dst, b, h) do { _Pragma("unroll") for (int n = 0; n < 2; ++n) { const i32x4 _l0 = *(const LAS i32x4*)(lds + PG8_SB(b, h) + boff0 + n * 2048), _l1 = *(const LAS i32x4*)(lds + PG8_SB(b, h) + boff1 + n * 2048); \
        dst[n] = __builtin_shufflevector(_l0, _l1, 0, 1, 2, 3, 4, 5, 6, 7); } } while (0)
#define PG8_MMA(ai, bj, At, Bt) do { __builtin_amdgcn_s_setprio(1); _Pragma("unroll") for (int m = 0; m < 4; ++m) _Pragma("unroll") for (int n = 0; n < 2; ++n) { \
        if constexpr (FP8) { asm volatile("v_mfma_scale_f32_16x16x128_f8f6f4 %0, %1, %2, %0, %3, %3 op_sel_hi:[0,0,0]" : "+v"(acc[ai][bj][m][n]) : "v"(Bt[n]), "v"(At[m]), "v"(scl8)); } \
        else { acc[ai][bj][m][n] = __builtin_amdgcn_mfma_f32_16x16x32_bf16(__builtin_bit_cast(bf16x8, __builtin_shufflevector(Bt[n], Bt[n], 0, 1, 2, 3)), __builtin_bit_cast(bf16x8, __builtin_shufflevector(At[m], At[m], 0, 1, 2, 3)), acc[ai][bj][m][n], 0, 0, 0); \
               acc[ai][bj][m][n] = __builtin_amdgcn_mfma_f32_16x16x32_bf16(__builtin_bit_cast(bf16x8, __builtin_shufflevector(Bt[n], Bt[n], 4, 5, 6, 7)), __builtin_bit_cast(bf16x8, __builtin_shufflevector(At[m], At[m], 4, 5, 6, 7)), acc[ai][bj][m][n], 0, 0, 0); } } \
        __builtin_amdgcn_s_setprio(0); } while (0)
#define PG8_WAIT_V(n) asm volatile("s_waitcnt vmcnt(" #n ")" ::: "memory")
#define PG8_WAIT_VN(n) asm volatile("s_waitcnt vmcnt(%0)" :: "n"(n) : "memory")
#define PG8_WAIT_L(n) asm volatile("s_waitcnt lgkmcnt(" #n ")" ::: "memory")
#define PG8_BAR __builtin_amdgcn_s_barrier()
#define PG8_SCHED __builtin_amdgcn_sched_barrier(0)
#define PG8_AOFFS(u, dst) do { if constexpr (Sched::GATHER) { int _tz = threadIdx.x; asm volatile("" : "+v"(_tz)); _Pragma("unroll") for (int _h = 0; _h < 2; ++_h) _Pragma("unroll") for (int _i = 0; _i < 2; ++_i) { \
            int _R, _C; stage_rc(_tz * 16 + _i * 8192, _R, _C); const int _r = _h * HALF + _R; const int _tk = S.rowtok[(size_t)(u).e * ECAP + (u).pm * 256 + (_r < (u).valid ? _r : (u).valid - 1)]; dst[_h][_i] = (unsigned)(_tk * PB + 2 * _C); } } \
        else { _Pragma("unroll") for (int _i = 0; _i < 2; ++_i) { dst[0][_i] = voffA0[_i]; dst[1][_i] = voffA0[_i] + (unsigned)hstep; } } } while (0)
    Unit cur, nxt; int ui = 0;
    for (;;) { if (!S.next(ui, cur)) return; if (cur.e >= 0) break; ++ui; }
    f32x4 acc[2][2][4][2];
#pragma unroll
    for (int a = 0; a < 2; ++a)
#pragma unroll
        for (int b = 0; b < 2; ++b)
#pragma unroll
            for (int m = 0; m < 4; ++m)
#pragma unroll
                for (int n = 0; n < 2; ++n) { acc[a][b][m][n] = (f32x4){0.f, 0.f, 0.f, 0.f}; asm volatile("" : "+v"(acc[a][b][m][n])); }
    unsigned scl8 = 0x7f7f7f7fu; asm volatile("" : "+v"(scl8));
    i32x8 At[4], B0[2], B1[2];
    const char* cA = S.abase(cur); const char* cB = S.bbase(cur);
    unsigned cO[2][2];
    PG8_AOFFS(cur, cO);
    constexpr bool EARLY = FP8;
    static_assert(EARLY || !Sched::GATHER, "the gathered-A path assumes the peeled first trip");
    if constexpr (EARLY) {
        PG8_STAGE(PG8_SB(0, 0), cB, voffB); PG8_STAGE(PG8_SB(0, 1), cB + hstep, voffB); PG8_STAGE(PG8_SA(0, 0), cA, cO[0]); PG8_STAGE(PG8_SA(0, 1), cA, cO[1]);
        PG8_STAGE(PG8_SB(1, 0), cB + kstep, voffB); PG8_STAGE(PG8_SB(1, 1), cB + hstep + kstep, voffB); PG8_STAGE(PG8_SA(1, 0), cA + kstep, cO[0]); PG8_STAGE(PG8_SA(1, 1), cA + kstep, cO[1]);
        if (wr == 1) PG8_BAR;
        PG8_WAIT_V(0); PG8_BAR;
        PG8_WAIT_V(0); PG8_BAR;
    } else {
        PG8_STAGE(PG8_SB(0, 0), cB, voffB); PG8_STAGE(PG8_SB(0, 1), cB + hstep, voffB); PG8_STAGE(PG8_SA(0, 0), cA, cO[0]); PG8_STAGE(PG8_SA(0, 1), cA, cO[1]);
        if (wr == 1) PG8_BAR;
        PG8_WAIT_V(2); PG8_BAR;
        PG8_STAGE(PG8_SB(1, 0), cB + kstep, voffB); PG8_STAGE(PG8_SA(1, 0), cA + kstep, cO[0]); PG8_STAGE(PG8_SB(1, 1), cB + hstep + kstep, voffB);
        PG8_WAIT_V(6); PG8_BAR;
    }
    constexpr int WX = 8 + Epi::NSTORES + (Sched::GATHER ? 4 : 0);
    for (;;) {
        int uj = ui + 1; bool has_next;
        for (;;) { has_next = S.next(uj, nxt); if (!has_next || nxt.e >= 0) break; ++uj; }
        const char* nA = has_next ? S.abase(nxt) : cA; const char* nB = has_next ? S.bbase(nxt) : cB;
        unsigned nO[2][2];
#pragma unroll
        for (int h = 0; h < 2; ++h)
#pragma unroll
            for (int i = 0; i < 2; ++i) nO[h][i] = cO[h][i];
        if constexpr (Sched::GATHER) { int _tz = threadIdx.x; asm volatile("" : "+v"(_tz));
            const int te = has_next ? nxt.e : cur.e, tpm = has_next ? nxt.pm : cur.pm, tva = has_next ? nxt.valid : cur.valid;
#pragma unroll
            for (int _h = 0; _h < 2; ++_h)
#pragma unroll
                for (int _i = 0; _i < 2; ++_i) { int _R, _C; stage_rc(_tz * 16 + _i * 8192, _R, _C); const int _r = _h * HALF + _R;
                    __builtin_amdgcn_global_load_lds((const unsigned*)(S.rowtok + ((size_t)te * ECAP + tpm * 256 + (_r < tva ? _r : tva - 1))), (LAS unsigned*)(lds + L_TOK + (_h * 2 + _i) * 2048 + wid * 256), 4, 0, 0); } }
#define PG8_TRIP(t, last, W3, ST11) do { \
            const char* a1 = cA + (size_t)((t) + 1) * kstep; \
            const char* a2 = (last) ? nA : cA + (size_t)((t) + 2) * kstep; const char* b2 = (last) ? nB : cB + (size_t)((t) + 2) * kstep; \
            const char* a3 = a2 + kstep; const char* b3 = b2 + kstep; \
              \
            PG8_LDB(B0, 0, 0); PG8_LDB(B1, 0, 1); PG8_SCHED; PG8_LDA(At, 0, 0); if (ST11) PG8_STAGE(PG8_SA(1, 1), a1, cO[1]); \
            if (last) { _Pragma("unroll") for (int h = 0; h < 2; ++h) _Pragma("unroll") for (int i = 0; i < 2; ++i) cO[h][i] = nO[h][i]; }     \
            PG8_WAIT_VN(W3); PG8_WAIT_L(0); PG8_BAR; PG8_MMA(0, 0, At, B0); PG8_MMA(0, 1, At, B1); PG8_BAR; PG8_SCHED; \
              \
            PG8_LDA(At, 0, 1); PG8_STAGE(PG8_SB(0, 0), b2, voffB); PG8_STAGE(PG8_SB(0, 1), b2 + hstep, voffB); PG8_STAGE(PG8_SA(0, 0), a2, cO[0]); \
            PG8_WAIT_VN(W3); PG8_WAIT_L(0); PG8_BAR; PG8_MMA(1, 0, At, B0); PG8_MMA(1, 1, At, B1); PG8_BAR; PG8_SCHED; \
              \
            PG8_LDB(B0, 1, 0); PG8_LDB(B1, 1, 1); PG8_SCHED; PG8_LDA(At, 1, 0); PG8_STAGE(PG8_SA(0, 1), a2, cO[1]); \
            PG8_WAIT_VN(W3); PG8_WAIT_L(0); PG8_BAR; PG8_MMA(0, 0, At, B0); PG8_MMA(0, 1, At, B1); PG8_BAR; PG8_SCHED; \
              \
            PG8_LDA(At, 1, 1); PG8_STAGE(PG8_SB(1, 0), b3, voffB); PG8_STAGE(PG8_SB(1, 1), b3 + hstep, voffB); PG8_STAGE(PG8_SA(1, 0), a3, cO[0]); \
            PG8_WAIT_V(8); PG8_WAIT_L(0); PG8_BAR; PG8_MMA(1, 0, At, B0); PG8_MMA(1, 1, At, B1); PG8_BAR; PG8_SCHED; } while (0)
        if constexpr (EARLY) {
            PG8_TRIP(0, false, WX, false);
            if constexpr (Sched::GATHER) { if (has_next) {
                int _tz = threadIdx.x; asm volatile("" : "+v"(_tz));
#pragma unroll
                for (int _h = 0; _h < 2; ++_h)
#pragma unroll
                    for (int _i = 0; _i < 2; ++_i) { int _R, _C; stage_rc(_tz * 16 + _i * 8192, _R, _C); const int _tk = *(const LAS int*)(lds + L_TOK + (_h * 2 + _i) * 2048 + (_tz >> 6) * 256 + (_tz & 63) * 4); nO[_h][_i] = (unsigned)(_tk * PB + 2 * _C); } } }
#pragma unroll 1
            for (int t = 2; t < nt; t += 2) { const bool last = (t == nt - 2); PG8_TRIP(t, last, 8, true); }
        } else {
#pragma unroll 1
            for (int t = 0; t < nt; t += 2) { const bool last = (t == nt - 2); PG8_TRIP(t, last, 8, true); }
        }
#undef PG8_TRIP
        if (wr == 0) PG8_BAR;
        if constexpr (EARLY) PG8_STAGE(PG8_SA(1, 1), nA + kstep, cO[1]);
        if constexpr (FP8) asm volatile("s_nop 15\n\ts_nop 15" ::: "memory");
        { int tz = threadIdx.x; asm volatile("" : "+v"(tz));
          const int wid2 = tz >> 6, lane2 = tz & 63; E(acc, cur, wid2 >> 2, wid2 & 3, lane2 & 15, lane2 >> 4); }
        if (!has_next) break;
#pragma unroll
        for (int a = 0; a < 2; ++a)
#pragma unroll
            for (int b = 0; b < 2; ++b)
#pragma unroll
                for (int m = 0; m < 4; ++m)
#pragma unroll
                    for (int n = 0; n < 2; ++n) { acc[a][b][m][n] = (f32x4){0.f, 0.f, 0.f, 0.f}; asm volatile("" : "+v"(acc[a][b][m][n])); }
        cur = nxt; cA = nA; cB = nB; ui = uj;
        if (wr == 1) PG8_BAR;
    }
    PG8_WAIT_V(0);
    PG8_BAR;
#undef PG8_SA
#undef PG8_SB
#undef PG8_STAGE
#undef PG8_LDA
#undef PG8_LDB
#undef PG8_MMA
#undef PG8_WAIT_V
#undef PG8_WAIT_VN
#undef PG8_WAIT_L
#undef PG8_BAR
#undef PG8_SCHED
#undef PG8_AOFFS
}
}

__device__ __forceinline__ void transpose_item(const float* W, int K, int N, bf16* WT, int dst_row0, LAS float* scr, int k0, int n0, int lane) {
#pragma unroll 8
    for (int i = 0; i < 32; ++i) { const int kk = 2 * i + (lane >> 5); scr[kk * 33 + (lane & 31)] = W[(size_t)(k0 + kk) * N + n0 + (lane & 31)]; }
    asm volatile("s_waitcnt lgkmcnt(0)" ::: "memory");
    const int c = lane & 7;
#pragma unroll
    for (int j = 0; j < 4; ++j) { const int n = (lane >> 3) + 8 * j; const LAS float* s = scr + (8 * c) * 33 + n;
        u32x4 o; o.x = pk2(s[0 * 33], s[1 * 33]); o.y = pk2(s[2 * 33], s[3 * 33]); o.z = pk2(s[4 * 33], s[5 * 33]); o.w = pk2(s[6 * 33], s[7 * 33]);
        *(u32x4*)(WT + (size_t)(dst_row0 + n) * K + k0 + 8 * c) = o; }
    asm volatile("s_waitcnt lgkmcnt(0)" ::: "memory");
}
__device__ __forceinline__ void transpose_item_fp8(const float* W, int K, int N, unsigned char* WT, int dst_row0, LAS float* scr, int k0, int n0, int lane) {
#pragma unroll 8
    for (int i = 0; i < 32; ++i) { const int kk = 2 * i + (lane >> 5); scr[kk * 33 + (lane & 31)] = W[(size_t)(k0 + kk) * N + n0 + (lane & 31)] * pg8::WSCALE8; }
    asm volatile("s_waitcnt lgkmcnt(0)" ::: "memory");
    const int c = lane & 7;
#pragma unroll
    for (int j = 0; j < 4; ++j) { const int n = (lane >> 3) + 8 * j; const LAS float* s = scr + (8 * c) * 33 + n;
        u32x2 o; o.x = pk4_fp8(s[0 * 33], s[1 * 33], s[2 * 33], s[3 * 33]); o.y = pk4_fp8(s[4 * 33], s[5 * 33], s[6 * 33], s[7 * 33]);
        *(u32x2*)(WT + (size_t)(dst_row0 + n) * K + k0 + 8 * c) = o; }
    asm volatile("s_waitcnt lgkmcnt(0)" ::: "memory");
}
__device__ __forceinline__ void ph_prep(const Args& a, Frame& F) {
    if (F.bid == 0 && F.tid == 0) { const float** tab = (const float**)(F.ws + WS_ARGTAB);
#pragma unroll
        for (int i = 0; i < 41; ++i) tab[i] = a.in[i];
        tab[41] = a.out; }
    LAS float* scr = (LAS float*)(F.lds + F.wave * 16384);
    const int gw = F.bid * NWAVES + F.wave, NGW = F.G * NWAVES, lane = F.lane;
    unsigned char* ws = F.ws;
    {
        const float* cin = a.in[1]; const float* mw = a.in[2]; float* modp = (float*)(ws + WS_MODP);
        for (int it = gw; it < 2 * 96 * 16; it += NGW) {
            const int l = it / 1536, rem = it % 1536, cb = rem / 16, ks = rem % 16, col = cb * 64 + lane;
#pragma unroll
            for (int b = 0; b < 8; ++b) { const float cv = cin[b * D + ks * 64 + lane]; scr[b * 64 + lane] = siluf_(cv); }
            asm volatile("s_waitcnt lgkmcnt(0)" ::: "memory");
            float acc[8];
#pragma unroll
            for (int b = 0; b < 8; ++b) acc[b] = 0.f;
            const float* wp = mw + ((size_t)l * D + ks * 64) * 6144 + col;
#pragma unroll 8
            for (int k = 0; k < 64; ++k) { const float w = wp[(size_t)k * 6144];
#pragma unroll
                for (int b = 0; b < 8; ++b) acc[b] += scr[b * 64 + k] * w; }
#pragma unroll
            for (int b = 0; b < 8; ++b) modp[(size_t)((ks * 2 + l) * 8 + b) * 6144 + col] = acc[b];
            asm volatile("s_waitcnt lgkmcnt(0)" ::: "memory");
        }
    }
    {
        constexpr int I_EVIN = 16 * 128, I_EVOUT = 32 * 32, I_ODIN = 16 * 193, I_ODOUT = 32 * 32, I_GU = 64 * 1024, I_DN = 64 * 512, I_LRU = 16 * 8;
        constexpr int NIT = I_EVIN + I_EVOUT + I_ODIN + I_ODOUT + I_GU + I_DN + I_LRU;
        for (int it = gw; it < NIT; it += NGW) {
            int r = it;
            if (r < I_EVIN) { const int kb = r / 128, nb = r % 128; transpose_item(a.in[6], D, EVEN_IN, (bf16*)(ws + WS_WEVIN), 32 * nb, scr, 64 * kb, 32 * nb, lane); continue; } r -= I_EVIN;
            if (r < I_EVOUT) { const int kb = r / 32, nb = r % 32; transpose_item(a.in[25], MIXW, D, (bf16*)(ws + WS_WEVOUT), 32 * nb, scr, 64 * kb, 32 * nb, lane); continue; } r -= I_EVOUT;
            if (r < I_ODIN) { const int kb = r / 193, nb = r % 193; transpose_item_fp8(a.in[26], D, OD_IN, (unsigned char*)(ws + WS_WODIN), 32 * nb, scr, 64 * kb, 32 * nb, lane); continue; } r -= I_ODIN;
            if (r < I_ODOUT) { const int kb = r / 32, nb = r % 32; transpose_item(a.in[33], MIXW, D, (bf16*)(ws + WS_WODOUT), 32 * nb, scr, 64 * kb, 32 * nb, lane); continue; } r -= I_ODOUT;
            if (r < I_GU) { const int mat = r / 1024, rr = r % 1024, kb = rr / 64, nb = rr % 64, n0 = 32 * nb;
                const int drow = n0 < 1024 ? (n0 / 128) * 256 + (n0 % 128) : ((n0 - 1024) / 128) * 256 + 128 + ((n0 - 1024) % 128);
                transpose_item_fp8(a.in[36] + (size_t)mat * D * 2048, D, 2048, (unsigned char*)(ws + WS_WGU) + (size_t)mat * 2048 * D, drow, scr, 64 * kb, n0, lane); continue; } r -= I_GU;
            if (r < I_DN) { const int mat = r / 512, rr = r % 512, kb = rr / 32, nb = rr % 32;
                transpose_item_fp8(a.in[38] + (size_t)mat * DFF * D, DFF, D, (unsigned char*)(ws + WS_WDN) + (size_t)mat * D * DFF, 32 * nb, scr, 64 * kb, 32 * nb, lane); continue; } r -= I_DN;
            { const int mat = r / 8, rr = r % 8, kb = rr / 4, nb = rr % 4, which = mat / 8, h = mat % 8;
                transpose_item((which ? a.in[11] : a.in[9]) + (size_t)h * 128 * 128, 128, 128, (bf16*)(ws + WS_LRUW) + (size_t)(which * 8 + h) * 128 * 128, 32 * nb, scr, 64 * kb, 32 * nb, lane); }
        }
    }
    {
        const size_t gt = (size_t)F.bid * NTHR + F.tid, NT = (size_t)F.G * NTHR;
        u32x4* z = (u32x4*)((unsigned char*)(ws + WS_WODIN) + (size_t)OD_IN * D);
        for (size_t i = gt; i < (size_t)(OD_INP - OD_IN) * D / 16; i += NT) z[i] = (u32x4){0u, 0u, 0u, 0u};
        bf16* gwt = (bf16*)(ws + WS_GATEW);
        for (size_t i = gt; i < 16 * 1024; i += NT) { const int j = (int)(i / 1024), cch = (int)(i % 1024), n = cch >> 2, d = cch & 3, jj = j & 7; const float* Wg = (j < 8 ? a.in[19] : a.in[21]);
            float sc = 0.f, sb = 0.f;
#pragma unroll
            for (int e = 0; e < 4; ++e) { sc += a.in[16][(n * 4 + d) * 4 + e] * Wg[(size_t)(4 * n + e) * 8 + jj] + a.in[17][(n * 4 + d) * 4 + e] * Wg[(size_t)(1024 + 4 * n + e) * 8 + jj];
                sb += a.in[18][(n * 4 + d) * 4 + e] * Wg[(size_t)(2048 + 4 * n + e) * 8 + jj]; }
            gwt[i] = (bf16)f2bf(sc); gwt[16 * 1024 + i] = (bf16)f2bf(sb); }
        bf16* rw = (bf16*)(ws + WS_ROUTW);
        for (size_t i = gt; i < 2 * 32 * 1024; i += NT) { const int l = (int)(i / 32768), e = (int)((i / 1024) % 32), k = (int)(i % 1024);
            const float v = a.in[34][((size_t)l * D + k) * 32 + e]; const unsigned hi = f2bf(v); const unsigned lo = f2bf(v - bf2f(hi));
            rw[((size_t)(l * 2 + 0) * 32 + e) * 1024 + k] = (bf16)hi; rw[((size_t)(l * 2 + 1) * 32 + e) * 1024 + k] = (bf16)lo; }
    }
}

template <int MODE>
__device__ __forceinline__ void ph_rows(const PArgs& a, Frame& F, int l  ) {
    unsigned char* ws = F.ws;
    LAS float* gm = (LAS float*)(F.lds); LAS float* ga = (LAS float*)(F.lds + 4096); LAS float* gf = (LAS float*)(F.lds + 8192); LAS int* offs = (LAS int*)(F.lds + 12288);
    const float* modp = (const float*)(ws + WS_MODP); float* modf = (float*)(ws + WS_MODF);
    if (MODE == 0) {
        for (size_t i = (size_t)F.bid * NTHR + F.tid; i < 2 * 8 * 6144; i += (size_t)F.G * NTHR) { const int l2 = (int)(i / 49152), b = (int)((i / 6144) % 8), n = (int)(i % 6144);
            float s = a.in[3][l2 * 6144 + n];
#pragma unroll
            for (int ks = 0; ks < 16; ++ks) s += modp[(size_t)((ks * 2 + l2) * 8 + b) * 6144 + n];
            modf[i] = s; }
    }
    if (MODE != 0) { if (F.tid == 0) { int o = 0; for (int e = 0; e < NE; ++e) { offs[e] = o; o += (int)F.ctl[CW_CNT + l * 2048 + e * 64]; } } }
    const GAS float* xin = uptr(a.in[0]); const GAS float* xout = uptr(a.in[41]);
    for (int tile = F.bid; tile < MTOK / 128; tile += F.G) {
        const int b = (tile * 128) / SEQ;
        __syncthreads();
        for (int k = F.tid; k < D; k += NTHR) {
            if (MODE == 0) { float sh = a.in[3][k], sc = a.in[3][1024 + k];
#pragma unroll
                for (int ks = 0; ks < 16; ++ks) { const float* p = modp + (size_t)((ks * 2 + 0) * 8 + b) * 6144; sh += p[k]; sc += p[1024 + k]; }
                gm[k] = a.in[4][k] * (1.0f + sc); ga[k] = sh; }
            else if (MODE == 1) { const float* mf = modf + (size_t)((l + 1) * 8 + b) * 6144; gm[k] = a.in[4][(l + 1) * D + k] * (1.0f + mf[1024 + k]); ga[k] = mf[k]; gf[k] = modf[(size_t)(l * 8 + b) * 6144 + 5120 + k]; }
            else { gm[k] = a.in[40][k]; ga[k] = 0.f; gf[k] = modf[(size_t)(l * 8 + b) * 6144 + 5120 + k]; }
        }
        __syncthreads();
        int slotv = 0;
        if (MODE != 0) slotv = ((const int*)(ws + WS_TOKSLOT))[(size_t)(tile * 128 + F.wave * 16) * 4 + F.lane];
#pragma unroll 1
        for (int i = 0; i < 16; i += 2) {
            f32x4 v[2][4]; unsigned yw[2][4][4];
#pragma unroll
            for (int rr = 0; rr < 2; ++rr) { const int row = tile * 128 + F.wave * 16 + i + rr;
#pragma unroll
                for (int j = 0; j < 4; ++j) { if (MODE == 0) v[rr][j] = *(const GAS f32x4*)((const GAS unsigned char*)xin + (unsigned)(row * D + 4 * F.lane) * 4u + 1024 * j);
                    else { const u32x2 hw = *(const u32x2*)(ws + WS_H1 + (unsigned)(row * D + 4 * F.lane) * 2u + 512 * j); v[rr][j] = (f32x4){bf2f(hw.x & 0xffffu), bf2f(hw.x >> 16), bf2f(hw.y & 0xffffu), bf2f(hw.y >> 16)}; } }
                if (MODE != 0) {
#pragma unroll
                    for (int kk = 0; kk < 4; ++kk) { const int sl = __shfl(slotv, 4 * (i + rr) + kk); const int e = sl >> 15, pos = sl & 32767; const unsigned yr = (unsigned)(offs[e] + pos);
                        const unsigned char* yp = ws + WS_YBUF + (yr * (unsigned)D + 4u * (unsigned)F.lane);
#pragma unroll
                        for (int j = 0; j < 4; ++j) yw[rr][kk][j] = *(const unsigned*)(yp + 256 * j); } } }
#pragma unroll
            for (int rr = 0; rr < 2; ++rr) { const int row = tile * 128 + F.wave * 16 + i + rr;
                if (MODE != 0) {
#pragma unroll
                    for (int j = 0; j < 4; ++j) { f32x4 sm = (f32x4){0.f, 0.f, 0.f, 0.f};
#pragma unroll
                        for (int kk = 0; kk < 4; ++kk) { const int w = (int)yw[rr][kk][j]; sm[0] += __builtin_amdgcn_cvt_f32_fp8(w, 0); sm[1] += __builtin_amdgcn_cvt_f32_fp8(w, 1); sm[2] += __builtin_amdgcn_cvt_f32_fp8(w, 2); sm[3] += __builtin_amdgcn_cvt_f32_fp8(w, 3); }
                        const f32x4 g = *(const LAS f32x4*)(gf + 4 * F.lane + 256 * j); v[rr][j] = v[rr][j] + g * (sm * pg8::YINV8); }
                    if (MODE == 1) {
#pragma unroll
                        for (int j = 0; j < 4; ++j) { u32x2 hw; hw.x = pk2(v[rr][j][0], v[rr][j][1]); hw.y = pk2(v[rr][j][2], v[rr][j][3]); *(u32x2*)(ws + WS_H2 + (unsigned)(row * D + 4 * F.lane) * 2u + 512 * j) = hw; } }
                }
                float ss = 0.f;
#pragma unroll
                for (int j = 0; j < 4; ++j) ss += (v[rr][j][0] * v[rr][j][0] + v[rr][j][1] * v[rr][j][1]) + (v[rr][j][2] * v[rr][j][2] + v[rr][j][3] * v[rr][j][3]);
                const float rstd = __builtin_amdgcn_rsqf(wave_sum(ss) * (1.0f / D) + EPS);
#pragma unroll
                for (int j = 0; j < 4; ++j) { const f32x4 m = *(const LAS f32x4*)(gm + 4 * F.lane + 256 * j); const f32x4 ad = *(const LAS f32x4*)(ga + 4 * F.lane + 256 * j);
                    const f32x4 o = v[rr][j] * rstd * m + ad;
                    if (MODE == 2) *(GAS f32x4*)((GAS unsigned char*)xout + (unsigned)(row * D + 4 * F.lane) * 4u + 1024 * j) = o;
                    else if (MODE == 1) *(unsigned*)(ws + WS_U + (unsigned)(row * D + 4 * F.lane) + 256 * j) = pk4_fp8(o[0], o[1], o[2], o[3]);
                    else { u32x2 w; w.x = pk2(o[0], o[1]); w.y = pk2(o[2], o[3]); *(u32x2*)(ws + WS_U + (unsigned)(row * D + 4 * F.lane) * 2u + 512 * j) = w; } } }
        }
    }
}

__device__ __forceinline__ void ph_route(const PArgs& a, Frame& F, int l) {
    unsigned char* ws = F.ws;
    LAS float* gm = (LAS float*)(F.lds); LAS float* ga = (LAS float*)(F.lds + 4096); LAS float* LG = (LAS float*)(F.lds + 8192);
    LAS int* lcnt = (LAS int*)(F.lds + 25600); LAS int* lbase = (LAS int*)(F.lds + 25728);
    const float* modf = (const float*)(ws + WS_MODF); const bf16* h1 = (const bf16*)(ws + WS_H1);
    const bf16* rw = (const bf16*)(ws + WS_ROUTW) + (size_t)l * 2 * 32 * 1024;
    const int r = F.lane & 15, kg = F.lane >> 4;
    for (int tile = F.bid; tile < MTOK / 128; tile += F.G) {
        const int b = (tile * 128) / SEQ;
        __syncthreads();
        for (int k = F.tid; k < D; k += NTHR) { const float* mf = modf + (size_t)(l * 8 + b) * 6144; gm[k] = a.in[5][l * D + k] * (1.0f + mf[4096 + k]); ga[k] = mf[3072 + k]; }
        if (F.tid < 32) lcnt[F.tid] = 0;
        __syncthreads();
        const int row = tile * 128 + F.wave * 16 + r;
        const bf16* hp = h1 + (size_t)row * D + 8 * kg;
        float ss = 0.f;
#pragma unroll 4
        for (int s = 0; s < 32; ++s) { const u32x4 hw = *(const u32x4*)(hp + 32 * s);
            const f32x4 x0 = (f32x4){bf2f(hw.x & 0xffffu), bf2f(hw.x >> 16), bf2f(hw.y & 0xffffu), bf2f(hw.y >> 16)}, x1 = (f32x4){bf2f(hw.z & 0xffffu), bf2f(hw.z >> 16), bf2f(hw.w & 0xffffu), bf2f(hw.w >> 16)};
            ss += (x0[0] * x0[0] + x0[1] * x0[1]) + (x0[2] * x0[2] + x0[3] * x0[3]) + (x1[0] * x1[0] + x1[1] * x1[1]) + (x1[2] * x1[2] + x1[3] * x1[3]); }
        ss += __shfl_xor(ss, 16); ss += __shfl_xor(ss, 32);
        const float rstd = __builtin_amdgcn_rsqf(ss * (1.0f / D) + EPS);
        f32x4 acc[2]; acc[0] = (f32x4){0.f, 0.f, 0.f, 0.f}; acc[1] = acc[0];
        unsigned char* up = (unsigned char*)(ws + WS_U) + (size_t)row * D + 8 * kg;
#pragma unroll 2
        for (int s = 0; s < 32; ++s) {
            const u32x4 hw = *(const u32x4*)(hp + 32 * s);
            const f32x4 x0 = (f32x4){bf2f(hw.x & 0xffffu), bf2f(hw.x >> 16), bf2f(hw.y & 0xffffu), bf2f(hw.y >> 16)}, x1 = (f32x4){bf2f(hw.z & 0xffffu), bf2f(hw.z >> 16), bf2f(hw.w & 0xffffu), bf2f(hw.w >> 16)};
            const f32x4 m0 = *(const LAS f32x4*)(gm + 32 * s + 8 * kg), m1 = *(const LAS f32x4*)(gm + 32 * s + 8 * kg + 4);
            const f32x4 a0 = *(const LAS f32x4*)(ga + 32 * s + 8 * kg), a1 = *(const LAS f32x4*)(ga + 32 * s + 8 * kg + 4);
            const f32x4 u0 = x0 * rstd * m0 + a0, u1 = x1 * rstd * m1 + a1;
            bf16x8 ahi, alo;
#pragma unroll
            for (int j = 0; j < 4; ++j) { const unsigned h0 = f2bf(u0[j]), h1b = f2bf(u1[j]); ahi[j] = (short)h0; ahi[4 + j] = (short)h1b; alo[j] = (short)f2bf(u0[j] - bf2f(h0)); alo[4 + j] = (short)f2bf(u1[j] - bf2f(h1b)); }
            { u32x2 w8; w8.x = pk4_fp8(u0[0], u0[1], u0[2], u0[3]); w8.y = pk4_fp8(u1[0], u1[1], u1[2], u1[3]); *(u32x2*)(up + 32 * s) = w8; }
#pragma unroll
            for (int nt = 0; nt < 2; ++nt) { const bf16x8 bhi = *(const bf16x8*)(rw + (size_t)(16 * nt + r) * 1024 + 32 * s + 8 * kg); const bf16x8 blo = *(const bf16x8*)(rw + (size_t)(32 + 16 * nt + r) * 1024 + 32 * s + 8 * kg);
                acc[nt] = MFMA16(ahi, bhi, acc[nt]); acc[nt] = MFMA16(ahi, blo, acc[nt]); acc[nt] = MFMA16(alo, bhi, acc[nt]); }
        }
#pragma unroll
        for (int nt = 0; nt < 2; ++nt)
#pragma unroll
            for (int j = 0; j < 4; ++j) LG[(F.wave * 16 + 4 * kg + j) * 33 + 16 * nt + r] = acc[nt][j] + a.in[35][l * 32 + 16 * nt + r];
        __syncthreads();
        int pe[4]; float pg[4]; int prank[4];
        if (F.tid < 128) {
            float lv[32];
#pragma unroll
            for (int e = 0; e < 32; ++e) lv[e] = LG[F.tid * 33 + e];
#pragma unroll
            for (int k = 0; k < 4; ++k) { float best = -3.0e38f; int bi = 0;
#pragma unroll
                for (int e = 0; e < 32; ++e) { const bool tk = lv[e] > best; best = tk ? lv[e] : best; bi = tk ? e : bi; }
                pe[k] = bi; pg[k] = best;
#pragma unroll
                for (int e = 0; e < 32; ++e) lv[e] = (e == bi) ? -3.0e38f : lv[e]; }
            const float mx = pg[0]; float sm = 0.f;
#pragma unroll
            for (int k = 0; k < 4; ++k) { pg[k] = __expf(pg[k] - mx); sm += pg[k]; }
            const float inv = 1.0f / sm;
#pragma unroll
            for (int k = 0; k < 4; ++k) { pg[k] *= inv; prank[k] = __hip_atomic_fetch_add(&lcnt[pe[k]], 1, __ATOMIC_RELAXED, __HIP_MEMORY_SCOPE_WORKGROUP); }
        }
        __syncthreads();
        if (F.tid < 32) { const int c = lcnt[F.tid]; lbase[F.tid] = c ? (int)atomicAdd(&F.ctl[CW_CNT + l * 2048 + F.tid * 64], (unsigned)c) : 0; }
        __syncthreads();
        if (F.tid < 128) {
            const int trow = tile * 128 + F.tid;
#pragma unroll
            for (int k = 0; k < 4; ++k) { const int pos = lbase[pe[k]] + prank[k]; const size_t li = (size_t)pe[k] * ECAP + pos;
                ((int*)(ws + WS_ROWTOK))[li] = trow; ((float*)(ws + WS_ROWGATE))[li] = pg[k]; ((int*)(ws + WS_TOKSLOT))[(size_t)trow * 4 + k] = pe[k] * 32768 + pos; }
        }
    }
}

#define RAW_PF(pr, src, ld, grow0, tseq0, c0) do { _Pragma("unroll") for (int i_ = 0; i_ < 5; ++i_) { const int q0_ = F.tid + i_ * NTHR, q_ = q0_ < 131 * 16 ? q0_ : 131 * 16 - 1, r_ = q_ >> 4, cc_ = q_ & 15; \
        const int back_ = (tseq0) - 3 + r_ >= 0 ? 3 - r_ : (tseq0);     \
        const u32x4 v_ = *(const u32x4*)((const unsigned char*)(src) + (unsigned)(((grow0) - back_) * (ld) + (c0) + 8 * cc_) * 2u); pr[i_] = ((tseq0) - 3 + r_ >= 0) ? v_ : (u32x4){0u, 0u, 0u, 0u}; } } while (0)
#define RAW_PW(pr) do { _Pragma("unroll") for (int i_ = 0; i_ < 5; ++i_) { const int q_ = F.tid + i_ * NTHR, r_ = q_ >> 4, cc_ = q_ & 15; if (q_ < 131 * 16) *(LAS u32x4*)(F.lds + L_RAW + r_ * RLD + cc_ * 16) = pr[i_]; } } while (0)
template <int RLDB>
__device__ __forceinline__ void tr_frag4(unsigned a, bf16x8 (&out)[4]) {
    u32x2 r0, r1, r2, r3, r4, r5, r6, r7;
    asm volatile(
        "ds_read_b64_tr_b16 %0, %8 offset:%9\n\t"
        "ds_read_b64_tr_b16 %1, %8 offset:%10\n\t"
        "ds_read_b64_tr_b16 %2, %8 offset:%11\n\t"
        "ds_read_b64_tr_b16 %3, %8 offset:%12\n\t"
        "ds_read_b64_tr_b16 %4, %8 offset:%13\n\t"
        "ds_read_b64_tr_b16 %5, %8 offset:%14\n\t"
        "ds_read_b64_tr_b16 %6, %8 offset:%15\n\t"
        "ds_read_b64_tr_b16 %7, %8 offset:%16\n\t"
        "s_waitcnt lgkmcnt(0)"
        : "=&v"(r0), "=&v"(r1), "=&v"(r2), "=&v"(r3), "=&v"(r4), "=&v"(r5), "=&v"(r6), "=&v"(r7)
        : "v"(a), "i"(0), "i"(4 * RLDB), "i"(32 * RLDB), "i"(36 * RLDB), "i"(64 * RLDB), "i"(68 * RLDB), "i"(96 * RLDB), "i"(100 * RLDB)
        : "memory");
    out[0] = __builtin_bit_cast(bf16x8, (u32x4){r0.x, r0.y, r1.x, r1.y});
    out[1] = __builtin_bit_cast(bf16x8, (u32x4){r2.x, r2.y, r3.x, r3.y});
    out[2] = __builtin_bit_cast(bf16x8, (u32x4){r4.x, r4.y, r5.x, r5.y});
    out[3] = __builtin_bit_cast(bf16x8, (u32x4){r6.x, r6.y, r7.x, r7.y});
}
__device__ __forceinline__ unsigned tr_addr(const LAS unsigned char* tile, int n0, int lane) { return (unsigned)(size_t)tile + (unsigned)((8 * (lane >> 4) + ((lane & 15) >> 2)) * RLD + (n0 + 4 * (lane & 3)) * 2); }
__device__ __forceinline__ void copy_tile(Frame& F, const bf16* src, int ld, int dstoff) {
#pragma unroll
    for (int i = 0; i < 4; ++i) { const int q = F.tid + i * NTHR, r = q >> 4, cc = q & 15; *(LAS u32x4*)(F.lds + dstoff + r * RLD + cc * 16) = *(const u32x4*)(src + (size_t)r * ld + 8 * cc); }
}
__device__ __forceinline__ u32x4 scale8(u32x4 v, float s) { u32x4 o; o.x = pk2(bf2f(v.x & 0xffffu) * s, bf2f(v.x >> 16) * s); o.y = pk2(bf2f(v.y & 0xffffu) * s, bf2f(v.y >> 16) * s); o.z = pk2(bf2f(v.z & 0xffffu) * s, bf2f(v.z >> 16) * s); o.w = pk2(bf2f(v.w & 0xffffu) * s, bf2f(v.w >> 16) * s); return o; }
#define WSYNC() do { asm volatile("s_waitcnt vmcnt(0)" ::: "memory"); __syncthreads(); } while (0)

constexpr int L_GT = L_SM, L_GC = L_SM + 8192, L_BC = L_GC + 4096, L_MV = L_BC + 4096, L_BM = L_MV + 4096, L_MP = L_BM + 32;
constexpr int L_WS = L_MP + 32;
__device__ __forceinline__ void ml_pre(const PArgs& a, Frame& F0, int b, int c) { Frame F = relaunder(F0);
    unsigned char* ws = F.ws; LAS unsigned char* lds = F.lds;
    const bf16* proj = (const bf16*)(ws + WS_PROJ);
    const int wid = F.wave, lane = F.lane, fr = lane & 15, fq = lane >> 4, row0 = b * SEQ + c * CH;
    const int n = F.tid & 31, tg = F.tid >> 5;
    LAS float* GT = (LAS float*)(lds + L_GT); LAS float* Gc = (LAS float*)(lds + L_GC); LAS float* Bc = (LAS float*)(lds + L_BC); LAS float* BM = (LAS float*)(lds + L_BM);
    const float kscale = 0.08838834764831845f;
    f32x4 gacc = (f32x4){0.f, 0.f, 0.f, 0.f};
    constexpr int GWLD = 2064;
    { u32x4 gw[8];
#pragma unroll
      for (int i = 0; i < 8; ++i) gw[i] = *(const u32x4*)(ws + WS_GATEW + (unsigned)((F.tid + i * NTHR) * 16));
#pragma unroll
      for (int i = 0; i < 8; ++i) { const int q = F.tid + i * NTHR; *(LAS u32x4*)(lds + L_T1 + (q >> 7) * GWLD + (q & 127) * 16) = gw[i]; } }
    const LAS unsigned char* gwl = lds + L_T1 + fr * GWLD + 16 * fq;
    u32x4 pr[5];
    RAW_PF(pr, proj, EVEN_IN, row0, c * CH, 2048);
    const GAS float* p14 = uptr(a.in[14]); const GAS float* p15 = uptr(a.in[15]); const GAS float* p16 = uptr(a.in[16]); const GAS float* p17 = uptr(a.in[17]); const GAS float* p18 = uptr(a.in[18]);
    for (int h = 0; h < 8; ++h) {
        const int gc = 128 * h + 4 * n;
        f32x4 cw[4], wq[4], wk[4], wv[4];
        const f32x4 cb = *(const GAS f32x4*)(p15 + gc);
#pragma unroll
        for (int j = 0; j < 4; ++j) { cw[j] = *(const GAS f32x4*)(p14 + (size_t)j * D + gc); wq[j] = *(const GAS f32x4*)(p16 + (size_t)(32 * h + n) * 16 + 4 * j);
            wk[j] = *(const GAS f32x4*)(p17 + (size_t)(32 * h + n) * 16 + 4 * j); wv[j] = *(const GAS f32x4*)(p18 + (size_t)(32 * h + n) * 16 + 4 * j); }
        RAW_PW(pr);
#pragma unroll
        for (int j = 0; j < 4; ++j) wk[j] *= kscale;
        __syncthreads();
        if (h < 7) RAW_PF(pr, proj, EVEN_IN, row0, c * CH, 2048 + 128 * (h + 1));
        float w0[4], w1[4], w2[4], w3[4];
        { const LAS unsigned char* rp = lds + L_RAW + (8 * tg) * RLD + 8 * n; u32x2 u;
          u = *(const LAS u32x2*)(rp); w0[0] = bf2f(u.x & 0xffffu); w0[1] = bf2f(u.x >> 16); w0[2] = bf2f(u.y & 0xffffu); w0[3] = bf2f(u.y >> 16);
          u = *(const LAS u32x2*)(rp + RLD); w1[0] = bf2f(u.x & 0xffffu); w1[1] = bf2f(u.x >> 16); w1[2] = bf2f(u.y & 0xffffu); w1[3] = bf2f(u.y >> 16);
          u = *(const LAS u32x2*)(rp + 2 * RLD); w2[0] = bf2f(u.x & 0xffffu); w2[1] = bf2f(u.x >> 16); w2[2] = bf2f(u.y & 0xffffu); w2[3] = bf2f(u.y >> 16); }
#pragma unroll
        for (int i = 0; i < 8; ++i) { const int t = 8 * tg + i;
            { const u32x2 u = *(const LAS u32x2*)(lds + L_RAW + (t + 3) * RLD + 8 * n); w3[0] = bf2f(u.x & 0xffffu); w3[1] = bf2f(u.x >> 16); w3[2] = bf2f(u.y & 0xffffu); w3[3] = bf2f(u.y >> 16); }
            float xc[4], q[4], k[4], v[4];
#pragma unroll
            for (int e = 0; e < 4; ++e) xc[e] = siluf_(cb[e] + cw[0][e] * w0[e] + cw[1][e] * w1[e] + cw[2][e] * w2[e] + cw[3][e] * w3[e]);
#pragma unroll
            for (int e = 0; e < 4; ++e) { q[e] = xc[0] * wq[0][e] + xc[1] * wq[1][e] + xc[2] * wq[2][e] + xc[3] * wq[3][e]; k[e] = xc[0] * wk[0][e] + xc[1] * wk[1][e] + xc[2] * wk[2][e] + xc[3] * wk[3][e];
                v[e] = w3[0] * wv[0][e] + w3[1] * wv[1][e] + w3[2] * wv[2][e] + w3[3] * wv[3][e]; }
            u32x2 o; o.x = pk2(xc[0], xc[1]); o.y = pk2(xc[2], xc[3]);
            *(LAS u32x2*)(lds + L_T0 + t * RLD + 8 * n) = o;
            const unsigned go = (unsigned)((row0 + t) * D + gc) * 2u;
            *(u32x2*)(ws + WS_XC + go) = o;
            o.x = pk2(q[0], q[1]); o.y = pk2(q[2], q[3]); *(u32x2*)(ws + WS_QG + go) = o;
            o.x = pk2(k[0], k[1]); o.y = pk2(k[2], k[3]); *(u32x2*)(ws + WS_KG + go) = o;
            o.x = pk2(v[0], v[1]); o.y = pk2(v[2], v[3]); *(u32x2*)(ws + WS_VG + go) = o;
#pragma unroll
            for (int e = 0; e < 4; ++e) { w0[e] = w1[e]; w1[e] = w2[e]; w2[e] = w3[e]; } }
        __syncthreads();
#pragma unroll
        for (int ks = 0; ks < 4; ++ks) { const bf16x8 A1 = LFRAG(lds + L_T0, 16 * wid + fr, 32 * ks + 8 * fq); const bf16x8 B1 = *(const LAS bf16x8*)(gwl + (128 * h + 32 * ks) * 2); gacc = MFMA16(A1, B1, gacc);
            const bf16x8 A2 = LFRAG(lds + L_RAW, 16 * wid + fr + 3, 32 * ks + 8 * fq); const bf16x8 B2 = *(const LAS bf16x8*)(gwl + 16 * GWLD + (128 * h + 32 * ks) * 2); gacc = MFMA16(A2, B2, gacc); }
        __syncthreads();
    }
    const float gbias = *(fr < 8 ? a.in[20] + fr : a.in[22] + (fr - 8));
#pragma unroll
    for (int j = 0; j < 4; ++j) { float v = gacc[j] + gbias; if (fr >= 8) v = logsigmoidf_(v); GT[(16 * wid + 4 * fq + j) * 16 + fr] = v; }
    __syncthreads();
    if (F.tid < 8) { const int h = F.tid; float g = 0.f, bmax = -3.0e38f;
        for (int t = 0; t < CH; ++t) { g += GT[t * 16 + 8 + h]; const float bb = GT[t * 16 + h] - g; Gc[t * 8 + h] = g; Bc[t * 8 + h] = bb; bmax = fmaxf(bmax, bb); }
        BM[h] = bmax; const int u = (b * 8 + h) * NCHUNK + c; ((float*)(ws + WS_ML_GT))[u] = g; ((float*)(ws + WS_ML_ML))[u] = g + bmax; }
    __syncthreads();
    for (int i = F.tid; i < CH * 8; i += NTHR) { ((float*)(ws + WS_ML_G))[(size_t)row0 * 8 + i] = Gc[i]; ((float*)(ws + WS_ML_B))[(size_t)row0 * 8 + i] = Bc[i]; }
}
__device__ __forceinline__ void ml_local2(const PArgs& a, Frame& F, int b, int c) {
    unsigned char* ws = F.ws; LAS unsigned char* lds = F.lds;
    const int wid = F.wave, lane = F.lane, fr = lane & 15, fq = lane >> 4, row0 = b * SEQ + c * CH;
    LAS float* Bc = (LAS float*)(lds + L_BC); LAS float* BM = (LAS float*)(lds + L_BM);
    WSYNC();
    u32x4 pk[4], pv[4];
#define KV_PF(hh) do { _Pragma("unroll") for (int i_ = 0; i_ < 4; ++i_) { const int q_ = F.tid + i_ * NTHR; const size_t o_ = (size_t)(row0 + (q_ >> 4)) * D + 128 * (hh) + 8 * (q_ & 15); pk[i_] = *(const u32x4*)((const bf16*)(ws + WS_KG) + o_); pv[i_] = *(const u32x4*)((const bf16*)(ws + WS_VG) + o_); } } while (0)
    KV_PF(0);
    for (int h = 0; h < 8; ++h) {
        const float bm = BM[h];
#pragma unroll
        for (int i = 0; i < 4; ++i) { const int q = F.tid + i * NTHR, r = q >> 4, cc = q & 15; const float sc = __expf(Bc[r * 8 + h] - bm);
            *(LAS u32x4*)(lds + L_T1 + r * RLD + cc * 16) = scale8(pk[i], sc);
            *(LAS u32x4*)(lds + L_T2 + r * RLD + cc * 16) = pv[i]; }
        __syncthreads();
        if (h < 7) KV_PF(h + 1);
        const int u = (b * 8 + h) * NCHUNK + c;
        bf16x8 Av[4]; tr_frag4<RLD>(tr_addr(lds + L_T2, 16 * wid, lane), Av);
        bf16* cl = (bf16*)(ws + WS_CLOC) + (size_t)u * 16384;
#pragma unroll
        for (int nt = 0; nt < 8; ++nt) { bf16x8 Bk[4]; tr_frag4<RLD>(tr_addr(lds + L_T1, 16 * nt, lane), Bk);
            f32x4 acc = (f32x4){0.f, 0.f, 0.f, 0.f};
#pragma unroll
            for (int ks = 0; ks < 4; ++ks) acc = MFMA16(Av[ks], Bk[ks], acc);
#pragma unroll
            for (int j = 0; j < 4; ++j) cl[(16 * wid + 4 * fq + j) * 128 + 16 * nt + fr] = (bf16)f2bf(acc[j]); }
        if (F.tid < 128) { float s0 = 0.f, s1 = 0.f;
#pragma unroll 8
            for (int t = 0; t < CH; t += 2) { s0 += bf2f(*(const LAS bf16*)(lds + L_T1 + t * RLD + F.tid * 2)); s1 += bf2f(*(const LAS bf16*)(lds + L_T1 + (t + 1) * RLD + F.tid * 2)); }
            ((float*)(ws + WS_ML_NLOC))[(size_t)u * 128 + F.tid] = s0 + s1; }
        __syncthreads();
    }
}

__device__ __forceinline__ void lru_fix(const PArgs& a, Frame& F0, int b, int c) { Frame F = relaunder(F0);
    unsigned char* ws = F.ws; const bf16* proj = (const bf16*)(ws + WS_PROJ);
    const int row0 = b * SEQ + c * CH, cc = F.tid & 127, tg = F.tid >> 7;
    const float* cp = (const float*)(ws + WS_LRU_CARRY) + (size_t)(b * NCHUNK + c) * D + 8 * cc;
    const f32x4 c0 = *(const f32x4*)cp, c1 = *(const f32x4*)(cp + 4);
#pragma unroll 1
    for (int t0 = 0; t0 < 32; t0 += 4) { u32x4 hw[4], pw[4], gw[4];
#pragma unroll
        for (int i = 0; i < 4; ++i) { const size_t r = (size_t)(row0 + 32 * tg + t0 + i); hw[i] = *(const u32x4*)((const bf16*)(ws + WS_LRU_HL) + r * D + 8 * cc); pw[i] = *(const u32x4*)((const bf16*)(ws + WS_LRU_PC) + r * D + 8 * cc); gw[i] = *(const u32x4*)(proj + r * EVEN_IN + 1024 + 8 * cc); }
#pragma unroll
        for (int i = 0; i < 4; ++i) { const size_t r = (size_t)(row0 + 32 * tg + t0 + i); float o[8];
#pragma unroll
            for (int e = 0; e < 8; ++e) { const unsigned hh = (e < 2) ? hw[i].x : (e < 4) ? hw[i].y : (e < 6) ? hw[i].z : hw[i].w, pq = (e < 2) ? pw[i].x : (e < 4) ? pw[i].y : (e < 6) ? pw[i].z : pw[i].w, gg = (e < 2) ? gw[i].x : (e < 4) ? gw[i].y : (e < 6) ? gw[i].z : gw[i].w;
                const float hl = bf2f((e & 1) ? (hh >> 16) : (hh & 0xffffu)), pc = bf2f((e & 1) ? (pq >> 16) : (pq & 0xffffu)), g = bf2f((e & 1) ? (gg >> 16) : (gg & 0xffffu));
                o[e] = (hl + pc * (e < 4 ? c0[e] : c1[e - 4])) * gelu_tanh(g); }
            u32x4 w; w.x = pk2(o[0], o[1]); w.y = pk2(o[2], o[3]); w.z = pk2(o[4], o[5]); w.w = pk2(o[6], o[7]);
            *(u32x4*)((bf16*)(ws + WS_MIX) + r * MIXW + 8 * cc) = w; } }
}
#undef KV_PF
__device__ __attribute__((noinline)) void ml_local2_nl(const GAS unsigned char* tab, GAS unsigned char* ws, int b, int c) { Frame F = make_frame((unsigned char*)ws); PArgs pa; pa.in.p = (const float* const*)tab; ml_local2(pa, F, b, c); }
__device__ __forceinline__ void ml_out2(const PArgs& a, Frame& F0, int b, int c) { Frame F = relaunder(F0);
    unsigned char* ws = F.ws; LAS unsigned char* lds = F.lds;
    const bf16* proj = (const bf16*)(ws + WS_PROJ); bf16* mix = (bf16*)(ws + WS_MIX);
    const int wid = F.wave, lane = F.lane, fr = lane & 15, fq = lane >> 4, row0 = b * SEQ + c * CH;
    LAS float* Gc = (LAS float*)(lds + L_GC); LAS float* Bc = (LAS float*)(lds + L_BC); LAS float* Mv = (LAS float*)(lds + L_MV); LAS float* MP = (LAS float*)(lds + L_MP);
    u32x4 tq[4], tk[4];
#define QKV_PF(hh) do { _Pragma("unroll") for (int i_ = 0; i_ < 4; ++i_) { const int q_ = F.tid + i_ * NTHR; const size_t o_ = (size_t)(row0 + (q_ >> 4)) * D + 128 * (hh) + 8 * (q_ & 15); \
        tq[i_] = *(const u32x4*)((const bf16*)(ws + WS_QG) + o_); tk[i_] = *(const u32x4*)((const bf16*)(ws + WS_KG) + o_); } } while (0)
    __syncthreads();
    QKV_PF(0);
    LAS float* NWS = (LAS float*)(lds + L_GT);
    {
        const GAS float* nwp = a.in[23]; const GAS float* skp = a.in[24];
        const float g0 = ((const float*)(ws + WS_ML_G))[(size_t)row0 * 8 + F.tid], g1 = ((const float*)(ws + WS_ML_G))[(size_t)row0 * 8 + F.tid + NTHR];
        const float b0 = ((const float*)(ws + WS_ML_B))[(size_t)row0 * 8 + F.tid], b1 = ((const float*)(ws + WS_ML_B))[(size_t)row0 * 8 + F.tid + NTHR];
        const float n0 = nwp[F.tid], n1 = nwp[F.tid + NTHR], s0 = skp[F.tid], s1 = skp[F.tid + NTHR];
        const float mp0 = ((const float*)(ws + WS_ML_MS))[(b * 8 + (F.tid & 7)) * NCHUNK + c];
        Gc[F.tid] = g0; Gc[F.tid + NTHR] = g1; Bc[F.tid] = b0; Bc[F.tid + NTHR] = b1; NWS[F.tid] = n0; NWS[F.tid + NTHR] = n1; NWS[1024 + F.tid] = s0; NWS[1024 + F.tid + NTHR] = s1;
        if (F.tid < 8) MP[F.tid] = mp0; }
    __syncthreads();
    if (F.tid < 8) { const int h = F.tid; float pm = -3.0e38f; const float mp = MP[h]; for (int t = 0; t < CH; ++t) { pm = fmaxf(pm, Bc[t * 8 + h]); Mv[t * 8 + h] = fmaxf(mp, pm); } }
    __syncthreads();
    LAS unsigned char* PS = lds + L_RAW + wid * 16 * RLD;
    LAS unsigned char* HS = lds + L_T0 + wid * 8448;
    for (int h = 0; h < 8; ++h) {
#pragma unroll
        for (int i = 0; i < 4; ++i) { const int q = F.tid + i * NTHR; const int lo = (q >> 4) * RLD + (q & 15) * 16; *(LAS u32x4*)(lds + L_T0 + lo) = tq[i]; *(LAS u32x4*)(lds + L_T1 + lo) = tk[i]; }
        const int u = (b * 8 + h) * NCHUNK + c;
        u32x4 pc[4], tv[4];
#pragma unroll
        for (int i = 0; i < 4; ++i) { const int q = F.tid + i * NTHR; pc[i] = *(const u32x4*)((const bf16*)(ws + WS_CST) + (size_t)u * 16384 + (size_t)(q >> 4) * 128 + 8 * (q & 15));
            tv[i] = *(const u32x4*)((const bf16*)(ws + WS_VG) + (size_t)(row0 + (q >> 4)) * D + 128 * h + 8 * (q & 15)); }
        __syncthreads();
        float rs[4] = {0.f, 0.f, 0.f, 0.f};
        float mrow[4];
#pragma unroll
        for (int j = 0; j < 4; ++j) mrow[j] = Mv[(16 * wid + 4 * fq + j) * 8 + h];
        bf16x8 Aq[4];
#pragma unroll
        for (int ks = 0; ks < 4; ++ks) Aq[ks] = LFRAG(lds + L_T0, 16 * wid + fr, 32 * ks + 8 * fq);
#pragma unroll
        for (int nt = 0; nt < 8; ++nt) {
            if (nt <= wid) {
                f32x4 sacc = (f32x4){0.f, 0.f, 0.f, 0.f};
#pragma unroll
                for (int ks = 0; ks < 4; ++ks) { const bf16x8 B = LFRAG(lds + L_T1, 16 * nt + fr, 32 * ks + 8 * fq); sacc = MFMA16(Aq[ks], B, sacc); }
                const int s_ = 16 * nt + fr; const float bs = Bc[s_ * 8 + h];
#pragma unroll
                for (int j = 0; j < 4; ++j) { const int t = 16 * wid + 4 * fq + j; const float p = (s_ <= t) ? sacc[j] * __expf(bs - mrow[j]) : 0.f; rs[j] += p;
                    *(LAS bf16*)(PS + (4 * fq + j) * RLD + s_ * 2) = (bf16)f2bf(p); }
            } else if (nt == wid + 1) {
#pragma unroll
                for (int j = 0; j < 4; ++j) *(LAS bf16*)(PS + (4 * fq + j) * RLD + (16 * nt + fr) * 2) = (bf16)0;
            }
        }
#pragma unroll
        for (int j = 0; j < 4; ++j) rs[j] = red16(rs[j]);
        __syncthreads();
#pragma unroll
        for (int i = 0; i < 4; ++i) { const int q = F.tid + i * NTHR; *(LAS u32x4*)(lds + L_T1 + (q >> 4) * RLD + (q & 15) * 16) = pc[i]; *(LAS u32x4*)(lds + L_T2 + (q >> 4) * RLD + (q & 15) * 16) = tv[i]; }
        __syncthreads();
        if (h < 7) QKV_PF(h + 1);
        f32x4 oacc[8];
#pragma unroll
        for (int ne = 0; ne < 8; ++ne) oacc[ne] = (f32x4){0.f, 0.f, 0.f, 0.f};
#pragma unroll
        for (int ks = 0; ks < 4; ++ks) {
#pragma unroll
            for (int ne = 0; ne < 8; ++ne) { const bf16x8 B = LFRAG(lds + L_T1, 16 * ne + fr, 32 * ks + 8 * fq); oacc[ne] = MFMA16(Aq[ks], B, oacc[ne]); } }
        const float mp = MP[h];
        float winter[4];
#pragma unroll
        for (int j = 0; j < 4; ++j) winter[j] = __expf(mp - mrow[j]);
#pragma unroll
        for (int ne = 0; ne < 8; ++ne)
#pragma unroll
            for (int j = 0; j < 4; ++j) oacc[ne][j] *= winter[j];
        const int kmax = (wid + 2) >> 1;
        bf16x8 Ap[4];
#pragma unroll
        for (int ks = 0; ks < 4; ++ks) Ap[ks] = LFRAG(PS, fr, 32 * ks + 8 * fq);
#pragma unroll
        for (int ne = 0; ne < 8; ++ne) { bf16x8 Bv[4]; tr_frag4<RLD>(tr_addr(lds + L_T2, 16 * ne, lane), Bv);
#pragma unroll
            for (int ks = 0; ks < 4; ++ks) if (ks < kmax) oacc[ne] = MFMA16(Ap[ks], Bv[ks], oacc[ne]); }
        float qn[4];
        { const float* np = (const float*)(ws + WS_ML_NST) + (size_t)u * 128 + 8 * fr; const f32x4 n0 = *(const f32x4*)np, n1 = *(const f32x4*)(np + 4);
#pragma unroll
            for (int j = 0; j < 4; ++j) { const bf16x8 qq = LFRAG(lds + L_T0, 16 * wid + 4 * fq + j, 8 * fr); float s = 0.f;
#pragma unroll
                for (int d = 0; d < 4; ++d) s += bf2f((unsigned short)qq[d]) * n0[d] + bf2f((unsigned short)qq[4 + d]) * n1[d];
                qn[j] = red16(s); } }
        float inv[4], mean[4], rstd[4];
#pragma unroll
        for (int j = 0; j < 4; ++j) { const int t = 16 * wid + 4 * fq + j; const float den = rs[j] + winter[j] * qn[j]; inv[j] = frcp(fmaxf(fabsf(den), __expf(-(Gc[t * 8 + h] + mrow[j])))); }
#pragma unroll
        for (int ne = 0; ne < 8; ++ne)
#pragma unroll
            for (int j = 0; j < 4; ++j) oacc[ne][j] *= inv[j];
#pragma unroll
        for (int j = 0; j < 4; ++j) { float s = 0.f;
#pragma unroll
            for (int ne = 0; ne < 8; ++ne) s += oacc[ne][j];
            mean[j] = red16(s) * (1.0f / 128.0f); float q2 = 0.f;
#pragma unroll
            for (int ne = 0; ne < 8; ++ne) { const float d = oacc[ne][j] - mean[j]; q2 += d * d; }
            rstd[j] = __builtin_amdgcn_rsqf(red16(q2) * (1.0f / 128.0f) + EPS); }
        const int er = lane >> 2, esg = lane & 3; const size_t egrow = (size_t)(row0 + 16 * wid + er); const int ec0 = 128 * h + 32 * esg;
        u32x4 exw[4], ezw[4];
#pragma unroll
        for (int q = 0; q < 4; ++q) { exw[q] = *(const u32x4*)((const bf16*)(ws + WS_XC) + egrow * D + ec0 + 8 * q); ezw[q] = *(const u32x4*)(proj + egrow * EVEN_IN + 3072 + ec0 + 8 * q); }
        __syncthreads();
#pragma unroll
        for (int ne = 0; ne < 8; ++ne)
#pragma unroll
            for (int j = 0; j < 4; ++j) *(LAS float*)(HS + (4 * fq + j) * 528 + (16 * ne + fr) * 4) = (oacc[ne][j] - mean[j]) * rstd[j];
        asm volatile("s_waitcnt lgkmcnt(0)" ::: "memory");
        { const int r = er, sg = esg; const size_t grow = egrow; const int c0 = ec0;
#pragma unroll
            for (int q = 0; q < 4; ++q) { const int cc = c0 + 8 * q;
                const f32x4 h0 = *(const LAS f32x4*)(HS + r * 528 + (32 * sg + 8 * q) * 4), h1 = *(const LAS f32x4*)(HS + r * 528 + (32 * sg + 8 * q + 4) * 4);
                const u32x4 xw = exw[q]; const u32x4 zw = ezw[q];
                const f32x4 nw0 = *(const LAS f32x4*)(NWS + cc), nw1 = *(const LAS f32x4*)(NWS + cc + 4), sk0 = *(const LAS f32x4*)(NWS + 1024 + cc), sk1 = *(const LAS f32x4*)(NWS + 1024 + cc + 4);
                float o[8];
#pragma unroll
                for (int e = 0; e < 4; ++e) { const unsigned xa = (e < 2) ? xw.x : xw.y, xb_ = (e < 2) ? xw.z : xw.w, za = (e < 2) ? zw.x : zw.y, zb_ = (e < 2) ? zw.z : zw.w;
                    const float x0 = bf2f((e & 1) ? (xa >> 16) : (xa & 0xffffu)), x1 = bf2f((e & 1) ? (xb_ >> 16) : (xb_ & 0xffffu));
                    const float z0 = bf2f((e & 1) ? (za >> 16) : (za & 0xffffu)), z1 = bf2f((e & 1) ? (zb_ >> 16) : (zb_ & 0xffffu));
                    o[e] = (h0[e] * nw0[e] + sk0[e] * x0) * siluf_(z0); o[4 + e] = (h1[e] * nw1[e] + sk1[e] * x1) * siluf_(z1); }
                u32x4 w; w.x = pk2(o[0], o[1]); w.y = pk2(o[2], o[3]); w.z = pk2(o[4], o[5]); w.w = pk2(o[6], o[7]);
                *(u32x4*)(mix + grow * MIXW + 1024 + cc) = w; } }
        __syncthreads();
    }
#undef QKV_PF
}


template <bool OUT>
__device__ __forceinline__ void lru_unit2(const PArgs& a, Frame& F0, int b, int c) { Frame F = relaunder(F0);
    unsigned char* ws = F.ws; LAS unsigned char* lds = F.lds;
    const bf16* proj = (const bf16*)(ws + WS_PROJ);
    const int wid = F.wave, lane = F.lane, fr = lane & 15, fq = lane >> 4;
    const int n = F.tid & 31, tg = F.tid >> 5;
    const int row0 = b * SEQ + c * CH;
    __syncthreads();
    u32x4 pr[5];
    RAW_PF(pr, proj, EVEN_IN, row0, c * CH, 0);
    for (int h = 0; h < 8; ++h) {
        RAW_PW(pr);
        if (OUT) copy_tile(F, proj + (size_t)row0 * EVEN_IN + 1024 + 128 * h, EVEN_IN, L_T1);
        const int gc = 128 * h + 4 * n;
        f32x4 cw[4]; const f32x4 cb = *(const f32x4*)(a.in[8] + gc);
#pragma unroll
        for (int j = 0; j < 4; ++j) cw[j] = *(const f32x4*)(a.in[7] + (size_t)j * D + gc);
        const bf16* wr_ = (const bf16*)(ws + WS_LRUW) + (size_t)(h * 128 + 16 * wid + fr) * 128 + 8 * fq;
        const bf16* wi_ = wr_ + (size_t)8 * 128 * 128;
        bf16x8 Br[4], Bi[4];
#pragma unroll
        for (int ks = 0; ks < 4; ++ks) { Br[ks] = *(const bf16x8*)(wr_ + 32 * ks); Bi[ks] = *(const bf16x8*)(wi_ + 32 * ks); }
        const int ch = 128 * h + 16 * wid + fr;
        const float br = a.in[10][ch], bi = a.in[12][ch], ls8 = -8.0f * log1pf(__expf(-a.in[13][ch]));
        float hin = OUT ? ((const float*)(ws + WS_LRU_CARRY))[(size_t)(b * NCHUNK + c) * D + ch] : 0.f;
        __syncthreads();
        { float w0[4], w1[4], w2[4], w3[4]; const LAS unsigned char* rp = lds + L_RAW + (8 * tg) * RLD + 8 * n; u32x2 u;
          u = *(const LAS u32x2*)(rp); w0[0] = bf2f(u.x & 0xffffu); w0[1] = bf2f(u.x >> 16); w0[2] = bf2f(u.y & 0xffffu); w0[3] = bf2f(u.y >> 16);
          u = *(const LAS u32x2*)(rp + RLD); w1[0] = bf2f(u.x & 0xffffu); w1[1] = bf2f(u.x >> 16); w1[2] = bf2f(u.y & 0xffffu); w1[3] = bf2f(u.y >> 16);
          u = *(const LAS u32x2*)(rp + 2 * RLD); w2[0] = bf2f(u.x & 0xffffu); w2[1] = bf2f(u.x >> 16); w2[2] = bf2f(u.y & 0xffffu); w2[3] = bf2f(u.y >> 16);
#pragma unroll
          for (int i = 0; i < 8; ++i) { const int t = 8 * tg + i;
              u = *(const LAS u32x2*)(rp + (3 + i) * RLD); w3[0] = bf2f(u.x & 0xffffu); w3[1] = bf2f(u.x >> 16); w3[2] = bf2f(u.y & 0xffffu); w3[3] = bf2f(u.y >> 16);
              float y[4];
#pragma unroll
              for (int e = 0; e < 4; ++e) y[e] = cb[e] + cw[0][e] * w0[e] + cw[1][e] * w1[e] + cw[2][e] * w2[e] + cw[3][e] * w3[e];
              u32x2 o; o.x = pk2(y[0], y[1]); o.y = pk2(y[2], y[3]); *(LAS u32x2*)(lds + L_T0 + t * RLD + 8 * n) = o;
#pragma unroll
              for (int e = 0; e < 4; ++e) { w0[e] = w1[e]; w1[e] = w2[e]; w2[e] = w3[e]; } } }
        __syncthreads();
        if (h < 7) RAW_PF(pr, proj, EVEN_IN, row0, c * CH, 128 * (h + 1));
        float aprod = 1.f;
#pragma unroll 1
        for (int mt = 0; mt < 8; ++mt) {
            f32x4 ar = (f32x4){0.f, 0.f, 0.f, 0.f}, ai = ar;
#pragma unroll
            for (int ks = 0; ks < 4; ++ks) { const bf16x8 A = LFRAG(lds + L_T0, 16 * mt + fr, 32 * ks + 8 * fq); ar = MFMA16(A, Br[ks], ar); ai = MFMA16(A, Bi[ks], ai); }
            float av[4], uv[4];
#pragma unroll
            for (int j = 0; j < 4; ++j) { const float rr = sigmoidf_(ar[j] + br), ii = sigmoidf_(ai[j] + bi); av[j] = __expf(rr * ls8);
                const float x = bf2f(*(const LAS bf16*)(lds + L_T0 + (16 * mt + 4 * fq + j) * RLD + (16 * wid + fr) * 2));
                uv[j] = __builtin_amdgcn_sqrtf(fmaxf(1.0f - av[j] * av[j], 0.f)) * ii * x; }
            const float As = av[0] * av[1] * av[2] * av[3];
            const float Hs = ((uv[0] * av[1] + uv[1]) * av[2] + uv[2]) * av[3] + uv[3];
            const float A0 = __shfl(As, fr), H0 = __shfl(Hs, fr), A1 = __shfl(As, 16 + fr), H1 = __shfl(Hs, 16 + fr), A2 = __shfl(As, 32 + fr), H2 = __shfl(Hs, 32 + fr), A3 = __shfl(As, 48 + fr), H3 = __shfl(Hs, 48 + fr);
            const float h0 = hin, h1 = A0 * h0 + H0, h2 = A1 * h1 + H1, h3 = A2 * h2 + H2, hend = A3 * h3 + H3;
            if (OUT) { float hs = fq == 0 ? h0 : (fq == 1 ? h1 : (fq == 2 ? h2 : h3));
#pragma unroll
                for (int j = 0; j < 4; ++j) { hs = av[j] * hs + uv[j]; const int off = (16 * mt + 4 * fq + j) * RLD + (16 * wid + fr) * 2;
                    const float g = bf2f(*(const LAS bf16*)(lds + L_T1 + off)); *(LAS bf16*)(lds + L_T2 + off) = (bf16)f2bf(hs * gelu_tanh(g)); } }
            else { float hs = fq == 0 ? h0 : (fq == 1 ? h1 : (fq == 2 ? h2 : h3));
                float pp = aprod * (fq == 0 ? 1.0f : (fq == 1 ? A0 : (fq == 2 ? A0 * A1 : A0 * A1 * A2)));
#pragma unroll
                for (int j = 0; j < 4; ++j) { hs = av[j] * hs + uv[j]; pp *= av[j]; const int off = (16 * mt + 4 * fq + j) * RLD + (16 * wid + fr) * 2;
                    *(LAS bf16*)(lds + L_T1 + off) = (bf16)f2bf(hs); *(LAS bf16*)(lds + L_T2 + off) = (bf16)f2bf(pp); } }
            hin = hend; aprod *= (A0 * A1) * (A2 * A3);
        }
        if (!OUT && fq == 0) { ((float*)(ws + WS_LRU_AT))[(size_t)(b * NCHUNK + c) * D + ch] = aprod; ((float*)(ws + WS_LRU_HT))[(size_t)(b * NCHUNK + c) * D + ch] = hin; }
        __syncthreads();
        if (OUT) {
#pragma unroll
            for (int i = 0; i < 4; ++i) { const int q = F.tid + i * NTHR, r = q >> 4, cc = q & 15; *(u32x4*)((bf16*)(ws + WS_MIX) + (size_t)(row0 + r) * MIXW + 128 * h + 8 * cc) = *(const LAS u32x4*)(lds + L_T2 + r * RLD + cc * 16); }
        } else {
#pragma unroll
            for (int i = 0; i < 4; ++i) { const int q = F.tid + i * NTHR, r = q >> 4, cc = q & 15; const size_t go = (size_t)(row0 + r) * D + 128 * h + 8 * cc;
                *(u32x4*)((bf16*)(ws + WS_LRU_HL) + go) = *(const LAS u32x4*)(lds + L_T1 + r * RLD + cc * 16); *(u32x4*)((bf16*)(ws + WS_LRU_PC) + go) = *(const LAS u32x4*)(lds + L_T2 + r * RLD + cc * 16); }
        }
    }
    __syncthreads();
}

__device__ __forceinline__ void ph_ev_local(const PArgs& a, Frame& F) { for (int u = F.bid; u < NB * NCHUNK; u += F.G) { const int b = u / NCHUNK, c = u % NCHUNK; lru_unit2<false>(a, F, b, c); ml_pre(a, F, b, c); ml_local2_nl((const GAS unsigned char*)a.in.p, (GAS unsigned char*)F.ws, b, c); } }
__device__ __forceinline__ void ph_ev_out(const PArgs& a, Frame& F) { for (int u = F.bid; u < NB * NCHUNK; u += F.G) { const int b = u / NCHUNK, c = u % NCHUNK; lru_fix(a, F, b, c); ml_out2(a, F, b, c); } }
__device__ __forceinline__ void ph_ev_scan(const PArgs& a, Frame& F) {
    unsigned char* ws = F.ws; const size_t gt = (size_t)F.bid * NTHR + F.tid, NT = (size_t)F.G * NTHR;
    for (size_t i = gt; i < (size_t)NB * D; i += NT) { const int b = (int)(i / D), ch = (int)(i % D); float carry = 0.f;
        for (int c = 0; c < NCHUNK; ++c) { const size_t o = (size_t)(b * NCHUNK + c) * D + ch; ((float*)(ws + WS_LRU_CARRY))[o] = carry; carry = ((const float*)(ws + WS_LRU_AT))[o] * carry + ((const float*)(ws + WS_LRU_HT))[o]; } }
    for (size_t i = gt; i < (size_t)64 * 4096; i += NT) { const int bh = (int)(i >> 12), e4 = (int)(i & 4095);
        float m = -1.0e30f; f32x4 val = (f32x4){0.f, 0.f, 0.f, 0.f};
#pragma unroll 1
        for (int c0 = 0; c0 < NCHUNK; c0 += 8) { u32x2 loc[8]; float Gv[8], mlv[8];
#pragma unroll
            for (int k = 0; k < 8; ++k) { const int u = bh * NCHUNK + c0 + k; Gv[k] = ((const float*)(ws + WS_ML_GT))[u]; mlv[k] = ((const float*)(ws + WS_ML_ML))[u]; loc[k] = *(const u32x2*)((const bf16*)(ws + WS_CLOC) + (size_t)u * 16384 + 4 * e4); }
#pragma unroll
            for (int k = 0; k < 8; ++k) { const int u = bh * NCHUNK + c0 + k;
                u32x2 w; w.x = pk2(val[0], val[1]); w.y = pk2(val[2], val[3]); *(u32x2*)((bf16*)(ws + WS_CST) + (size_t)u * 16384 + 4 * e4) = w;
                if (e4 == 0) ((float*)(ws + WS_ML_MS))[u] = m;
                const float mn = fmaxf(m + Gv[k], mlv[k]); const float wc = __expf(m + Gv[k] - mn), wl = __expf(mlv[k] - mn);
                const f32x4 lv = (f32x4){bf2f(loc[k].x & 0xffffu), bf2f(loc[k].x >> 16), bf2f(loc[k].y & 0xffffu), bf2f(loc[k].y >> 16)};
                val = val * wc + lv * wl; m = mn; } } }
    for (size_t i = gt; i < (size_t)64 * 128; i += NT) { const int bh = (int)(i >> 7), e = (int)(i & 127);
        float m = -1.0e30f, val = 0.f;
#pragma unroll 1
        for (int c0 = 0; c0 < NCHUNK; c0 += 8) { float loc[8], Gv[8], mlv[8];
#pragma unroll
            for (int k = 0; k < 8; ++k) { const int u = bh * NCHUNK + c0 + k; Gv[k] = ((const float*)(ws + WS_ML_GT))[u]; mlv[k] = ((const float*)(ws + WS_ML_ML))[u]; loc[k] = ((const float*)(ws + WS_ML_NLOC))[(size_t)u * 128 + e]; }
#pragma unroll
            for (int k = 0; k < 8; ++k) { const int u = bh * NCHUNK + c0 + k;
                ((float*)(ws + WS_ML_NST))[(size_t)u * 128 + e] = val;
                const float mn = fmaxf(m + Gv[k], mlv[k]); const float wc = __expf(m + Gv[k] - mn), wl = __expf(mlv[k] - mn);
                val = wc * val + wl * loc[k]; m = mn; } } }
}

__device__ __forceinline__ void ssd_pre(const PArgs& a, Frame& F0, int b, int c) { Frame F = relaunder(F0);
    unsigned char* ws = F.ws; const bf16* proj = (const bf16*)(ws + WS_PROJ); bf16* xbc = (bf16*)(ws + WS_XBC);
    const int row0 = b * SEQ + c * CH, ch0 = 8 * F.tid;
    float cw[4][8], cb[8];
#pragma unroll
    for (int j = 0; j < 4; ++j) { const f32x4 lo = *(const f32x4*)(a.in[27] + (size_t)j * 4096 + ch0), hi = *(const f32x4*)(a.in[27] + (size_t)j * 4096 + ch0 + 4);
#pragma unroll
        for (int e = 0; e < 4; ++e) { cw[j][e] = lo[e]; cw[j][4 + e] = hi[e]; } }
    { const f32x4 lo = *(const f32x4*)(a.in[28] + ch0), hi = *(const f32x4*)(a.in[28] + ch0 + 4);
#pragma unroll
        for (int e = 0; e < 4; ++e) { cb[e] = lo[e]; cb[4 + e] = hi[e]; } }
    const bf16* src = proj + (size_t)row0 * OD_INP + 2048 + ch0;
    u32x4 r0 = (u32x4){0u, 0u, 0u, 0u}, r1 = r0, r2 = r0;
    if (c > 0) { r0 = *(const u32x4*)(src - 3 * (ptrdiff_t)OD_INP); r1 = *(const u32x4*)(src - 2 * (ptrdiff_t)OD_INP); r2 = *(const u32x4*)(src - (ptrdiff_t)OD_INP); }
#pragma unroll 1
    for (int t0 = 0; t0 < CH; t0 += 8) {
        u32x4 rr[8];
#pragma unroll
        for (int i = 0; i < 8; ++i) rr[i] = *(const u32x4*)(src + (size_t)(t0 + i) * OD_INP);
#pragma unroll
        for (int i = 0; i < 8; ++i) { const u32x4 r3 = rr[i]; float o[8];
#pragma unroll
            for (int e = 0; e < 8; ++e) { const unsigned w0 = (e < 2) ? r0.x : (e < 4) ? r0.y : (e < 6) ? r0.z : r0.w, w1 = (e < 2) ? r1.x : (e < 4) ? r1.y : (e < 6) ? r1.z : r1.w,
                    w2 = (e < 2) ? r2.x : (e < 4) ? r2.y : (e < 6) ? r2.z : r2.w, w3 = (e < 2) ? r3.x : (e < 4) ? r3.y : (e < 6) ? r3.z : r3.w;
                const float x0 = bf2f((e & 1) ? (w0 >> 16) : (w0 & 0xffffu)), x1 = bf2f((e & 1) ? (w1 >> 16) : (w1 & 0xffffu)), x2 = bf2f((e & 1) ? (w2 >> 16) : (w2 & 0xffffu)), x3 = bf2f((e & 1) ? (w3 >> 16) : (w3 & 0xffffu));
                o[e] = siluf_(cb[e] + cw[0][e] * x0 + cw[1][e] * x1 + cw[2][e] * x2 + cw[3][e] * x3); }
            u32x4 w; w.x = pk2(o[0], o[1]); w.y = pk2(o[2], o[3]); w.z = pk2(o[4], o[5]); w.w = pk2(o[6], o[7]);
            *(u32x4*)(xbc + (size_t)(row0 + t0 + i) * 4096 + ch0) = w;
            r0 = r1; r1 = r2; r2 = r3; }
    }
}
constexpr int L_DT2 = L_T2, L_AC2 = L_T2 + 16384;
constexpr int L_DT4 = L_SM, L_AC4 = L_SM + 2048;
__device__ __forceinline__ void ssd_local2(const PArgs& a, Frame& F0, int b, int c) { Frame F = relaunder(F0);
    unsigned char* ws = F.ws; LAS unsigned char* lds = F.lds;
    const bf16* proj = (const bf16*)(ws + WS_PROJ); const bf16* xbc = (const bf16*)(ws + WS_XBC);
    const int wid = F.wave, lane = F.lane, fr = lane & 15, fq = lane >> 4, row0 = b * SEQ + c * CH;
    LAS float* DT = (LAS float*)(lds + L_DT2); LAS float* AC = (LAS float*)(lds + L_AC2);
    __syncthreads();
    for (int q = F.tid; q < CH * 32; q += NTHR) { const int t = q >> 5, hd = q & 31; const float raw = bf2f(proj[(size_t)(row0 + t) * OD_INP + 6144 + hd]); DT[q] = softplusf_(raw + a.in[29][hd]); }
    __syncthreads();
    if (F.tid < 32) { const float A = -__expf(a.in[30][F.tid]); float acc = 0.f; for (int t = 0; t < CH; ++t) { acc += DT[t * 32 + F.tid] * A; AC[t * 32 + F.tid] = acc; }
        ((float*)(ws + WS_SSD_ALAST))[(size_t)(b * NCHUNK + c) * 32 + F.tid] = acc; }
    __syncthreads();
    for (int q = F.tid; q < CH * 32; q += NTHR) { ((float*)(ws + WS_DTG))[(size_t)row0 * 32 + q] = DT[q]; ((float*)(ws + WS_ACG))[(size_t)row0 * 32 + q] = AC[q]; }
    ssd_pre(a, F, b, c);
    WSYNC();
    for (int g = 0; g < 8; ++g) {
        copy_tile(F, xbc + (size_t)row0 * 4096 + 2048 + 128 * g, 4096, L_T1);
        for (int jp = 0; jp < 2; ++jp) { const int hd0 = 4 * g + 2 * jp;
            const bf16* xs = xbc + (size_t)row0 * 4096 + 64 * hd0;
#pragma unroll
            for (int i = 0; i < 4; ++i) { const int q = F.tid + i * NTHR, r = q >> 4, cc = q & 15, hd = hd0 + (cc >> 3);
                const float sc = __expf(AC[127 * 32 + hd] - AC[r * 32 + hd]) * DT[r * 32 + hd];
                *(LAS u32x4*)(lds + L_T0 + r * RLD + cc * 16) = scale8(*(const u32x4*)(xs + (size_t)r * 4096 + 8 * cc), sc); }
            __syncthreads();
            bf16x8 Ax[4]; tr_frag4<RLD>(tr_addr(lds + L_T0, 16 * wid, lane), Ax);
            bf16* sl = (bf16*)(ws + WS_SLOC) + ((size_t)(b * NCHUNK + c) * 32 + hd0 + (wid >> 2)) * 8192;
#pragma unroll
            for (int nt = 0; nt < 8; ++nt) { bf16x8 Bb[4]; tr_frag4<RLD>(tr_addr(lds + L_T1, 16 * nt, lane), Bb);
                f32x4 acc = (f32x4){0.f, 0.f, 0.f, 0.f};
#pragma unroll
                for (int ks = 0; ks < 4; ++ks) acc = MFMA16(Ax[ks], Bb[ks], acc);
#pragma unroll
                for (int jj = 0; jj < 4; ++jj) sl[(16 * (wid & 3) + 4 * fq + jj) * 128 + 16 * nt + fr] = (bf16)f2bf(acc[jj]); }
            __syncthreads();
        }
    }
}
constexpr int L_NW4 = L_SM + 4096, L_SS = L_SM + 5120;
__device__ __forceinline__ void ssd_out3(const PArgs& a, Frame& F0, int b, int c) { Frame F = relaunder(F0);
    unsigned char* ws = F.ws; LAS unsigned char* lds = F.lds;
    const bf16* proj = (const bf16*)(ws + WS_PROJ); const bf16* xbc = (const bf16*)(ws + WS_XBC); bf16* mix = (bf16*)(ws + WS_MIX);
    const int wid = F.wave, lane = F.lane, fr = lane & 15, fq = lane >> 4, row0 = b * SEQ + c * CH;
    LAS float* DT4 = (LAS float*)(lds + L_DT4); LAS float* AC4 = (LAS float*)(lds + L_AC4); LAS float* NW4 = (LAS float*)(lds + L_NW4);
    LAS unsigned char* PS = lds + L_RAW + wid * 16 * RLD;
    LAS unsigned char* YS = lds + L_T0 + wid * 8448;
    const bf16* sstb = (const bf16*)(ws + WS_SST) + (size_t)(b * NCHUNK + c) * 32 * 8192;
    u32x4 pss[2];
#define SS_PF(hd_) do { const bf16* sp_ = sstb + (size_t)(hd_) * 8192; _Pragma("unroll") for (int i_ = 0; i_ < 2; ++i_) { const int q_ = F.tid + i_ * NTHR; pss[i_] = *(const u32x4*)(sp_ + (size_t)(q_ >> 4) * 128 + 8 * (q_ & 15)); } } while (0)
#define SS_PW() do { _Pragma("unroll") for (int i_ = 0; i_ < 2; ++i_) { const int q_ = F.tid + i_ * NTHR; *(LAS u32x4*)(lds + L_SS + (q_ >> 4) * RLD + (q_ & 15) * 16) = pss[i_]; } } while (0)
    SS_PF(0);
    for (int g = 0; g < 8; ++g) {
        __syncthreads();
        const bf16* xb0 = xbc + (size_t)row0 * 4096;
        copy_tile(F, xb0 + 3072 + 128 * g, 4096, L_T0);
        copy_tile(F, xb0 + 2048 + 128 * g, 4096, L_T1);
        copy_tile(F, xb0 + 64 * (4 * g), 4096, L_T2);
        u32x4 px1[4];
#pragma unroll
        for (int i = 0; i < 4; ++i) { const int q = F.tid + i * NTHR; px1[i] = *(const u32x4*)(xb0 + 64 * (4 * g + 2) + (size_t)(q >> 4) * 4096 + 8 * (q & 15)); }
        { const int t = F.tid >> 2, j = F.tid & 3; DT4[F.tid] = ((const float*)(ws + WS_DTG))[(size_t)(row0 + t) * 32 + 4 * g + j]; AC4[F.tid] = ((const float*)(ws + WS_ACG))[(size_t)(row0 + t) * 32 + 4 * g + j]; }
        if (F.tid < 256) NW4[F.tid] = a.in[32][256 * g + F.tid];
        __syncthreads();
        bf16x8 Ac[4];
#pragma unroll
        for (int ks = 0; ks < 4; ++ks) Ac[ks] = LFRAG(lds + L_T0, 16 * wid + fr, 32 * ks + 8 * fq);
        f32x4 cb[8];
#pragma unroll
        for (int nt = 0; nt < 8; ++nt) { cb[nt] = (f32x4){0.f, 0.f, 0.f, 0.f};
            if (nt <= wid) {
#pragma unroll
                for (int ks = 0; ks < 4; ++ks) { const bf16x8 B = LFRAG(lds + L_T1, 16 * nt + fr, 32 * ks + 8 * fq); cb[nt] = MFMA16(Ac[ks], B, cb[nt]); } } }
        __syncthreads();
#pragma unroll
        for (int i = 0; i < 4; ++i) { const int q = F.tid + i * NTHR; *(LAS u32x4*)(lds + L_T1 + (q >> 4) * RLD + (q & 15) * 16) = px1[i]; }
        SS_PW();
        __syncthreads();
        unsigned yp[4][4][2];
#pragma unroll 1
        for (int j = 0; j < 4; ++j) { const int hd = 4 * g + j; const int xoff = (j < 2 ? L_T2 : L_T1), xcol = 64 * (j & 1);
            if (hd < 31) SS_PF(hd + 1);
            float at[4];
#pragma unroll
            for (int jj = 0; jj < 4; ++jj) at[jj] = AC4[(16 * wid + 4 * fq + jj) * 4 + j];
#pragma unroll
            for (int nt = 0; nt < 8; ++nt) {
                if (nt <= wid) { const int s_ = 16 * nt + fr; const float as = AC4[s_ * 4 + j], ds = DT4[s_ * 4 + j];
#pragma unroll
                    for (int jj = 0; jj < 4; ++jj) { const int t = 16 * wid + 4 * fq + jj; const float w = (s_ <= t) ? cb[nt][jj] * __expf(at[jj] - as) * ds : 0.f;
                        *(LAS bf16*)(PS + (4 * fq + jj) * RLD + s_ * 2) = (bf16)f2bf(w); }
                } else if (nt == wid + 1) {
#pragma unroll
                    for (int jj = 0; jj < 4; ++jj) *(LAS bf16*)(PS + (4 * fq + jj) * RLD + (16 * nt + fr) * 2) = (bf16)0;
                }
            }
            asm volatile("s_waitcnt lgkmcnt(0)" ::: "memory");
            f32x4 ya[4];
#pragma unroll
            for (int np = 0; np < 4; ++np) ya[np] = (f32x4){0.f, 0.f, 0.f, 0.f};
#pragma unroll
            for (int ks = 0; ks < 4; ++ks) {
#pragma unroll
                for (int np = 0; np < 4; ++np) { const bf16x8 B = LFRAG(lds + L_SS, 16 * np + fr, 32 * ks + 8 * fq); ya[np] = MFMA16(Ac[ks], B, ya[np]); } }
#pragma unroll
            for (int np = 0; np < 4; ++np)
#pragma unroll
                for (int jj = 0; jj < 4; ++jj) ya[np][jj] *= __expf(at[jj]);
            const int kmax = (wid + 2) >> 1;
            bf16x8 Ap[4];
#pragma unroll
            for (int ks = 0; ks < 4; ++ks) Ap[ks] = LFRAG(PS, fr, 32 * ks + 8 * fq);
            const float dsk = a.in[31][hd];
#pragma unroll
            for (int np = 0; np < 4; ++np) { bf16x8 Bx[4]; tr_frag4<RLD>(tr_addr(lds + xoff, xcol + 16 * np, lane), Bx);
#pragma unroll
                for (int ks = 0; ks < 4; ++ks) if (ks < kmax) ya[np] = MFMA16(Ap[ks], Bx[ks], ya[np]);
                float yg[4];
#pragma unroll
                for (int jj = 0; jj < 4; ++jj) { const int t = 16 * wid + 4 * fq + jj; const float x = bf2f(*(const LAS bf16*)(lds + xoff + t * RLD + (xcol + 16 * np + fr) * 2)); yg[jj] = ya[np][jj] + dsk * x; }
                const unsigned p0 = pk2(yg[0], yg[1]), p1 = pk2(yg[2], yg[3]);
                if (j == 0) { yp[0][np][0] = p0; yp[0][np][1] = p1; } else if (j == 1) { yp[1][np][0] = p0; yp[1][np][1] = p1; } else if (j == 2) { yp[2][np][0] = p0; yp[2][np][1] = p1; } else { yp[3][np][0] = p0; yp[3][np][1] = p1; } }
            __syncthreads();
            if (j < 3) { SS_PW(); __syncthreads(); }
        }
        const int er = lane >> 2, ej = lane & 3; const size_t egrow = (size_t)(row0 + 16 * wid + er); const int ehd = 4 * g + ej;
        u32x4 zw[8];
#pragma unroll
        for (int q = 0; q < 8; ++q) zw[q] = *(const u32x4*)(proj + egrow * OD_INP + 64 * ehd + 8 * q);
#pragma unroll
        for (int j = 0; j < 4; ++j)
#pragma unroll
            for (int np = 0; np < 4; ++np)
#pragma unroll
                for (int jj = 0; jj < 4; ++jj) { const unsigned pw = yp[j][np][jj >> 1]; *(LAS bf16*)(YS + (4 * fq + jj) * 528 + (64 * j + 16 * np + fr) * 2) = (bf16)((jj & 1) ? (pw >> 16) : (pw & 0xffffu)); }
        asm volatile("s_waitcnt lgkmcnt(0)" ::: "memory");
        { float ssq = 0.f;
#pragma unroll
            for (int q = 0; q < 8; ++q) { LAS u32x4* yp_ = (LAS u32x4*)(YS + er * 528 + (64 * ej + 8 * q) * 2); const u32x4 yw = *yp_; float o[8];
#pragma unroll
                for (int e = 0; e < 8; ++e) { const unsigned yy = (e < 2) ? yw.x : (e < 4) ? yw.y : (e < 6) ? yw.z : yw.w, zz = (e < 2) ? zw[q].x : (e < 4) ? zw[q].y : (e < 6) ? zw[q].z : zw[q].w;
                    const float y = bf2f((e & 1) ? (yy >> 16) : (yy & 0xffffu)), z = bf2f((e & 1) ? (zz >> 16) : (zz & 0xffffu)); o[e] = y * siluf_(z); ssq += o[e] * o[e]; }
                u32x4 w; w.x = pk2(o[0], o[1]); w.y = pk2(o[2], o[3]); w.z = pk2(o[4], o[5]); w.w = pk2(o[6], o[7]); *yp_ = w; }
            ssq += __shfl_xor(ssq, 1); ssq += __shfl_xor(ssq, 2);
            const float rstd = __builtin_amdgcn_rsqf(ssq * (1.0f / 256.0f) + EPS);
#pragma unroll
            for (int q = 0; q < 8; ++q) { const int cl = 64 * ej + 8 * q; const f32x4 n0 = *(const LAS f32x4*)(NW4 + cl), n1 = *(const LAS f32x4*)(NW4 + cl + 4); const u32x4 yw = *(const LAS u32x4*)(YS + er * 528 + cl * 2);
                u32x4 w; w.x = pk2(bf2f(yw.x & 0xffffu) * rstd * n0[0], bf2f(yw.x >> 16) * rstd * n0[1]); w.y = pk2(bf2f(yw.y & 0xffffu) * rstd * n0[2], bf2f(yw.y >> 16) * rstd * n0[3]);
                w.z = pk2(bf2f(yw.z & 0xffffu) * rstd * n1[0], bf2f(yw.z >> 16) * rstd * n1[1]); w.w = pk2(bf2f(yw.w & 0xffffu) * rstd * n1[2], bf2f(yw.w >> 16) * rstd * n1[3]);
                *(u32x4*)(mix + egrow * MIXW + 256 * g + cl) = w; } }
    }
    __syncthreads();
#undef SS_PF
#undef SS_PW
}
__device__ __forceinline__ void ph_od_local(const PArgs& a, Frame& F) { for (int u = F.bid; u < NB * NCHUNK; u += F.G) ssd_local2(a, F, u / NCHUNK, u % NCHUNK); }
__device__ __forceinline__ void ph_od_out(const PArgs& a, Frame& F) { for (int u = F.bid; u < NB * NCHUNK; u += F.G) ssd_out3(a, F, u / NCHUNK, u % NCHUNK); }
__device__ __forceinline__ void ph_od_scan(const PArgs& a, Frame& F) {
    unsigned char* ws = F.ws; const size_t gt = (size_t)F.bid * NTHR + F.tid, NT = (size_t)F.G * NTHR;
    for (size_t i = gt; i < (size_t)NB * 32 * 8192 / 4; i += NT) { const int b = (int)(i / (32 * 2048)), rem = (int)(i % (32 * 2048)), hd = rem / 2048, e4 = rem % 2048;
        f32x4 st = (f32x4){0.f, 0.f, 0.f, 0.f};
#pragma unroll 1
        for (int c0 = 0; c0 < NCHUNK; c0 += 8) { f32x4 loc[8]; float dec[8];
#pragma unroll
            for (int k = 0; k < 8; ++k) { const size_t u = (size_t)(b * NCHUNK + c0 + k) * 32 + hd; { const u32x2 lw = *(const u32x2*)((const bf16*)(ws + WS_SLOC) + u * 8192 + 4 * e4); loc[k] = (f32x4){bf2f(lw.x & 0xffffu), bf2f(lw.x >> 16), bf2f(lw.y & 0xffffu), bf2f(lw.y >> 16)}; } dec[k] = ((const float*)(ws + WS_SSD_ALAST))[u]; }
#pragma unroll
            for (int k = 0; k < 8; ++k) { const size_t u = (size_t)(b * NCHUNK + c0 + k) * 32 + hd;
                u32x2 w; w.x = pk2(st[0], st[1]); w.y = pk2(st[2], st[3]); *(u32x2*)((bf16*)(ws + WS_SST) + u * 8192 + 4 * e4) = w;
                st = st * __expf(dec[k]) + loc[k]; } } }
}

__device__ __forceinline__ int moe_tables(Frame& F, int l) {
    LAS int* tab = (LAS int*)(F.lds + L_SCHED);
    __syncthreads();
    if (F.tid == 0) { int o = 0, ts = 0; for (int e = 0; e < NE; ++e) { const int cnt = (int)F.ctl[CW_CNT + l * 2048 + e * 64]; tab[e] = cnt; tab[32 + e] = o; tab[65 + e] = ts; o += cnt; ts += (cnt + 255) >> 8; } tab[64] = o; tab[97] = ts; }
    __syncthreads();
    return tab[97];
}
__device__ __forceinline__ void ph_moe1(const PArgs& a, Frame& F, int l) {
    const int ntiles = moe_tables(F, l);
    pg8::MoeSched<true, 8, 4> S; S.A = (const void*)(F.ws + WS_U); S.Bt = (const void*)(F.ws + WS_WGU + (size_t)l * 32 * 2048 * D); S.rowtok = (const int*)(F.ws + WS_ROWTOK);
    S.PB = D; S.G = F.G; S.c = F.bid; S.ntiles = ntiles; S.tab = (const LAS int*)(F.lds + L_SCHED); S.bstride = 2048;
    pg8::EpiSwiglu E{(unsigned char*)(F.ws + WS_ACT), a.in[37] + (size_t)l * 32 * 2048, (unsigned char*)(F.ws + WS_DUMMY) + F.tid * 16};
    pg8::gemm_phase<pg8::EpiSwiglu, pg8::MoeSched<true, 8, 4>, true>(F.lds, S, E);
}
__device__ __forceinline__ void ph_moe2(const PArgs& a, Frame& F, int l) {
    const int ntiles = moe_tables(F, l);
    pg8::MoeSched<false, 4, 8> S; S.A = (const void*)(F.ws + WS_ACT); S.Bt = (const void*)(F.ws + WS_WDN + (size_t)l * 32 * D * DFF); S.rowtok = nullptr;
    S.PB = DFF; S.G = F.G; S.c = F.bid; S.ntiles = ntiles; S.tab = (const LAS int*)(F.lds + L_SCHED); S.bstride = 1024;
    pg8::EpiDown E{(unsigned char*)(F.ws + WS_YBUF), a.in[39] + (size_t)l * 32 * D, (const float*)(F.ws + WS_ROWGATE), (unsigned char*)(F.ws + WS_DUMMY) + F.tid * 16};
    pg8::gemm_phase<pg8::EpiDown, pg8::MoeSched<false, 4, 8>, true>(F.lds, S, E);
}
__device__ __forceinline__ void ph_gemm_plain_bf16(Frame& F, size_t wsA, size_t wsB, int N, int K, size_t wsO) {
    pg8::PlainSched S; S.init((const bf16*)(F.ws + wsA), (const bf16*)(F.ws + wsB), MTOK, N, K, F.G, F.bid);
    pg8::EpiBf16 E{(bf16*)(F.ws + wsO), N, 1.0f};
    pg8::gemm_phase<pg8::EpiBf16, pg8::PlainSched>(F.lds, S, E);
}
__device__ __forceinline__ void ph_gemm_plain_fp8(Frame& F, size_t wsA, size_t wsB, int N, int K, size_t wsO) {
    pg8::PlainSched S; S.init((const void*)(F.ws + wsA), (const void*)(F.ws + wsB), MTOK, N, K, F.G, F.bid, 1);
    pg8::EpiBf16 E{(bf16*)(F.ws + wsO), N, pg8::WINV8};
    pg8::gemm_phase<pg8::EpiBf16, pg8::PlainSched, true>(F.lds, S, E);
}
template <bool HIN_F32>
__device__ __forceinline__ void ph_gemm_resid(Frame& F, size_t wsB, const GAS void* hin, bf16* hout, int l) {
    pg8::PlainSched S; S.init((const bf16*)(F.ws + WS_MIX), (const bf16*)(F.ws + wsB), MTOK, D, MIXW, F.G, F.bid);
    pg8::EpiResid<HIN_F32> E{hin, hout, (const float*)(F.ws + WS_MODF) + (size_t)l * 8 * 6144 + 2048};
    pg8::gemm_phase<pg8::EpiResid<HIN_F32>, pg8::PlainSched>(F.lds, S, E);
}

__global__ void __launch_bounds__(NTHR, 2) mk_fwd(Args args) {
    extern __shared__ __attribute__((aligned(16))) unsigned char lds_[];
    Frame F;
    F.lds = (LAS unsigned char*)lds_; F.tid = threadIdx.x; F.lane = F.tid & 63; F.wave = __builtin_amdgcn_readfirstlane(F.tid >> 6);
    F.G = gridDim.x; F.bid = blockIdx.x; F.ws = args.ws; F.ctl = (unsigned*)(args.ws + WS_CTL);
    const int lo = args.ph_lo, hi = args.ph_hi;
    volatile LAS unsigned* misc = (volatile LAS unsigned*)(F.lds + L_MISC);
    if (F.tid < 4) misc[F.tid] = 0u;
    __syncthreads();
    XcdBarrier bar; bar.bar = F.ctl + CW_BAR; bar.x = 0; bar.st = misc;
    if (hi - lo > 1) bar = xcd_barrier_post(F.ctl + CW_BAR, misc);
#define IN(k) (lo <= (k) && (k) < hi)
#define SEAM(k) do { if (IN(k) && IN((k) + 1)) xcd_barrier(bar); } while (0)
    bf16* H1 = (bf16*)(F.ws + WS_H1); bf16* H2 = (bf16*)(F.ws + WS_H2);
    PArgs pa; pa.in.p = (const float* const*)(const GAS unsigned char*)(F.ws + WS_ARGTAB);
    if (IN(0)) ph_prep(args, F);
    SEAM(0);
    if (IN(1)) ph_rows<0>(pa, F, 0);
    SEAM(1);
    if (IN(2)) ph_gemm_plain_bf16(F, WS_U, WS_WEVIN, EVEN_IN, D, WS_PROJ);
    SEAM(2);
    if (IN(3)) ph_ev_local(pa, F);
    SEAM(3);
    if (IN(4)) ph_ev_scan(pa, F);
    SEAM(4);
    if (IN(5)) ph_ev_out(pa, F);
    SEAM(5);
    if (IN(6)) ph_gemm_resid<true>(F, WS_WEVOUT, (const GAS void*)pa.in[0], H1, 0);
    SEAM(6);
    if (IN(7)) ph_route(pa, F, 0);
    SEAM(7);
    if (IN(8)) ph_moe1(pa, F, 0);
    SEAM(8);
    if (IN(9)) ph_moe2(pa, F, 0);
    SEAM(9);
    if (IN(10)) ph_rows<1>(pa, F, 0);
    SEAM(10);
    if (IN(11)) ph_gemm_plain_fp8(F, WS_U, WS_WODIN, OD_INP, D, WS_PROJ);
    SEAM(11);
    if (IN(12)) ph_od_local(pa, F);
    SEAM(12);
    if (IN(13)) ph_od_scan(pa, F);
    SEAM(13);
    if (IN(14)) ph_od_out(pa, F);
    SEAM(14);
    if (IN(15)) ph_gemm_resid<false>(F, WS_WODOUT, (const GAS void*)H2, H1, 1);
    SEAM(15);
    if (IN(16)) ph_route(pa, F, 1);
    SEAM(16);
    if (IN(17)) ph_moe1(pa, F, 1);
    SEAM(17);
    if (IN(18)) ph_moe2(pa, F, 1);
    SEAM(18);
    if (IN(19)) ph_rows<2>(pa, F, 1);
#undef IN
#undef SEAM
}

extern "C" void kernel_launch(void* const* d_in, const int* in_sizes, int n_in, void* d_out, int out_size, void* d_ws, size_t ws_size, hipStream_t stream) {
    static int grid = 0;
    if (grid == 0) {
        if (n_in != 41 || out_size != MTOK * D || ws_size < WS_END) { fprintf(stderr, "kernel_launch: unexpected shapes (n_in %d, out %d, ws %zu < %zu)\n", n_in, out_size, ws_size, (size_t)WS_END); grid = -1; return; }
        int dev = 0, cus = 0, per_cu = 0;
        if (hipGetDevice(&dev) != hipSuccess || hipDeviceGetAttribute(&cus, hipDeviceAttributeMultiprocessorCount, dev) != hipSuccess) { grid = -1; return; }
        if (hipFuncSetAttribute((const void*)mk_fwd, hipFuncAttributeMaxDynamicSharedMemorySize, LDS_BYTES) != hipSuccess) { fprintf(stderr, "kernel_launch: hipFuncSetAttribute failed\n"); grid = -1; return; }
        if (hipOccupancyMaxActiveBlocksPerMultiprocessor(&per_cu, (const void*)mk_fwd, NTHR, LDS_BYTES) != hipSuccess || per_cu < 1) fprintf(stderr, "kernel_launch: occupancy query says %d\n", per_cu);
        (void)hipGetLastError();
        grid = cus;
    }
    if (grid < 0) return;
    (void)hipMemsetAsync((char*)d_ws + WS_CTL, 0, CTL_ZERO_BYTES, stream);
    Args a{};
    for (int i = 0; i < 41; ++i) a.in[i] = (const float*)d_in[i];
    a.out = (float*)d_out; a.ws = (unsigned char*)d_ws;
#if MK_ONE_LAUNCH
    a.ph_lo = 0; a.ph_hi = NPH;
    hipLaunchKernelGGL(mk_fwd, dim3(grid), dim3(NTHR), LDS_BYTES, stream, a);
#else
    for (int k = 0; k < NPH; ++k) { a.ph_lo = k; a.ph_hi = k + 1; hipLaunchKernelGGL(mk_fwd, dim3(grid), dim3(NTHR), LDS_BYTES, stream, a); }
#endif
}
```

```cpp
#include <hip/hip_runtime.h>
#include <cstdio>
#include <cstdint>

#ifndef MK_ONE_LAUNCH
#define MK_ONE_LAUNCH 1
#endif

#define GAS __attribute__((address_space(1)))
#define LAS __attribute__((address_space(3)))
typedef unsigned short bf16;
typedef short bf16x8 __attribute__((ext_vector_type(8)));
typedef float f32x4 __attribute__((ext_vector_type(4)));
typedef unsigned u32x4 __attribute__((ext_vector_type(4)));
typedef unsigned u32x2 __attribute__((ext_vector_type(2)));
typedef int i32x8 __attribute__((ext_vector_type(8)));
typedef int i32x4 __attribute__((ext_vector_type(4)));

constexpr int NB = 8, SEQ = 4096, D = 1024, MTOK = NB * SEQ, CH = 128, NCHUNK = SEQ / CH;
constexpr int EVEN_IN = 4096, OD_IN = 6176, OD_INP = 6400, OD_GN = 6144, MIXW = 2048;
constexpr int NE = 32, TOPK = 4, DFF = 1024, ECAP = MTOK;
constexpr float EPS = 1e-6f;
constexpr int NWAVES = 8, NTHR = 512;
constexpr int NPH = 20;

constexpr size_t MiB = 1u << 20;
constexpr size_t WS_CTL = 0, CTL_ZERO_BYTES = 128 * 1024;
constexpr size_t WS_MODP = 1 * MiB;
constexpr size_t WS_MODF = 7 * MiB;
constexpr size_t WS_LRUW = 8 * MiB;
constexpr size_t WS_GATEW = 8 * MiB + 512 * 1024;
constexpr size_t WS_ROUTW = 8 * MiB + 768 * 1024;
constexpr size_t WS_ROWTOK = 9 * MiB;
constexpr size_t WS_ROWGATE = 13 * MiB;
constexpr size_t WS_TOKSLOT = 17 * MiB;
constexpr size_t WS_LRU_AT = 18 * MiB, WS_LRU_HT = 19 * MiB, WS_LRU_CARRY = 20 * MiB;
constexpr size_t WS_ML_G = 21 * MiB, WS_ML_B = 22 * MiB;
constexpr size_t WS_ML_NLOC = 23 * MiB, WS_ML_NST = 24 * MiB;
constexpr size_t WS_ML_GT = 25 * MiB, WS_ML_ML = 25 * MiB + 65536, WS_ML_MS = 25 * MiB + 131072;
constexpr size_t WS_SSD_ALAST = 26 * MiB;
constexpr size_t WS_ARGTAB = 27 * MiB;
constexpr size_t WS_DUMMY = 27 * MiB + 65536;
constexpr size_t WS_WEVIN = 28 * MiB, WS_WEVOUT = 36 * MiB, WS_WODIN = 40 * MiB, WS_WODOUT = 53 * MiB;
constexpr size_t WS_WGU = 64 * MiB, WS_WDN = 320 * MiB;
constexpr size_t WS_U = 448 * MiB, WS_H1 = 512 * MiB, WS_H2 = 640 * MiB, WS_MIX = 768 * MiB;
constexpr size_t WS_PROJ = 896 * MiB, WS_ACT = WS_PROJ;
constexpr size_t WS_LRU_HL = 1152 * MiB, WS_LRU_PC = 1216 * MiB;
constexpr size_t WS_ST = 1296 * MiB;
constexpr size_t WS_CLOC = WS_ST, WS_CST = WS_ST + 128 * MiB;
constexpr size_t WS_SLOC = WS_ST, WS_SST = WS_ST + 256 * MiB;
constexpr size_t WS_YBUF = WS_ST;
constexpr size_t WS_XC = 1680 * MiB, WS_QG = 1744 * MiB, WS_KG = 1808 * MiB, WS_VG = 1872 * MiB;
constexpr size_t WS_XBC = 1680 * MiB;
constexpr size_t WS_DTG = 1936 * MiB, WS_ACG = 1940 * MiB;
constexpr size_t WS_END = 1944 * MiB;
constexpr int CW_BAR = 4096;
constexpr int CW_CNT = 16384;

constexpr int LDS_BYTES = 163840;
constexpr int L_MISC = LDS_BYTES - 256;
constexpr int L_SCHED = 135168;
constexpr int RLD = 272;
constexpr int L_RAW = 0, L_T0 = 35840, L_T1 = 70656, L_T2 = 105472, L_SM = 140288;
constexpr int L_TOK = 136192, L_EPI = 144384;
constexpr int L_DT = L_T2 + 17408, L_AC = L_DT + 16384;

typedef __bf16 bf16v2_t __attribute__((ext_vector_type(2)));
typedef float f32x2_t __attribute__((ext_vector_type(2)));
__device__ __forceinline__ unsigned pk2(float lo, float hi) { const f32x2_t f = {lo, hi}; return __builtin_bit_cast(unsigned, __builtin_convertvector(f, bf16v2_t)); }
__device__ __forceinline__ unsigned f2bf(float f) { return (unsigned)__builtin_bit_cast(unsigned short, (__bf16)f); }
__device__ __forceinline__ float bf2f(unsigned h) { return __builtin_bit_cast(float, h << 16); }
__device__ __forceinline__ float frcp(float x) { return __builtin_amdgcn_rcpf(x); }
__device__ __forceinline__ float sigmoidf_(float x) { return frcp(1.0f + __expf(-x)); }
__device__ __forceinline__ float siluf_(float x) { return x * frcp(1.0f + __expf(-x)); }
__device__ __forceinline__ float softplusf_(float x) { return x > 20.0f ? x : log1pf(__expf(x)); }
__device__ __forceinline__ float logsigmoidf_(float x) { return fminf(x, 0.0f) - log1pf(__expf(-fabsf(x))); }
__device__ __forceinline__ float gelu_tanh(float x) { const float y = 0.7978845608028654f * (x + 0.044715f * x * x * x); const float t = 1.0f - 2.0f * frcp(__expf(2.0f * y) + 1.0f); return 0.5f * x * (1.0f + t); }
__device__ __forceinline__ unsigned pk4_fp8(float a, float b, float c, float d) { int p = __builtin_amdgcn_cvt_pk_fp8_f32(a, b, 0, false); p = __builtin_amdgcn_cvt_pk_fp8_f32(c, d, p, true); return (unsigned)p; }
#define MFMA16(a, b, c) __builtin_amdgcn_mfma_f32_16x16x32_bf16((a), (b), (c), 0, 0, 0)
#define LFRAG(base, row, kel) (*(const LAS bf16x8*)((base) + (row) * RLD + (kel) * 2))
#define XLO(q_) (((q_) >> 4) * 256 + ((((q_) & 15) ^ (((q_) >> 4) & 15)) << 4))
#define XFRAG(base, row, ch) (*(const LAS bf16x8*)((base) + (row) * 256 + ((((ch)) ^ ((row) & 15)) << 4)))
__device__ __forceinline__ float wave_sum(float v) {
#pragma unroll
    for (int o = 1; o < 64; o <<= 1) v += __shfl_xor(v, o);
    return v;
}
__device__ __forceinline__ float red16(float v) { v += __shfl_xor(v, 1); v += __shfl_xor(v, 2); v += __shfl_xor(v, 4); v += __shfl_xor(v, 8); return v; }

#define XB_TMO      128
#define XB_XCNT(j)  (256  + 64 * (j))
#define XB_XSUB(j)  (1280 + 64 * (j))
#define XB_XGEN(j)  (2304 + 64 * (j))
#define XB_TOP      3328
#define XB_TOPGEN   3392
#define XCD_BAR_WORDS 3456
#define XB_SPIN_CAP (1u << 18)
__device__ __forceinline__ unsigned xb_ld(unsigned* p)              { return __hip_atomic_load(p, __ATOMIC_RELAXED, __HIP_MEMORY_SCOPE_AGENT); }
__device__ __forceinline__ unsigned xb_add(unsigned* p, unsigned v) { return __hip_atomic_fetch_add(p, v, __ATOMIC_RELAXED, __HIP_MEMORY_SCOPE_AGENT); }
__device__ __forceinline__ unsigned xb_xcc_id() { return (unsigned)__builtin_amdgcn_s_getreg((3 << 11) | 20) & 0xFu; }
#define XB_SPIN(cond, bar) do { unsigned _sp = 0; while (cond) { __builtin_amdgcn_s_sleep(1); \
    if ((++_sp & 255u) == 0u) { if (xb_ld(&(bar)[XB_TMO])) break; if (_sp > XB_SPIN_CAP) { atomicAdd(&(bar)[XB_TMO], 1u); break; } } } } while (0)
struct XcdBarrier { unsigned* bar; unsigned x; volatile LAS unsigned* st; };
__device__ __forceinline__ XcdBarrier xcd_barrier_post(unsigned* bar, volatile LAS unsigned* st) {
    XcdBarrier b; b.bar = bar; b.x = xb_xcc_id(); b.st = st;
    if (threadIdx.x == 0) (void)xb_add(&bar[XB_XCNT(b.x)], 1u);
    return b;
}
__device__ __forceinline__ void xcd_barrier_complete(unsigned* bar, unsigned x, unsigned& nloc, unsigned& nx) {
    const unsigned G = gridDim.x * gridDim.y * gridDim.z;
    unsigned sum, cnt, mine, sp = 0u;
    for (;;) {
        sum = 0u; cnt = 0u; mine = 0u;
#pragma unroll
        for (unsigned j = 0; j < 16; ++j) { const unsigned c = xb_ld(&bar[XB_XCNT(j)]); sum += c; cnt += (c > 0u) ? 1u : 0u; mine = (j == x) ? c : mine; }
        if (sum == G) break;
        __builtin_amdgcn_s_sleep(1);
        if ((++sp & 255u) == 0u) { if (xb_ld(&bar[XB_TMO])) break; if (sp > XB_SPIN_CAP) { atomicAdd(&bar[XB_TMO], 1u); break; } }
    }
    nloc = mine > 0u ? mine : 1u; nx = cnt > 0u ? cnt : 1u;
}
__device__ __forceinline__ void xcd_barrier(const XcdBarrier& b) {
    asm volatile("s_waitcnt vmcnt(0)" ::: "memory");
    __syncthreads();
    if (threadIdx.x == 0) {
        unsigned* bar = b.bar;
        __builtin_amdgcn_s_waitcnt(0);
        unsigned nloc = b.st[0], nx = b.st[1];
        if (nloc == 0u) { xcd_barrier_complete(bar, b.x, nloc, nx); b.st[0] = nloc; b.st[1] = nx; }
        const unsigned old = xb_add(&bar[XB_XSUB(b.x)], 1u);
        const unsigned gen = old / nloc;
        if (old + 1u == (gen + 1u) * nloc) {
            __builtin_amdgcn_fence(__ATOMIC_RELEASE, "agent");
            asm volatile("s_waitcnt vmcnt(0)" ::: "memory");
            const unsigned og = xb_add(&bar[XB_TOP], 1u);
            const unsigned tg = og / nx;
            if (og + 1u == (tg + 1u) * nx) xb_add(&bar[XB_TOPGEN], 1u);
            else XB_SPIN(xb_ld(&bar[XB_TOPGEN]) == tg, bar);
            __builtin_amdgcn_fence(__ATOMIC_ACQUIRE, "agent");
            xb_add(&bar[XB_XGEN(b.x)], 1u);
            asm volatile("s_waitcnt vmcnt(0)" ::: "memory");
        } else {
            XB_SPIN(xb_ld(&bar[XB_XGEN(b.x)]) == gen, bar);
            __builtin_amdgcn_fence(__ATOMIC_ACQUIRE, "agent");
            asm volatile("s_waitcnt vmcnt(0)" ::: "memory");
        }
    }
    __syncthreads();
}

struct Args { const float* in[41]; float* out; unsigned char* ws; int ph_lo, ph_hi; };
struct InTab { const float* const* p; __device__ __forceinline__ const GAS float* operator[](int k) const { return (const GAS float*)p[k]; } };
__device__ __forceinline__ const GAS float* uptr(const GAS float* p) { const unsigned long long v = (unsigned long long)p; const unsigned lo = __builtin_amdgcn_readfirstlane((unsigned)v), hi = __builtin_amdgcn_readfirstlane((unsigned)(v >> 32)); return (const GAS float*)(((unsigned long long)hi << 32) | lo); }
struct PArgs { InTab in; };
struct Frame { LAS unsigned char* lds; int tid, lane, wave, G, bid; unsigned char* ws; unsigned* ctl; };
__device__ __forceinline__ Frame relaunder(const Frame& F0) { Frame F = F0; int tz = F0.tid; asm volatile("" : "+v"(tz)); F.tid = tz; F.lane = tz & 63; F.wave = __builtin_amdgcn_readfirstlane(tz >> 6); return F; }
extern __shared__ __attribute__((aligned(16))) unsigned char lds_nl[];
__device__ __forceinline__ Frame make_frame(unsigned char* ws) { Frame F; F.lds = (LAS unsigned char*)lds_nl; F.tid = threadIdx.x; F.lane = F.tid & 63; F.wave = __builtin_amdgcn_readfirstlane(F.tid >> 6); F.G = gridDim.x; F.bid = blockIdx.x; F.ws = ws; F.ctl = (unsigned*)(ws + WS_CTL); return F; }

namespace pg8 {
constexpr int BM = 256, BK = 64, HALF = 128, HTB = HALF * BK * 2, STAGE_BYTES = 8 * HTB, NXCD = 8, WGM = 8;
__host__ __device__ __forceinline__ int lds_xr(int r) { return ((r >> 1) & 1) ^ (((r >> 2) & 1) << 2) ^ (((r >> 3) & 1) * 6); }
__host__ __device__ __forceinline__ int lds_byte(int r, int c) { const int ch = c >> 3; return (r >> 3) * 1024 + (r & 7) * 128 + ((ch ^ lds_xr(r)) << 4) + (c & 7) * 2; }
__host__ __device__ __forceinline__ void stage_rc(int b, int& R, int& C) { const int piece = b >> 10, rip = (b >> 7) & 7, slot = (b >> 4) & 7; R = piece * 8 + rip; C = ((slot ^ lds_xr(R)) << 3); }
__host__ __device__ __forceinline__ int perm32(int rho) { const int n = rho >> 4, i = rho & 15; return 8 * (i >> 2) + 4 * n + (i & 3); }
__device__ __forceinline__ unsigned cvt_pk_bf16(float lo, float hi) { return pk2(lo, hi); }

struct Unit { int pm, pn, e, valid, rowbase; };

struct PlainSched {
    static constexpr bool GATHER = false;
    const bf16* A; const bf16* Bt; int PB, nM, nN, nwg, G, c;
    __device__ void init(const void* A_, const void* Bt_, int M, int N, int K_, int G_, int c_, int elem_bytes = 2) { A = (const bf16*)A_; Bt = (const bf16*)Bt_; PB = elem_bytes * K_; nM = M / BM; nN = N / BM; nwg = nM * nN; G = G_; c = c_; }
    __device__ __forceinline__ bool next(int i, Unit& u) const {
        const long L = (long)i * G + c; if (L >= nwg) return false;
        int wgid = (int)L; { const int q = nwg / NXCD, r = nwg % NXCD, xcd = wgid % NXCD, off = wgid / NXCD; wgid = (xcd < r ? xcd * (q + 1) : r * (q + 1) + (xcd - r) * q) + off; }
        const int nig = WGM * nN, gid = wgid / nig, fm = gid * WGM, gsz = (nM - fm) < WGM ? (nM - fm) : WGM;
        u.pm = fm + ((wgid % nig) % gsz); u.pn = (wgid % nig) / gsz; u.e = 0; u.valid = 256; u.rowbase = u.pm * 256; return true;
    }
    __device__ __forceinline__ const char* abase(const Unit& u) const { return (const char*)A + (size_t)u.pm * 256 * PB; }
    __device__ __forceinline__ const char* bbase(const Unit& u) const { return (const char*)Bt + (size_t)u.pn * 256 * PB; }
};
template <bool GATHER_, int NT_  , int MB_  >
struct MoeSched {
    static constexpr bool GATHER = GATHER_;
    const void* A; const void* Bt; const int* rowtok; int PB, G, c, ntiles; const LAS int* tab; size_t bstride;
    __device__ __forceinline__ bool next(int i, Unit& u) const {
        int blk, j;
        if (G == 256) { blk = i * 8 + (c & 7); j = c >> 3; } else { const long U = (long)i * G + c; blk = (int)(U >> 5); j = (int)(U & 31); }
        const int nblk = (ntiles + MB_ - 1) / MB_;
        if (blk >= nblk) return false;
        const int mtg = blk * MB_ + (j % MB_); u.pn = j / MB_;
        if (mtg >= ntiles) { u.e = -1; u.pm = 0; u.valid = 0; u.rowbase = 0; return true; }
        const int lane31 = (int)__builtin_amdgcn_mbcnt_lo(~0u, 0u) & 31;
        const unsigned mle = (unsigned)__ballot(tab[65 + lane31] <= mtg);
        const int e = 31 - __builtin_clz(mle);
        u.e = e; u.pm = mtg - __builtin_amdgcn_readfirstlane(tab[65 + e]);
        const int cnt = __builtin_amdgcn_readfirstlane(tab[e]); const int v = cnt - u.pm * 256; u.valid = v < 256 ? v : 256; u.rowbase = __builtin_amdgcn_readfirstlane(tab[32 + e]) + u.pm * 256; return true;
    }
    __device__ __forceinline__ const char* abase(const Unit& u) const { return GATHER_ ? (const char*)A : (const char*)A + (size_t)u.rowbase * PB; }
    __device__ __forceinline__ const char* bbase(const Unit& u) const { return (const char*)Bt + ((size_t)u.e * bstride + (size_t)u.pn * 256) * PB; }
};

struct EpiBf16 {
    static constexpr bool PERM = true; static constexpr int BJSTEP = 128; static constexpr int NSTORES = 16;
    bf16* O; int ldc; float scale;
    __device__ __forceinline__ void prefetch(LAS unsigned char*, const Unit&, int, int) const {}
    __device__ __forceinline__ void operator()(const f32x4 (&acc)[2][2][4][2], const Unit& u, int wr, int wc, int fr, int fq, const LAS unsigned char*) const {
        const int row0 = u.pm * BM + wr * 64 + fr, col0 = u.pn * BM + wc * 32 + 8 * fq;
#pragma unroll
        for (int ai = 0; ai < 2; ++ai)
#pragma unroll
            for (int m = 0; m < 4; ++m) { bf16* rowp = O + (size_t)(row0 + ai * HALF + m * 16) * ldc + col0;
#pragma unroll
                for (int bj = 0; bj < 2; ++bj) { const f32x4 v0 = acc[ai][bj][m][0] * scale, v1 = acc[ai][bj][m][1] * scale;
                    u32x4 w; w.x = cvt_pk_bf16(v0[0], v0[1]); w.y = cvt_pk_bf16(v0[2], v0[3]); w.z = cvt_pk_bf16(v1[0], v1[1]); w.w = cvt_pk_bf16(v1[2], v1[3]);
                    __builtin_nontemporal_store(w, (u32x4*)(rowp + bj * HALF)); } }
    }
};
template <bool HIN_F32>
struct EpiResid {
    static constexpr bool PERM = true; static constexpr int BJSTEP = 128; static constexpr int NSTORES = 16;
    const GAS void* hin; bf16* out; const float* gvec;
    __device__ __forceinline__ void prefetch(LAS unsigned char*, const Unit&, int, int) const {}
    __device__ __forceinline__ void operator()(const f32x4 (&acc)[2][2][4][2], const Unit& u, int wr, int wc, int fr, int fq, const LAS unsigned char*) const {
        const int row0 = u.pm * BM + wr * 64 + fr, col0 = u.pn * BM + wc * 32 + 8 * fq;
        const float* gb = gvec + (size_t)((u.pm * BM) / SEQ) * 6144 + col0;
        constexpr int NL = HIN_F32 ? 2 : 1, ROWS = HIN_F32 ? 2 : 4, NBT = 8 / ROWS, ESZ = HIN_F32 ? 4 : 2;
        u32x4 hb[2][ROWS][2][NL];
        const unsigned eoff = (unsigned)(row0 * D + col0);
        f32x4 gv[2][2];
#pragma unroll
        for (int bj = 0; bj < 2; ++bj)
#pragma unroll
            for (int n = 0; n < 2; ++n) gv[bj][n] = *(const f32x4*)(gb + bj * HALF + 4 * n);
#pragma unroll
        for (int bt = -1; bt < NBT; ++bt) {
            if (bt + 1 < NBT) {
#pragma unroll
                for (int r = 0; r < ROWS; ++r) { const int q = (bt + 1) * ROWS + r, ai = q >> 2, m = q & 3;
#pragma unroll
                    for (int bj = 0; bj < 2; ++bj)
#pragma unroll
                        for (int k = 0; k < NL; ++k) hb[(bt + 1) & 1][r][bj][k] = *(const GAS u32x4*)((const GAS unsigned char*)hin + (eoff + (unsigned)((ai * HALF + m * 16) * D + bj * HALF)) * ESZ + 16 * k); } }
            if (bt >= 0) {
#pragma unroll
                for (int r = 0; r < ROWS; ++r) { const int q = bt * ROWS + r, ai = q >> 2, m = q & 3;
#pragma unroll
                    for (int bj = 0; bj < 2; ++bj) { f32x4 h0, h1;
                        if (HIN_F32) { h0 = __builtin_bit_cast(f32x4, hb[bt & 1][r][bj][0]); h1 = __builtin_bit_cast(f32x4, hb[bt & 1][r][bj][NL - 1]); }
                        else { const u32x4 hw = hb[bt & 1][r][bj][0]; h0 = (f32x4){bf2f(hw.x & 0xffffu), bf2f(hw.x >> 16), bf2f(hw.y & 0xffffu), bf2f(hw.y >> 16)}; h1 = (f32x4){bf2f(hw.z & 0xffffu), bf2f(hw.z >> 16), bf2f(hw.w & 0xffffu), bf2f(hw.w >> 16)}; }
                        const f32x4 v0 = h0 + gv[bj][0] * acc[ai][bj][m][0], v1 = h1 + gv[bj][1] * acc[ai][bj][m][1];
                        u32x4 w; w.x = cvt_pk_bf16(v0[0], v0[1]); w.y = cvt_pk_bf16(v0[2], v0[3]); w.z = cvt_pk_bf16(v1[0], v1[1]); w.w = cvt_pk_bf16(v1[2], v1[3]);
                        *(u32x4*)((unsigned char*)out + (eoff + (unsigned)((ai * HALF + m * 16) * D + bj * HALF)) * 2u) = w; } } }
        }
    }
};
constexpr float WSCALE8 = 32.0f, WINV8 = 1.0f / 32.0f;
struct EpiSwiglu {
    static constexpr bool PERM = true; static constexpr int BJSTEP = 128; static constexpr int NSTORES = 8;
    unsigned char* act; const GAS float* bgu; unsigned char* sink;
    __device__ __forceinline__ void prefetch(LAS unsigned char* es, const Unit& u, int wid, int lane) const {
        if (wid == 0) { const GAS float* src = bgu + (size_t)u.e * 2048 + u.pn * 128 + (lane < 32 ? 4 * lane : 1024 + 4 * (lane - 32)); __builtin_amdgcn_global_load_lds((const unsigned*)src, (LAS unsigned*)es, 16, 0, 0); } }
    __device__ __forceinline__ void operator()(const f32x4 (&acc)[2][2][4][2], const Unit& u, int wr, int wc, int fr, int fq, const LAS unsigned char* es) const {
        const int cc = u.pn * 128 + wc * 32 + 8 * fq;
        const LAS float* bb = (const LAS float*)es + wc * 32 + 8 * fq;
        const f32x4 bg0 = *(const LAS f32x4*)(bb), bg1 = *(const LAS f32x4*)(bb + 4), bl0 = *(const LAS f32x4*)(bb + 128) + 1.0f, bl1 = *(const LAS f32x4*)(bb + 132) + 1.0f;
#pragma unroll
        for (int ai = 0; ai < 2; ++ai)
#pragma unroll
            for (int m = 0; m < 4; ++m) { const int r = ai * HALF + wr * 64 + m * 16 + fr;
                float o[8];
#pragma unroll
                for (int n = 0; n < 2; ++n)
#pragma unroll
                    for (int j = 0; j < 4; j += 2) { const f32x4 ag = acc[ai][0][m][n], al = acc[ai][1][m][n]; const f32x4 vbg = n ? bg1 : bg0, vbl = n ? bl1 : bl0;
                        f32x2_t g = (f32x2_t){ag[j], ag[j + 1]} * WINV8 + (f32x2_t){vbg[j], vbg[j + 1]}, li = (f32x2_t){al[j], al[j + 1]} * WINV8 + (f32x2_t){vbl[j], vbl[j + 1]};
                        g = (f32x2_t){fminf(g[0], 7.0f), fminf(g[1], 7.0f)}; li = (f32x2_t){fminf(fmaxf(li[0], -6.0f), 8.0f), fminf(fmaxf(li[1], -6.0f), 8.0f)};
                        const f32x2_t t = g * (-1.702f * 1.4426950408889634f);
                        const f32x2_t d = (f32x2_t){__builtin_amdgcn_exp2f(t[0]), __builtin_amdgcn_exp2f(t[1])} + 1.0f;
                        const f32x2_t r = (f32x2_t){__builtin_amdgcn_rcpf(d[0]), __builtin_amdgcn_rcpf(d[1])};
                        const f32x2_t oo = g * r * li; o[n * 4 + j] = oo[0]; o[n * 4 + j + 1] = oo[1]; }
                u32x2 w; w.x = pk4_fp8(o[0], o[1], o[2], o[3]); w.y = pk4_fp8(o[4], o[5], o[6], o[7]);
                unsigned char* dst = (r < u.valid) ? act + (size_t)(u.rowbase + r) * DFF + cc : sink;
                *(u32x2*)dst = w; }
    }
};
constexpr float YSCALE8 = 16.0f, YINV8 = 1.0f / 16.0f;
struct EpiDown {
    static constexpr bool PERM = true; static constexpr int BJSTEP = 8; static constexpr int NSTORES = 8;
    unsigned char* y; const GAS float* bdn; const float* rowgate; unsigned char* sink;
    __device__ __forceinline__ void prefetch(LAS unsigned char* es, const Unit& u, int wid, int lane) const {
        if (wid == 0) __builtin_amdgcn_global_load_lds((const unsigned*)(bdn + (size_t)u.e * D + u.pn * BM + 4 * lane), (LAS unsigned*)es, 16, 0, 0);
        if (wid == 1) __builtin_amdgcn_global_load_lds((const unsigned*)(rowgate + (size_t)u.e * ECAP + u.pm * 256 + 4 * lane), (LAS unsigned*)(es + 1024), 16, 0, 0); }
    __device__ __forceinline__ void operator()(const f32x4 (&acc)[2][2][4][2], const Unit& u, int wr, int wc, int fr, int fq, const LAS unsigned char* es) const {
        const int col0 = u.pn * BM + wc * 64 + fq * 16;
        const LAS float* bb = (const LAS float*)es + wc * 64 + fq * 16;
        f32x4 bv[2][2];
#pragma unroll
        for (int bj = 0; bj < 2; ++bj)
#pragma unroll
            for (int n = 0; n < 2; ++n) bv[bj][n] = *(const LAS f32x4*)(bb + 8 * bj + 4 * n);
        const LAS float* gp = (const LAS float*)(es + 1024) + wr * 64 + fr;
        float gts[2][4];
#pragma unroll
        for (int ai = 0; ai < 2; ++ai)
#pragma unroll
            for (int m = 0; m < 4; ++m) gts[ai][m] = gp[ai * HALF + m * 16];
#pragma unroll
        for (int ai = 0; ai < 2; ++ai)
#pragma unroll
            for (int m = 0; m < 4; ++m) { const int r = ai * HALF + wr * 64 + m * 16 + fr; const float gt = gts[ai][m] * YSCALE8; unsigned char* rowp = y + (size_t)(u.rowbase + r) * D + col0;
                u32x4 w;
                { const f32x4 v = (acc[ai][0][m][0] * WINV8 + bv[0][0]) * gt; w.x = pk4_fp8(v[0], v[1], v[2], v[3]); }
                { const f32x4 v = (acc[ai][0][m][1] * WINV8 + bv[0][1]) * gt; w.y = pk4_fp8(v[0], v[1], v[2], v[3]); }
                { const f32x4 v = (acc[ai][1][m][0] * WINV8 + bv[1][0]) * gt; w.z = pk4_fp8(v[0], v[1], v[2], v[3]); }
                { const f32x4 v = (acc[ai][1][m][1] * WINV8 + bv[1][1]) * gt; w.w = pk4_fp8(v[0], v[1], v[2], v[3]); }
                *(u32x4*)((r < u.valid) ? rowp : sink) = w; }
    }
};

template <class Epi, class Sched, bool FP8 = false>
__device__ __forceinline__ void gemm_phase(LAS unsigned char* lds, const Sched& S, const Epi& E) {
    const int tid = threadIdx.x, wid = __builtin_amdgcn_readfirstlane(tid >> 6), lane = tid & 63, wr = wid >> 2, wc = wid & 3, fr = lane & 15, fq = lane >> 4;
    const int PB = S.PB, nt = PB / 128;
    unsigned voffB[2], voffA0[2];
#pragma unroll
    for (int i = 0; i < 2; ++i) { int R, C; stage_rc(tid * 16 + i * 8192, R, C); const int Rb = (Epi::BJSTEP == 8) ? (64 * (R >> 5) + 16 * ((R >> 2) & 3) + 4 * ((R >> 4) & 1) + (R & 3)) : (Epi::PERM ? ((R & ~31) + perm32(R & 31)) : R);
        voffA0[i] = (unsigned)(R * PB + 2 * C); voffB[i] = (unsigned)(Rb * PB + 2 * C); }
    const size_t kstep = (size_t)(BK * 2);
    const size_t hstep = (size_t)HALF * PB;
    const size_t bhstep = (size_t)Epi::BJSTEP * PB;
    const unsigned ldsw = (unsigned)wid * 1024u;
    const int aoff0 = FP8 ? lds_byte(wr * 64 + fr, 16 * fq) : lds_byte(wr * 64 + fr, fq * 8), boff0 = FP8 ? lds_byte(wc * 32 + fr, 16 * fq) : lds_byte(wc * 32 + fr, fq * 8);
    const int aoff1 = FP8 ? lds_byte(wr * 64 + fr, 16 * fq + 8) : lds_byte(wr * 64 + fr, fq * 8 + 32), boff1 = FP8 ? lds_byte(wc * 32 + fr, 16 * fq + 8) : lds_byte(wc * 32 + fr, fq * 8 + 32);
#define PG8_SA(b, h) (((b) * 2 + (h)) * HTB)
#define PG8_SB(b, h) ((4 + (b) * 2 + (h)) * HTB)
#define PG8_STAGE(bufoff, gbase, voff) do { _Pragma("unroll") for (int _i = 0; _i < 2; ++_i) \
        __builtin_amdgcn_global_load_lds((const unsigned*)((const char*)(gbase) + (voff)[_i]), (LAS unsigned*)(lds + (bufoff) + ldsw + _i * 8192), 16, 0, 0); } while (0)
#define PG8_LDA(dst, b, h) do { _Pragma("unroll") for (int m = 0; m < 4; ++m) { const i32x4 _l0 = *(const LAS i32x4*)(lds + PG8_SA(b, h) + aoff0 + m * 2048), _l1 = *(const LAS i32x4*)(lds + PG8_SA(b, h) + aoff1 + m * 2048); \
        dst[m] = __builtin_shufflevector(_l0, _l1, 0, 1, 2, 3, 4, 5, 6, 7); } } while (0)
#define PG8_LDB(dst, b, h) do { _Pragma("unroll") for (int n = 0; n < 2; ++n) { const i32x4 _l0 = *(const LAS i32x4*)(lds + PG8_SB(b, h) + boff0 + n * 2048), _l1 = *(const LAS i32x4*)(lds + PG8_SB(b, h) + boff1 + n * 2048); \
        dst[n] = __builtin_shufflevector(_l0, _l1, 0, 1, 2, 3, 4, 5, 6, 7); } } while (0)
#define PG8_MMA(ai, bj, At, Bt) do { __builtin_amdgcn_s_setprio(1); _Pragma("unroll") for (int m = 0; m < 4; ++m) _Pragma("unroll") for (int n = 0; n < 2; ++n) { \
        if constexpr (FP8) { asm volatile("v_mfma_scale_f32_16x16x128_f8f6f4 %0, %1, %2, %0, %3, %3 op_sel_hi:[0,0,0]" : "+v"(acc[ai][bj][m][n]) : "v"(Bt[n]), "v"(At[m]), "v"(scl8)); } \
        else { asm volatile("v_mfma_f32_16x16x32_bf16 %0, %1, %2, %0" : "+v"(acc[ai][bj][m][n]) : "v"(__builtin_shufflevector(Bt[n], Bt[n], 0, 1, 2, 3)), "v"(__builtin_shufflevector(At[m], At[m], 0, 1, 2, 3))); } } \
        if constexpr (!FP8) { _Pragma("unroll") for (int m = 0; m < 4; ++m) _Pragma("unroll") for (int n = 0; n < 2; ++n) {     \
            asm volatile("v_mfma_f32_16x16x32_bf16 %0, %1, %2, %0" : "+v"(acc[ai][bj][m][n]) : "v"(__builtin_shufflevector(Bt[n], Bt[n], 4, 5, 6, 7)), "v"(__builtin_shufflevector(At[m], At[m], 4, 5, 6, 7))); } } \
        __builtin_amdgcn_s_setprio(0); } while (0)
#define PG8_WAIT_V(n) asm volatile("s_waitcnt vmcnt(" #n ")" ::: "memory")
#define PG8_WAIT_VN(n) asm volatile("s_waitcnt vmcnt(%0)" :: "n"(n) : "memory")
#define PG8_WAIT_L(n) asm volatile("s_waitcnt lgkmcnt(" #n ")" ::: "memory")
#define PG8_BAR __builtin_amdgcn_s_barrier()
#define PG8_SCHED __builtin_amdgcn_sched_barrier(0)
#define PG8_AOFFS(u, dst) do { if constexpr (Sched::GATHER) { int _tz = threadIdx.x; asm volatile("" : "+v"(_tz)); _Pragma("unroll") for (int _h = 0; _h < 2; ++_h) _Pragma("unroll") for (int _i = 0; _i < 2; ++_i) { \
            int _R, _C; stage_rc(_tz * 16 + _i * 8192, _R, _C); const int _r = _h * HALF + _R; const int _tk = S.rowtok[(size_t)(u).e * ECAP + (u).pm * 256 + (_r < (u).valid ? _r : (u).valid - 1)]; dst[_h][_i] = (unsigned)(_tk * PB + 2 * _C); } } \
        else { _Pragma("unroll") for (int _i = 0; _i < 2; ++_i) { dst[0][_i] = voffA0[_i]; dst[1][_i] = voffA0[_i] + (unsigned)hstep; } } } while (0)
    Unit cur, nxt; int ui = 0;
    for (;;) { if (!S.next(ui, cur)) return; if (cur.e >= 0) break; ++ui; }
    f32x4 acc[2][2][4][2];
#pragma unroll
    for (int a = 0; a < 2; ++a)
#pragma unroll
        for (int b = 0; b < 2; ++b)
#pragma unroll
            for (int m = 0; m < 4; ++m)
#pragma unroll
                for (int n = 0; n < 2; ++n) { acc[a][b][m][n] = (f32x4){0.f, 0.f, 0.f, 0.f}; asm volatile("" : "+v"(acc[a][b][m][n])); }
    unsigned scl8 = 0x7f7f7f7fu; asm volatile("" : "+v"(scl8));
    i32x8 At[4], B0[2], B1[2];
    const char* cA = S.abase(cur); const char* cB = S.bbase(cur);
    unsigned cO[2][2];
    PG8_AOFFS(cur, cO);
    constexpr bool EARLY = true;
    static_assert(EARLY || !Sched::GATHER, "the gathered-A path assumes the peeled first trip");
    if constexpr (EARLY) {
        PG8_STAGE(PG8_SB(0, 0), cB, voffB); PG8_STAGE(PG8_SB(0, 1), cB + bhstep, voffB); PG8_STAGE(PG8_SA(0, 0), cA, cO[0]); PG8_STAGE(PG8_SA(0, 1), cA, cO[1]);
        PG8_STAGE(PG8_SB(1, 0), cB + kstep, voffB); PG8_STAGE(PG8_SB(1, 1), cB + bhstep + kstep, voffB); PG8_STAGE(PG8_SA(1, 0), cA + kstep, cO[0]); PG8_STAGE(PG8_SA(1, 1), cA + kstep, cO[1]);
        if (wr == 1) PG8_BAR;
        PG8_WAIT_V(0); PG8_BAR;
        PG8_WAIT_V(0); PG8_BAR;
    } else {
        PG8_STAGE(PG8_SB(0, 0), cB, voffB); PG8_STAGE(PG8_SB(0, 1), cB + bhstep, voffB); PG8_STAGE(PG8_SA(0, 0), cA, cO[0]); PG8_STAGE(PG8_SA(0, 1), cA, cO[1]);
        if (wr == 1) PG8_BAR;
        PG8_WAIT_V(2); PG8_BAR;
        PG8_STAGE(PG8_SB(1, 0), cB + kstep, voffB); PG8_STAGE(PG8_SA(1, 0), cA + kstep, cO[0]); PG8_STAGE(PG8_SB(1, 1), cB + bhstep + kstep, voffB);
        PG8_WAIT_V(6); PG8_BAR;
    }
    constexpr int WX = 8 + Epi::NSTORES + (Sched::GATHER ? 4 : 0);
    int eslot = 0;
    for (;;) {
        int uj = ui + 1; bool has_next;
        for (;;) { has_next = S.next(uj, nxt); if (!has_next || nxt.e >= 0) break; ++uj; }
        const char* nA = has_next ? S.abase(nxt) : cA; const char* nB = has_next ? S.bbase(nxt) : cB;
        unsigned nO[2][2];
#pragma unroll
        for (int h = 0; h < 2; ++h)
#pragma unroll
            for (int i = 0; i < 2; ++i) nO[h][i] = cO[h][i];
        { int _tp = threadIdx.x; asm volatile("" : "+v"(_tp)); E.prefetch(lds + L_EPI + eslot * 2048, cur, wid, _tp & 63); }
        if constexpr (Sched::GATHER) { int _tz = threadIdx.x; asm volatile("" : "+v"(_tz));
            const int te = has_next ? nxt.e : cur.e, tpm = has_next ? nxt.pm : cur.pm, tva = has_next ? nxt.valid : cur.valid;
#pragma unroll
            for (int _h = 0; _h < 2; ++_h)
#pragma unroll
                for (int _i = 0; _i < 2; ++_i) { int _R, _C; stage_rc(_tz * 16 + _i * 8192, _R, _C); const int _r = _h * HALF + _R;
                    __builtin_amdgcn_global_load_lds((const unsigned*)(S.rowtok + ((size_t)te * ECAP + tpm * 256 + (_r < tva ? _r : tva - 1))), (LAS unsigned*)(lds + L_TOK + (_h * 2 + _i) * 2048 + wid * 256), 4, 0, 0); } }
#define PG8_TRIP(t, last, W3, ST11) do { \
            const char* a1 = cA + (size_t)((t) + 1) * kstep; \
            const char* a2 = (last) ? nA : cA + (size_t)((t) + 2) * kstep; const char* b2 = (last) ? nB : cB + (size_t)((t) + 2) * kstep; \
            const char* a3 = a2 + kstep; const char* b3 = b2 + kstep; \
              \
            PG8_LDB(B0, 0, 0); PG8_LDB(B1, 0, 1); PG8_SCHED; PG8_LDA(At, 0, 0); if (ST11) PG8_STAGE(PG8_SA(1, 1), a1, cO[1]); \
            if (last) { _Pragma("unroll") for (int h = 0; h < 2; ++h) _Pragma("unroll") for (int i = 0; i < 2; ++i) cO[h][i] = nO[h][i]; }     \
            PG8_WAIT_VN(W3); PG8_WAIT_L(0); PG8_BAR; PG8_MMA(0, 0, At, B0); PG8_MMA(0, 1, At, B1); PG8_BAR; PG8_SCHED; \
              \
            PG8_LDA(At, 0, 1); PG8_STAGE(PG8_SB(0, 0), b2, voffB); PG8_STAGE(PG8_SB(0, 1), b2 + bhstep, voffB); PG8_STAGE(PG8_SA(0, 0), a2, cO[0]); \
            PG8_WAIT_VN(W3); PG8_WAIT_L(0); PG8_BAR; PG8_MMA(1, 0, At, B0); PG8_MMA(1, 1, At, B1); PG8_BAR; PG8_SCHED; \
              \
            PG8_LDB(B0, 1, 0); PG8_LDB(B1, 1, 1); PG8_SCHED; PG8_LDA(At, 1, 0); PG8_STAGE(PG8_SA(0, 1), a2, cO[1]); \
            PG8_WAIT_VN(W3); PG8_WAIT_L(0); PG8_BAR; PG8_MMA(0, 0, At, B0); PG8_MMA(0, 1, At, B1); PG8_BAR; PG8_SCHED; \
              \
            PG8_LDA(At, 1, 1); PG8_STAGE(PG8_SB(1, 0), b3, voffB); PG8_STAGE(PG8_SB(1, 1), b3 + bhstep, voffB); PG8_STAGE(PG8_SA(1, 0), a3, cO[0]); \
            PG8_WAIT_V(8); PG8_WAIT_L(0); PG8_BAR; PG8_MMA(1, 0, At, B0); PG8_MMA(1, 1, At, B1); PG8_BAR; PG8_SCHED; } while (0)
        if constexpr (EARLY) {
            PG8_TRIP(0, false, WX, false);
            if constexpr (Sched::GATHER) { if (has_next) {
                int _tz = threadIdx.x; asm volatile("" : "+v"(_tz));
#pragma unroll
                for (int _h = 0; _h < 2; ++_h)
#pragma unroll
                    for (int _i = 0; _i < 2; ++_i) { int _R, _C; stage_rc(_tz * 16 + _i * 8192, _R, _C); const int _tk = *(const LAS int*)(lds + L_TOK + (_h * 2 + _i) * 2048 + (_tz >> 6) * 256 + (_tz & 63) * 4); nO[_h][_i] = (unsigned)(_tk * PB + 2 * _C); } } }
#pragma unroll 1
            for (int t = 2; t < nt; t += 2) { const bool last = (t == nt - 2); PG8_TRIP(t, last, 8, true); }
        } else {
#pragma unroll 1
            for (int t = 0; t < nt; t += 2) { const bool last = (t == nt - 2); PG8_TRIP(t, last, 8, true); }
        }
#undef PG8_TRIP
        if (wr == 0) PG8_BAR;
        if constexpr (EARLY) PG8_STAGE(PG8_SA(1, 1), nA + kstep, cO[1]);
        asm volatile("s_nop 15\n\ts_nop 15" ::: "memory");
        { int tz = threadIdx.x; asm volatile("" : "+v"(tz));
          const int wid2 = tz >> 6, lane2 = tz & 63; E(acc, cur, wid2 >> 2, wid2 & 3, lane2 & 15, lane2 >> 4, lds + L_EPI + eslot * 2048); }
        eslot ^= 1;
        if (!has_next) break;
#pragma unroll
        for (int a = 0; a < 2; ++a)
#pragma unroll
            for (int b = 0; b < 2; ++b)
#pragma unroll
                for (int m = 0; m < 4; ++m)
#pragma unroll
                    for (int n = 0; n < 2; ++n) { acc[a][b][m][n] = (f32x4){0.f, 0.f, 0.f, 0.f}; asm volatile("" : "+v"(acc[a][b][m][n])); }
        cur = nxt; cA = nA; cB = nB; ui = uj;
        if (wr == 1) PG8_BAR;
    }
    PG8_WAIT_V(0);
    PG8_BAR;
#undef PG8_SA
#undef PG8_SB
#undef PG8_STAGE
#undef PG8_LDA
#undef PG8_LDB
#undef PG8_MMA
#undef PG8_WAIT_V
#undef PG8_WAIT_VN
#undef PG8_WAIT_L
#undef PG8_BAR
#undef PG8_SCHED
#undef PG8_AOFFS
}
}

__device__ __forceinline__ void transpose_item(const float* W, int K, int N, bf16* WT, int dst_row0, LAS float* scr, int k0, int n0, int lane) {
#pragma unroll 8
    for (int i = 0; i < 32; ++i) { const int kk = 2 * i + (lane >> 5); scr[kk * 33 + (lane & 31)] = __builtin_nontemporal_load(W + (size_t)(k0 + kk) * N + n0 + (lane & 31)); }
    asm volatile("s_waitcnt lgkmcnt(0)" ::: "memory");
    const int c = lane & 7;
#pragma unroll
    for (int j = 0; j < 4; ++j) { const int n = (lane >> 3) + 8 * j; const LAS float* s = scr + (8 * c) * 33 + n;
        u32x4 o; o.x = pk2(s[0 * 33], s[1 * 33]); o.y = pk2(s[2 * 33], s[3 * 33]); o.z = pk2(s[4 * 33], s[5 * 33]); o.w = pk2(s[6 * 33], s[7 * 33]);
        *(u32x4*)(WT + (size_t)(dst_row0 + n) * K + k0 + 8 * c) = o; }
    asm volatile("s_waitcnt lgkmcnt(0)" ::: "memory");
}
__device__ __forceinline__ void transpose_item_fp8(const float* W, int K, int N, unsigned char* WT, int dst_row0, LAS float* scr, int k0, int n0, int lane) {
#pragma unroll 8
    for (int i = 0; i < 32; ++i) { const int kk = 2 * i + (lane >> 5); scr[kk * 33 + (lane & 31)] = __builtin_nontemporal_load(W + (size_t)(k0 + kk) * N + n0 + (lane & 31)) * pg8::WSCALE8; }
    asm volatile("s_waitcnt lgkmcnt(0)" ::: "memory");
    const int c = lane & 7;
#pragma unroll
    for (int j = 0; j < 4; ++j) { const int n = (lane >> 3) + 8 * j; const LAS float* s = scr + (8 * c) * 33 + n;
        u32x2 o; o.x = pk4_fp8(s[0 * 33], s[1 * 33], s[2 * 33], s[3 * 33]); o.y = pk4_fp8(s[4 * 33], s[5 * 33], s[6 * 33], s[7 * 33]);
        *(u32x2*)(WT + (size_t)(dst_row0 + n) * K + k0 + 8 * c) = o; }
    asm volatile("s_waitcnt lgkmcnt(0)" ::: "memory");
}
__device__ __forceinline__ void ph_prep(const Args& a, Frame& F) {
    if (F.bid == 0 && F.tid == 0) { const float** tab = (const float**)(F.ws + WS_ARGTAB);
#pragma unroll
        for (int i = 0; i < 41; ++i) tab[i] = a.in[i];
        tab[41] = a.out; }
    LAS float* scr = (LAS float*)(F.lds + F.wave * 16384);
    const int gw = F.bid * NWAVES + F.wave, NGW = F.G * NWAVES, lane = F.lane;
    unsigned char* ws = F.ws;
    {
        const float* cin = a.in[1]; const float* mw = a.in[2]; float* modp = (float*)(ws + WS_MODP);
        for (int it = gw; it < 2 * 96 * 16; it += NGW) {
            const int l = it / 1536, rem = it % 1536, cb = rem / 16, ks = rem % 16, col = cb * 64 + lane;
#pragma unroll
            for (int b = 0; b < 8; ++b) { const float cv = cin[b * D + ks * 64 + lane]; scr[b * 64 + lane] = siluf_(cv); }
            asm volatile("s_waitcnt lgkmcnt(0)" ::: "memory");
            float acc[8];
#pragma unroll
            for (int b = 0; b < 8; ++b) acc[b] = 0.f;
            const float* wp = mw + ((size_t)l * D + ks * 64) * 6144 + col;
#pragma unroll 8
            for (int k = 0; k < 64; ++k) { const float w = wp[(size_t)k * 6144];
#pragma unroll
                for (int b = 0; b < 8; ++b) acc[b] += scr[b * 64 + k] * w; }
#pragma unroll
            for (int b = 0; b < 8; ++b) modp[(size_t)((ks * 2 + l) * 8 + b) * 6144 + col] = acc[b];
            asm volatile("s_waitcnt lgkmcnt(0)" ::: "memory");
        }
    }
    {
        constexpr int I_EVIN = 16 * 128, I_EVOUT = 32 * 32, I_ODIN = 16 * 193, I_ODOUT = 32 * 32, I_GU = 64 * 1024, I_DN = 64 * 512, I_LRU = 16 * 8;
        constexpr int NIT = I_EVIN + I_EVOUT + I_ODIN + I_ODOUT + I_GU + I_DN + I_LRU;
        for (int it = gw; it < NIT; it += NGW) {
            int r = it;
            if (r < I_EVIN) { const int kb = r / 128, nb = r % 128; transpose_item(a.in[6], D, EVEN_IN, (bf16*)(ws + WS_WEVIN), 32 * nb, scr, 64 * kb, 32 * nb, lane); continue; } r -= I_EVIN;
            if (r < I_EVOUT) { const int kb = r / 32, nb = r % 32; transpose_item(a.in[25], MIXW, D, (bf16*)(ws + WS_WEVOUT), 32 * nb, scr, 64 * kb, 32 * nb, lane); continue; } r -= I_EVOUT;
            if (r < I_ODIN) { const int kb = r / 193, nb = r % 193; transpose_item_fp8(a.in[26], D, OD_IN, (unsigned char*)(ws + WS_WODIN), 32 * nb, scr, 64 * kb, 32 * nb, lane); continue; } r -= I_ODIN;
            if (r < I_ODOUT) { const int kb = r / 32, nb = r % 32; transpose_item(a.in[33], MIXW, D, (bf16*)(ws + WS_WODOUT), 32 * nb, scr, 64 * kb, 32 * nb, lane); continue; } r -= I_ODOUT;
            if (r < I_GU) { const int mat = r / 1024, rr = r % 1024, kb = rr / 64, nb = rr % 64, n0 = 32 * nb;
                const int drow = n0 < 1024 ? (n0 / 128) * 256 + (n0 % 128) : ((n0 - 1024) / 128) * 256 + 128 + ((n0 - 1024) % 128);
                transpose_item_fp8(a.in[36] + (size_t)mat * D * 2048, D, 2048, (unsigned char*)(ws + WS_WGU) + (size_t)mat * 2048 * D, drow, scr, 64 * kb, n0, lane); continue; } r -= I_GU;
            if (r < I_DN) { const int mat = r / 512, rr = r % 512, kb = rr / 32, nb = rr % 32;
                transpose_item_fp8(a.in[38] + (size_t)mat * DFF * D, DFF, D, (unsigned char*)(ws + WS_WDN) + (size_t)mat * D * DFF, 32 * nb, scr, 64 * kb, 32 * nb, lane); continue; } r -= I_DN;
            { const int mat = r / 8, rr = r % 8, kb = rr / 4, nb = rr % 4, which = mat / 8, h = mat % 8;
                transpose_item((which ? a.in[11] : a.in[9]) + (size_t)h * 128 * 128, 128, 128, (bf16*)(ws + WS_LRUW) + (size_t)(which * 8 + h) * 128 * 128, 32 * nb, scr, 64 * kb, 32 * nb, lane); }
        }
    }
    {
        const size_t gt = (size_t)F.bid * NTHR + F.tid, NT = (size_t)F.G * NTHR;
        u32x4* z = (u32x4*)((unsigned char*)(ws + WS_WODIN) + (size_t)OD_IN * D);
        for (size_t i = gt; i < (size_t)(OD_INP - OD_IN) * D / 16; i += NT) z[i] = (u32x4){0u, 0u, 0u, 0u};
        bf16* gwt = (bf16*)(ws + WS_GATEW);
        for (size_t i = gt; i < 16 * 1024; i += NT) { const int j = (int)(i / 1024), cch = (int)(i % 1024), n = cch >> 2, d = cch & 3, jj = j & 7; const float* Wg = (j < 8 ? a.in[19] : a.in[21]);
            float sc = 0.f, sb = 0.f;
#pragma unroll
            for (int e = 0; e < 4; ++e) { sc += a.in[16][(n * 4 + d) * 4 + e] * Wg[(size_t)(4 * n + e) * 8 + jj] + a.in[17][(n * 4 + d) * 4 + e] * Wg[(size_t)(1024 + 4 * n + e) * 8 + jj];
                sb += a.in[18][(n * 4 + d) * 4 + e] * Wg[(size_t)(2048 + 4 * n + e) * 8 + jj]; }
            gwt[i] = (bf16)f2bf(sc); gwt[16 * 1024 + i] = (bf16)f2bf(sb); }
        bf16* rw = (bf16*)(ws + WS_ROUTW);
        for (size_t i = gt; i < 2 * 32 * 1024; i += NT) { const int l = (int)(i / 32768), e = (int)((i / 1024) % 32), k = (int)(i % 1024);
            const float v = a.in[34][((size_t)l * D + k) * 32 + e]; const unsigned hi = f2bf(v); const unsigned lo = f2bf(v - bf2f(hi));
            rw[((size_t)(l * 2 + 0) * 32 + e) * 1024 + k] = (bf16)hi; rw[((size_t)(l * 2 + 1) * 32 + e) * 1024 + k] = (bf16)lo; }
    }
}

template <int MODE>
__device__ __forceinline__ void ph_rows(const PArgs& a, Frame& F, int l  ) {
    unsigned char* ws = F.ws;
    LAS float* gm = (LAS float*)(F.lds); LAS float* ga = (LAS float*)(F.lds + 4096); LAS float* gf = (LAS float*)(F.lds + 8192); LAS int* offs = (LAS int*)(F.lds + 12288);
    const float* modp = (const float*)(ws + WS_MODP); float* modf = (float*)(ws + WS_MODF);
    if (MODE == 0) {
        for (size_t i = (size_t)F.bid * NTHR + F.tid; i < 2 * 8 * 6144; i += (size_t)F.G * NTHR) { const int l2 = (int)(i / 49152), b = (int)((i / 6144) % 8), n = (int)(i % 6144);
            float s = a.in[3][l2 * 6144 + n];
#pragma unroll
            for (int ks = 0; ks < 16; ++ks) s += modp[(size_t)((ks * 2 + l2) * 8 + b) * 6144 + n];
            modf[i] = s; }
    }
    if (MODE != 0) { if (F.tid == 0) { int o = 0; for (int e = 0; e < NE; ++e) { offs[e] = o; o += (int)F.ctl[CW_CNT + l * 2048 + e * 64]; } } }
    const GAS float* xin = uptr(a.in[0]); const GAS float* xout = uptr(a.in[41]);
    for (int tile = F.bid; tile < MTOK / 128; tile += F.G) {
        const int b = (tile * 128) / SEQ;
        __syncthreads();
        for (int k = F.tid; k < D; k += NTHR) {
            if (MODE == 0) { float sh = a.in[3][k], sc = a.in[3][1024 + k];
#pragma unroll
                for (int ks = 0; ks < 16; ++ks) { const float* p = modp + (size_t)((ks * 2 + 0) * 8 + b) * 6144; sh += p[k]; sc += p[1024 + k]; }
                gm[k] = a.in[4][k] * (1.0f + sc); ga[k] = sh; }
            else if (MODE == 1) { const float* mf = modf + (size_t)((l + 1) * 8 + b) * 6144; gm[k] = a.in[4][(l + 1) * D + k] * (1.0f + mf[1024 + k]); ga[k] = mf[k]; gf[k] = modf[(size_t)(l * 8 + b) * 6144 + 5120 + k]; }
            else { gm[k] = a.in[40][k]; ga[k] = 0.f; gf[k] = modf[(size_t)(l * 8 + b) * 6144 + 5120 + k]; }
        }
        __syncthreads();
        int slotv = 0;
        if (MODE != 0) slotv = ((const int*)(ws + WS_TOKSLOT))[(size_t)(tile * 128 + F.wave * 16) * 4 + F.lane];
#pragma unroll 1
        for (int i = 0; i < 16; i += 2) {
            f32x4 v[2][4]; unsigned yw[2][4][4];
#pragma unroll
            for (int rr = 0; rr < 2; ++rr) { const int row = tile * 128 + F.wave * 16 + i + rr;
#pragma unroll
                for (int j = 0; j < 4; ++j) { if (MODE == 0) v[rr][j] = *(const GAS f32x4*)((const GAS unsigned char*)xin + (unsigned)(row * D + 4 * F.lane) * 4u + 1024 * j);
                    else { const u32x2 hw = *(const u32x2*)(ws + WS_H1 + (unsigned)(row * D + 4 * F.lane) * 2u + 512 * j); v[rr][j] = (f32x4){bf2f(hw.x & 0xffffu), bf2f(hw.x >> 16), bf2f(hw.y & 0xffffu), bf2f(hw.y >> 16)}; } }
                if (MODE != 0) {
#pragma unroll
                    for (int kk = 0; kk < 4; ++kk) { const int sl = __shfl(slotv, 4 * (i + rr) + kk); const int e = sl >> 15, pos = sl & 32767; const unsigned yr = (unsigned)(offs[e] + pos);
                        const unsigned char* yp = ws + WS_YBUF + (yr * (unsigned)D + 4u * (unsigned)F.lane);
#pragma unroll
                        for (int j = 0; j < 4; ++j) yw[rr][kk][j] = *(const unsigned*)(yp + 256 * j); } } }
#pragma unroll
            for (int rr = 0; rr < 2; ++rr) { const int row = tile * 128 + F.wave * 16 + i + rr;
                if (MODE != 0) {
#pragma unroll
                    for (int j = 0; j < 4; ++j) { f32x2_t s01 = (f32x2_t){0.f, 0.f}, s23 = s01;
#pragma unroll
                        for (int kk = 0; kk < 4; ++kk) { const int w = (int)yw[rr][kk][j]; s01 += __builtin_amdgcn_cvt_pk_f32_fp8(w, false); s23 += __builtin_amdgcn_cvt_pk_f32_fp8(w, true); }
                        const f32x4 sm = (f32x4){s01[0], s01[1], s23[0], s23[1]};
                        const f32x4 g = *(const LAS f32x4*)(gf + 4 * F.lane + 256 * j); v[rr][j] = v[rr][j] + g * (sm * pg8::YINV8); }
                    if (MODE == 1) {
#pragma unroll
                        for (int j = 0; j < 4; ++j) { u32x2 hw; hw.x = pk2(v[rr][j][0], v[rr][j][1]); hw.y = pk2(v[rr][j][2], v[rr][j][3]); *(u32x2*)(ws + WS_H2 + (unsigned)(row * D + 4 * F.lane) * 2u + 512 * j) = hw; } }
                }
                float ss = 0.f;
#pragma unroll
                for (int j = 0; j < 4; ++j) ss += (v[rr][j][0] * v[rr][j][0] + v[rr][j][1] * v[rr][j][1]) + (v[rr][j][2] * v[rr][j][2] + v[rr][j][3] * v[rr][j][3]);
                const float rstd = __builtin_amdgcn_rsqf(wave_sum(ss) * (1.0f / D) + EPS);
#pragma unroll
                for (int j = 0; j < 4; ++j) { const f32x4 m = *(const LAS f32x4*)(gm + 4 * F.lane + 256 * j); const f32x4 ad = *(const LAS f32x4*)(ga + 4 * F.lane + 256 * j);
                    const f32x4 o = v[rr][j] * rstd * m + ad;
                    if (MODE == 2) __builtin_nontemporal_store(o, (GAS f32x4*)((GAS unsigned char*)xout + (unsigned)(row * D + 4 * F.lane) * 4u + 1024 * j));
                    else if (MODE == 1) *(unsigned*)(ws + WS_U + (unsigned)(row * D + 4 * F.lane) + 256 * j) = pk4_fp8(o[0], o[1], o[2], o[3]);
                    else { u32x2 w; w.x = pk2(o[0], o[1]); w.y = pk2(o[2], o[3]); *(u32x2*)(ws + WS_U + (unsigned)(row * D + 4 * F.lane) * 2u + 512 * j) = w; } } }
        }
    }
}

__device__ __forceinline__ void ph_route(const PArgs& a, Frame& F, int l) {
    unsigned char* ws = F.ws;
    LAS float* gm = (LAS float*)(F.lds); LAS float* ga = (LAS float*)(F.lds + 4096); LAS float* LG = (LAS float*)(F.lds + 8192);
    LAS int* lcnt = (LAS int*)(F.lds + 25600); LAS int* lbase = (LAS int*)(F.lds + 25728);
    const float* modf = (const float*)(ws + WS_MODF); const bf16* h1 = (const bf16*)(ws + WS_H1);
    const bf16* rw = (const bf16*)(ws + WS_ROUTW) + (size_t)l * 2 * 32 * 1024;
    const int r = F.lane & 15, kg = F.lane >> 4;
    for (int tile = F.bid; tile < MTOK / 128; tile += F.G) {
        const int b = (tile * 128) / SEQ;
        __syncthreads();
        for (int k = F.tid; k < D; k += NTHR) { const float* mf = modf + (size_t)(l * 8 + b) * 6144; gm[k] = a.in[5][l * D + k] * (1.0f + mf[4096 + k]); ga[k] = mf[3072 + k]; }
        if (F.tid < 32) lcnt[F.tid] = 0;
        __syncthreads();
        const int row = tile * 128 + F.wave * 16 + r;
        const bf16* hp = h1 + (size_t)row * D + 8 * kg;
        float ss = 0.f;
        u32x4 hwv[32];
#pragma unroll
        for (int s = 0; s < 32; ++s) hwv[s] = *(const u32x4*)(hp + 32 * s);
#pragma unroll
        for (int s = 0; s < 32; ++s) { const u32x4 hw = hwv[s];
            const f32x4 x0 = (f32x4){bf2f(hw.x & 0xffffu), bf2f(hw.x >> 16), bf2f(hw.y & 0xffffu), bf2f(hw.y >> 16)}, x1 = (f32x4){bf2f(hw.z & 0xffffu), bf2f(hw.z >> 16), bf2f(hw.w & 0xffffu), bf2f(hw.w >> 16)};
            ss += (x0[0] * x0[0] + x0[1] * x0[1]) + (x0[2] * x0[2] + x0[3] * x0[3]) + (x1[0] * x1[0] + x1[1] * x1[1]) + (x1[2] * x1[2] + x1[3] * x1[3]); }
        ss += __shfl_xor(ss, 16); ss += __shfl_xor(ss, 32);
        const float rstd = __builtin_amdgcn_rsqf(ss * (1.0f / D) + EPS);
        f32x4 acc[2]; acc[0] = (f32x4){0.f, 0.f, 0.f, 0.f}; acc[1] = acc[0];
        unsigned char* up = (unsigned char*)(ws + WS_U) + (size_t)row * D + 8 * kg;
#pragma unroll 4
        for (int s = 0; s < 32; ++s) {
            const u32x4 hw = *(const u32x4*)(hp + 32 * s);
            const f32x4 x0 = (f32x4){bf2f(hw.x & 0xffffu), bf2f(hw.x >> 16), bf2f(hw.y & 0xffffu), bf2f(hw.y >> 16)}, x1 = (f32x4){bf2f(hw.z & 0xffffu), bf2f(hw.z >> 16), bf2f(hw.w & 0xffffu), bf2f(hw.w >> 16)};
            const f32x4 m0 = *(const LAS f32x4*)(gm + 32 * s + 8 * kg), m1 = *(const LAS f32x4*)(gm + 32 * s + 8 * kg + 4);
            const f32x4 a0 = *(const LAS f32x4*)(ga + 32 * s + 8 * kg), a1 = *(const LAS f32x4*)(ga + 32 * s + 8 * kg + 4);
            const f32x4 u0 = x0 * rstd * m0 + a0, u1 = x1 * rstd * m1 + a1;
            bf16x8 ahi, alo;
#pragma unroll
            for (int j = 0; j < 4; ++j) { const unsigned h0 = f2bf(u0[j]), h1b = f2bf(u1[j]); ahi[j] = (short)h0; ahi[4 + j] = (short)h1b; alo[j] = (short)f2bf(u0[j] - bf2f(h0)); alo[4 + j] = (short)f2bf(u1[j] - bf2f(h1b)); }
            { u32x2 w8; w8.x = pk4_fp8(u0[0], u0[1], u0[2], u0[3]); w8.y = pk4_fp8(u1[0], u1[1], u1[2], u1[3]); *(u32x2*)(up + 32 * s) = w8; }
#pragma unroll
            for (int nt = 0; nt < 2; ++nt) { const bf16x8 bhi = *(const bf16x8*)(rw + (size_t)(16 * nt + r) * 1024 + 32 * s + 8 * kg); const bf16x8 blo = *(const bf16x8*)(rw + (size_t)(32 + 16 * nt + r) * 1024 + 32 * s + 8 * kg);
                acc[nt] = MFMA16(ahi, bhi, acc[nt]); acc[nt] = MFMA16(ahi, blo, acc[nt]); acc[nt] = MFMA16(alo, bhi, acc[nt]); }
        }
#pragma unroll
        for (int nt = 0; nt < 2; ++nt)
#pragma unroll
            for (int j = 0; j < 4; ++j) LG[(F.wave * 16 + 4 * kg + j) * 33 + 16 * nt + r] = acc[nt][j] + a.in[35][l * 32 + 16 * nt + r];
        __syncthreads();
        int pe[4]; float pg[4]; int prank[4];
        if (F.tid < 128) {
            float lv[32];
#pragma unroll
            for (int e = 0; e < 32; ++e) lv[e] = LG[F.tid * 33 + e];
#pragma unroll
            for (int k = 0; k < 4; ++k) { float best = -3.0e38f; int bi = 0;
#pragma unroll
                for (int e = 0; e < 32; ++e) { const bool tk = lv[e] > best; best = tk ? lv[e] : best; bi = tk ? e : bi; }
                pe[k] = bi; pg[k] = best;
#pragma unroll
                for (int e = 0; e < 32; ++e) lv[e] = (e == bi) ? -3.0e38f : lv[e]; }
            const float mx = pg[0]; float sm = 0.f;
#pragma unroll
            for (int k = 0; k < 4; ++k) { pg[k] = __expf(pg[k] - mx); sm += pg[k]; }
            const float inv = 1.0f / sm;
#pragma unroll
            for (int k = 0; k < 4; ++k) { pg[k] *= inv; prank[k] = __hip_atomic_fetch_add(&lcnt[pe[k]], 1, __ATOMIC_RELAXED, __HIP_MEMORY_SCOPE_WORKGROUP); }
        }
        __syncthreads();
        if (F.tid < 32) { const int c = lcnt[F.tid]; lbase[F.tid] = c ? (int)atomicAdd(&F.ctl[CW_CNT + l * 2048 + F.tid * 64], (unsigned)c) : 0; }
        __syncthreads();
        if (F.tid < 128) {
            const int trow = tile * 128 + F.tid;
#pragma unroll
            for (int k = 0; k < 4; ++k) { const int pos = lbase[pe[k]] + prank[k]; const size_t li = (size_t)pe[k] * ECAP + pos;
                ((int*)(ws + WS_ROWTOK))[li] = trow; ((float*)(ws + WS_ROWGATE))[li] = pg[k]; ((int*)(ws + WS_TOKSLOT))[(size_t)trow * 4 + k] = pe[k] * 32768 + pos; }
        }
    }
}

#define RAW_PF(pr, src, ld, grow0, tseq0, c0) do { _Pragma("unroll") for (int i_ = 0; i_ < 5; ++i_) { const int q0_ = F.tid + i_ * NTHR, q_ = q0_ < 131 * 16 ? q0_ : 131 * 16 - 1, r_ = q_ >> 4, cc_ = q_ & 15; \
        const int back_ = (tseq0) - 3 + r_ >= 0 ? 3 - r_ : (tseq0);     \
        const u32x4 v_ = *(const u32x4*)((const unsigned char*)(src) + (unsigned)(((grow0) - back_) * (ld) + (c0) + 8 * cc_) * 2u); pr[i_] = ((tseq0) - 3 + r_ >= 0) ? v_ : (u32x4){0u, 0u, 0u, 0u}; } } while (0)
#define RAW_PW(pr) do { _Pragma("unroll") for (int i_ = 0; i_ < 5; ++i_) { const int q_ = F.tid + i_ * NTHR, r_ = q_ >> 4, cc_ = q_ & 15; if (q_ < 131 * 16) *(LAS u32x4*)(F.lds + L_RAW + r_ * RLD + cc_ * 16) = pr[i_]; } } while (0)
template <int RLDB>
__device__ __forceinline__ void tr_frag4(unsigned a, bf16x8 (&out)[4]) {
    u32x2 r0, r1, r2, r3, r4, r5, r6, r7;
    asm volatile(
        "ds_read_b64_tr_b16 %0, %8 offset:%9\n\t"
        "ds_read_b64_tr_b16 %1, %8 offset:%10\n\t"
        "ds_read_b64_tr_b16 %2, %8 offset:%11\n\t"
        "ds_read_b64_tr_b16 %3, %8 offset:%12\n\t"
        "ds_read_b64_tr_b16 %4, %8 offset:%13\n\t"
        "ds_read_b64_tr_b16 %5, %8 offset:%14\n\t"
        "ds_read_b64_tr_b16 %6, %8 offset:%15\n\t"
        "ds_read_b64_tr_b16 %7, %8 offset:%16\n\t"
        "s_waitcnt lgkmcnt(0)"
        : "=&v"(r0), "=&v"(r1), "=&v"(r2), "=&v"(r3), "=&v"(r4), "=&v"(r5), "=&v"(r6), "=&v"(r7)
        : "v"(a), "i"(0), "i"(4 * RLDB), "i"(32 * RLDB), "i"(36 * RLDB), "i"(64 * RLDB), "i"(68 * RLDB), "i"(96 * RLDB), "i"(100 * RLDB)
        : "memory");
    out[0] = __builtin_bit_cast(bf16x8, (u32x4){r0.x, r0.y, r1.x, r1.y});
    out[1] = __builtin_bit_cast(bf16x8, (u32x4){r2.x, r2.y, r3.x, r3.y});
    out[2] = __builtin_bit_cast(bf16x8, (u32x4){r4.x, r4.y, r5.x, r5.y});
    out[3] = __builtin_bit_cast(bf16x8, (u32x4){r6.x, r6.y, r7.x, r7.y});
}
__device__ __forceinline__ unsigned tr_addr(const LAS unsigned char* tile, int n0, int lane) { return (unsigned)(size_t)tile + (unsigned)((8 * (lane >> 4) + ((lane & 15) >> 2)) * RLD + (n0 + 4 * (lane & 3)) * 2); }
__device__ __forceinline__ void copy_tile(Frame& F, const bf16* src, int ld, int dstoff) {
#pragma unroll
    for (int i = 0; i < 4; ++i) { const int q = F.tid + i * NTHR, r = q >> 4, cc = q & 15; *(LAS u32x4*)(F.lds + dstoff + r * RLD + cc * 16) = *(const u32x4*)(src + (size_t)r * ld + 8 * cc); }
}
__device__ __forceinline__ u32x4 scale8(u32x4 v, float s) { u32x4 o; o.x = pk2(bf2f(v.x & 0xffffu) * s, bf2f(v.x >> 16) * s); o.y = pk2(bf2f(v.y & 0xffffu) * s, bf2f(v.y >> 16) * s); o.z = pk2(bf2f(v.z & 0xffffu) * s, bf2f(v.z >> 16) * s); o.w = pk2(bf2f(v.w & 0xffffu) * s, bf2f(v.w >> 16) * s); return o; }
#define WSYNC() do { asm volatile("s_waitcnt vmcnt(0)" ::: "memory"); __syncthreads(); } while (0)
__device__ __forceinline__ u32x4 bd8(u32x4 x, const f32x4 (&w)[2][4], float s) {
    const float a0 = bf2f(x.x & 0xffffu), a1 = bf2f(x.x >> 16), a2 = bf2f(x.y & 0xffffu), a3 = bf2f(x.y >> 16), b0 = bf2f(x.z & 0xffffu), b1 = bf2f(x.z >> 16), b2 = bf2f(x.w & 0xffffu), b3 = bf2f(x.w >> 16);
    const f32x4 o0 = (w[0][0] * a0 + w[0][1] * a1 + w[0][2] * a2 + w[0][3] * a3) * s, o1 = (w[1][0] * b0 + w[1][1] * b1 + w[1][2] * b2 + w[1][3] * b3) * s;
    u32x4 o; o.x = pk2(o0[0], o0[1]); o.y = pk2(o0[2], o0[3]); o.z = pk2(o1[0], o1[1]); o.w = pk2(o1[2], o1[3]); return o; }
#define BD_W(dst, ptr, hh_, cc_) do { _Pragma("unroll") for (int g_ = 0; g_ < 2; ++g_) _Pragma("unroll") for (int j_ = 0; j_ < 4; ++j_) dst[g_][j_] = *(const GAS f32x4*)((ptr) + (32 * (hh_) + 2 * (cc_) + g_) * 16 + 4 * j_); } while (0)
constexpr float ML_KSCALE = 0.08838834764831845f;

constexpr int L_GT = L_SM, L_GC = L_SM + 8192, L_BC = L_GC + 4096, L_MV = L_BC + 4096, L_BM = L_MV + 4096, L_MP = L_BM + 32;
constexpr int L_WS = L_MP + 32;
__device__ __forceinline__ void ml_pre(const PArgs& a, Frame& F0, int b, int c) { Frame F = relaunder(F0);
    unsigned char* ws = F.ws; LAS unsigned char* lds = F.lds;
    const bf16* proj = (const bf16*)(ws + WS_PROJ);
    const int wid = F.wave, lane = F.lane, fr = lane & 15, fq = lane >> 4, row0 = b * SEQ + c * CH;
    const int n = F.tid & 31, tg = F.tid >> 5;
    LAS float* GT = (LAS float*)(lds + L_GT); LAS float* Gc = (LAS float*)(lds + L_GC); LAS float* Bc = (LAS float*)(lds + L_BC); LAS float* BM = (LAS float*)(lds + L_BM);
    const float kscale = 0.08838834764831845f;
    f32x4 gacc = (f32x4){0.f, 0.f, 0.f, 0.f};
    constexpr int GWLD = 2064;
    { u32x4 gw[8];
#pragma unroll
      for (int i = 0; i < 8; ++i) gw[i] = *(const u32x4*)(ws + WS_GATEW + (unsigned)((F.tid + i * NTHR) * 16));
#pragma unroll
      for (int i = 0; i < 8; ++i) { const int q = F.tid + i * NTHR; *(LAS u32x4*)(lds + L_T1 + (q >> 7) * GWLD + (q & 127) * 16) = gw[i]; } }
    const LAS unsigned char* gwl = lds + L_T1 + fr * GWLD + 16 * fq;
    u32x4 pr[5];
    RAW_PF(pr, proj, EVEN_IN, row0, c * CH, 2048);
    const GAS float* p14 = uptr(a.in[14]); const GAS float* p15 = uptr(a.in[15]); const GAS float* p16 = uptr(a.in[16]); const GAS float* p17 = uptr(a.in[17]); const GAS float* p18 = uptr(a.in[18]);
    for (int h = 0; h < 8; ++h) {
        const int gc = 128 * h + 4 * n;
        f32x4 cw[4];
        const f32x4 cb = *(const GAS f32x4*)(p15 + gc);
#pragma unroll
        for (int j = 0; j < 4; ++j) cw[j] = *(const GAS f32x4*)(p14 + (size_t)j * D + gc);
        RAW_PW(pr);
        __syncthreads();
        if (h < 7) RAW_PF(pr, proj, EVEN_IN, row0, c * CH, 2048 + 128 * (h + 1));
        float w0[4], w1[4], w2[4], w3[4];
        { const LAS unsigned char* rp = lds + L_RAW + (8 * tg) * RLD + 8 * n; u32x2 u;
          u = *(const LAS u32x2*)(rp); w0[0] = bf2f(u.x & 0xffffu); w0[1] = bf2f(u.x >> 16); w0[2] = bf2f(u.y & 0xffffu); w0[3] = bf2f(u.y >> 16);
          u = *(const LAS u32x2*)(rp + RLD); w1[0] = bf2f(u.x & 0xffffu); w1[1] = bf2f(u.x >> 16); w1[2] = bf2f(u.y & 0xffffu); w1[3] = bf2f(u.y >> 16);
          u = *(const LAS u32x2*)(rp + 2 * RLD); w2[0] = bf2f(u.x & 0xffffu); w2[1] = bf2f(u.x >> 16); w2[2] = bf2f(u.y & 0xffffu); w2[3] = bf2f(u.y >> 16); }
#pragma unroll
        for (int i = 0; i < 8; ++i) { const int t = 8 * tg + i;
            { const u32x2 u = *(const LAS u32x2*)(lds + L_RAW + (t + 3) * RLD + 8 * n); w3[0] = bf2f(u.x & 0xffffu); w3[1] = bf2f(u.x >> 16); w3[2] = bf2f(u.y & 0xffffu); w3[3] = bf2f(u.y >> 16); }
            float xc[4];
#pragma unroll
            for (int e = 0; e < 4; ++e) xc[e] = siluf_(cb[e] + cw[0][e] * w0[e] + cw[1][e] * w1[e] + cw[2][e] * w2[e] + cw[3][e] * w3[e]);
            u32x2 o; o.x = pk2(xc[0], xc[1]); o.y = pk2(xc[2], xc[3]);
            *(LAS u32x2*)(lds + L_T0 + t * RLD + 8 * n) = o;
            const unsigned go = (unsigned)((row0 + t) * D + gc) * 2u;
            *(u32x2*)(ws + WS_XC + go) = o;
#pragma unroll
            for (int e = 0; e < 4; ++e) { w0[e] = w1[e]; w1[e] = w2[e]; w2[e] = w3[e]; } }
        __syncthreads();
#pragma unroll
        for (int ks = 0; ks < 4; ++ks) { const bf16x8 A1 = LFRAG(lds + L_T0, 16 * wid + fr, 32 * ks + 8 * fq); const bf16x8 B1 = *(const LAS bf16x8*)(gwl + (128 * h + 32 * ks) * 2); gacc = MFMA16(A1, B1, gacc);
            const bf16x8 A2 = LFRAG(lds + L_RAW, 16 * wid + fr + 3, 32 * ks + 8 * fq); const bf16x8 B2 = *(const LAS bf16x8*)(gwl + 16 * GWLD + (128 * h + 32 * ks) * 2); gacc = MFMA16(A2, B2, gacc); }
        __syncthreads();
    }
    const float gbias = *(fr < 8 ? a.in[20] + fr : a.in[22] + (fr - 8));
#pragma unroll
    for (int j = 0; j < 4; ++j) { float v = gacc[j] + gbias; if (fr >= 8) v = logsigmoidf_(v); GT[(16 * wid + 4 * fq + j) * 16 + fr] = v; }
    __syncthreads();
    if (F.tid < 8) { const int h = F.tid; float g = 0.f, bmax = -3.0e38f;
        for (int t = 0; t < CH; ++t) { g += GT[t * 16 + 8 + h]; const float bb = GT[t * 16 + h] - g; Gc[t * 8 + h] = g; Bc[t * 8 + h] = bb; bmax = fmaxf(bmax, bb); }
        BM[h] = bmax; const int u = (b * 8 + h) * NCHUNK + c; ((float*)(ws + WS_ML_GT))[u] = g; ((float*)(ws + WS_ML_ML))[u] = g + bmax; }
    __syncthreads();
    for (int i = F.tid; i < CH * 8; i += NTHR) { ((float*)(ws + WS_ML_G))[(size_t)row0 * 8 + i] = Gc[i]; ((float*)(ws + WS_ML_B))[(size_t)row0 * 8 + i] = Bc[i]; }
}
__device__ __forceinline__ void ml_local2(const PArgs& a, Frame& F, int b, int c) {
    unsigned char* ws = F.ws; LAS unsigned char* lds = F.lds;
    const int wid = F.wave, lane = F.lane, fr = lane & 15, fq = lane >> 4, row0 = b * SEQ + c * CH;
    LAS float* Bc = (LAS float*)(lds + L_BC); LAS float* BM = (LAS float*)(lds + L_BM);
    WSYNC();
    u32x4 pk[4], pv[4];
#define KV_PF(hh) do { _Pragma("unroll") for (int i_ = 0; i_ < 4; ++i_) { const int q_ = F.tid + i_ * NTHR; pk[i_] = *(const u32x4*)(ws + WS_XC + (unsigned)((row0 + (q_ >> 4)) * D + 128 * (hh) + 8 * (q_ & 15)) * 2u); \
        pv[i_] = *(const u32x4*)(ws + WS_PROJ + (unsigned)((row0 + (q_ >> 4)) * EVEN_IN + 2048 + 128 * (hh) + 8 * (q_ & 15)) * 2u); } } while (0)
    KV_PF(0);
    const GAS float* p17 = a.in[17]; const GAS float* p18 = a.in[18];
    for (int h = 0; h < 8; ++h) {
        const float bm = BM[h];
        { f32x4 w2[2][4]; BD_W(w2, p17, h, F.tid & 15);
#pragma unroll
          for (int i = 0; i < 4; ++i) { const int q = F.tid + i * NTHR, r = q >> 4, cc = q & 15; const float sc = __expf(Bc[r * 8 + h] - bm);
              *(LAS u32x4*)(lds + L_T1 + r * RLD + cc * 16) = bd8(pk[i], w2, sc * ML_KSCALE); } }
        asm volatile("" ::: "memory");
        { f32x4 w2[2][4]; BD_W(w2, p18, h, F.tid & 15);
#pragma unroll
          for (int i = 0; i < 4; ++i) { const int q = F.tid + i * NTHR, r = q >> 4, cc = q & 15;
              *(LAS u32x4*)(lds + L_T2 + r * RLD + cc * 16) = bd8(pv[i], w2, 1.0f); } }
        __syncthreads();
        if (h < 7) KV_PF(h + 1);
        const int u = (b * 8 + h) * NCHUNK + c;
        bf16x8 Av[4]; tr_frag4<RLD>(tr_addr(lds + L_T2, 16 * wid, lane), Av);
        bf16* cl = (bf16*)(ws + WS_CLOC) + (size_t)u * 16384;
#pragma unroll
        for (int nt = 0; nt < 8; ++nt) { bf16x8 Bk[4]; tr_frag4<RLD>(tr_addr(lds + L_T1, 16 * nt, lane), Bk);
            f32x4 acc = (f32x4){0.f, 0.f, 0.f, 0.f};
#pragma unroll
            for (int ks = 0; ks < 4; ++ks) acc = MFMA16(Av[ks], Bk[ks], acc);
#pragma unroll
            for (int j = 0; j < 4; ++j) cl[(16 * wid + 4 * fq + j) * 128 + 16 * nt + fr] = (bf16)f2bf(acc[j]); }
        if (F.tid < 128) { float s0 = 0.f, s1 = 0.f;
#pragma unroll 8
            for (int t = 0; t < CH; t += 2) { s0 += bf2f(*(const LAS bf16*)(lds + L_T1 + t * RLD + F.tid * 2)); s1 += bf2f(*(const LAS bf16*)(lds + L_T1 + (t + 1) * RLD + F.tid * 2)); }
            ((float*)(ws + WS_ML_NLOC))[(size_t)u * 128 + F.tid] = s0 + s1; }
        __syncthreads();
    }
}

__device__ __forceinline__ void lru_fix(const PArgs& a, Frame& F0, int b, int c) { Frame F = relaunder(F0);
    unsigned char* ws = F.ws; const bf16* proj = (const bf16*)(ws + WS_PROJ);
    const int row0 = b * SEQ + c * CH, cc = F.tid & 127, tg = F.tid >> 7;
    const float* cp = (const float*)(ws + WS_LRU_CARRY) + (size_t)(b * NCHUNK + c) * D + 8 * cc;
    const f32x4 c0 = *(const f32x4*)cp, c1 = *(const f32x4*)(cp + 4);
#pragma unroll 1
    for (int t0 = 0; t0 < 32; t0 += 4) { u32x4 hw[4], pw[4], gw[4];
#pragma unroll
        for (int i = 0; i < 4; ++i) { const size_t r = (size_t)(row0 + 32 * tg + t0 + i); hw[i] = *(const u32x4*)((const bf16*)(ws + WS_LRU_HL) + r * D + 8 * cc); pw[i] = *(const u32x4*)((const bf16*)(ws + WS_LRU_PC) + r * D + 8 * cc); gw[i] = *(const u32x4*)(proj + r * EVEN_IN + 1024 + 8 * cc); }
#pragma unroll
        for (int i = 0; i < 4; ++i) { const size_t r = (size_t)(row0 + 32 * tg + t0 + i); float o[8];
#pragma unroll
            for (int e = 0; e < 8; ++e) { const unsigned hh = (e < 2) ? hw[i].x : (e < 4) ? hw[i].y : (e < 6) ? hw[i].z : hw[i].w, pq = (e < 2) ? pw[i].x : (e < 4) ? pw[i].y : (e < 6) ? pw[i].z : pw[i].w, gg = (e < 2) ? gw[i].x : (e < 4) ? gw[i].y : (e < 6) ? gw[i].z : gw[i].w;
                const float hl = bf2f((e & 1) ? (hh >> 16) : (hh & 0xffffu)), pc = bf2f((e & 1) ? (pq >> 16) : (pq & 0xffffu)), g = bf2f((e & 1) ? (gg >> 16) : (gg & 0xffffu));
                o[e] = (hl + pc * (e < 4 ? c0[e] : c1[e - 4])) * gelu_tanh(g); }
            u32x4 w; w.x = pk2(o[0], o[1]); w.y = pk2(o[2], o[3]); w.z = pk2(o[4], o[5]); w.w = pk2(o[6], o[7]);
            *(u32x4*)((bf16*)(ws + WS_MIX) + r * MIXW + 8 * cc) = w; } }
}
#undef KV_PF
__device__ __attribute__((noinline)) void ml_local2_nl(const GAS unsigned char* tab, GAS unsigned char* ws, int b, int c) { Frame F = make_frame((unsigned char*)ws); PArgs pa; pa.in.p = (const float* const*)tab; ml_local2(pa, F, b, c); }
__device__ __forceinline__ void ml_out2(const PArgs& a, Frame& F0, int b, int c) { Frame F = relaunder(F0);
    unsigned char* ws = F.ws; LAS unsigned char* lds = F.lds;
    const bf16* proj = (const bf16*)(ws + WS_PROJ); bf16* mix = (bf16*)(ws + WS_MIX);
    const int wid = F.wave, lane = F.lane, fr = lane & 15, fq = lane >> 4, row0 = b * SEQ + c * CH;
    LAS float* Gc = (LAS float*)(lds + L_GC); LAS float* Bc = (LAS float*)(lds + L_BC); LAS float* Mv = (LAS float*)(lds + L_MV); LAS float* MP = (LAS float*)(lds + L_MP);
    u32x4 tq[4];
    const GAS float* p16 = uptr(a.in[16]); const GAS float* p17 = uptr(a.in[17]); const GAS float* p18 = uptr(a.in[18]);
#define QKV_PF(hh) do { _Pragma("unroll") for (int i_ = 0; i_ < 4; ++i_) { const int q_ = F.tid + i_ * NTHR; tq[i_] = *(const u32x4*)(ws + WS_XC + (unsigned)((row0 + (q_ >> 4)) * D + 128 * (hh) + 8 * (q_ & 15)) * 2u); } } while (0)
    __syncthreads();
    QKV_PF(0);
    LAS float* NWS = (LAS float*)(lds + L_GT);
    {
        const GAS float* nwp = a.in[23]; const GAS float* skp = a.in[24];
        const float g0 = ((const float*)(ws + WS_ML_G))[(size_t)row0 * 8 + F.tid], g1 = ((const float*)(ws + WS_ML_G))[(size_t)row0 * 8 + F.tid + NTHR];
        const float b0 = ((const float*)(ws + WS_ML_B))[(size_t)row0 * 8 + F.tid], b1 = ((const float*)(ws + WS_ML_B))[(size_t)row0 * 8 + F.tid + NTHR];
        const float n0 = nwp[F.tid], n1 = nwp[F.tid + NTHR], s0 = skp[F.tid], s1 = skp[F.tid + NTHR];
        const float mp0 = ((const float*)(ws + WS_ML_MS))[(b * 8 + (F.tid & 7)) * NCHUNK + c];
        Gc[F.tid] = g0; Gc[F.tid + NTHR] = g1; Bc[F.tid] = b0; Bc[F.tid + NTHR] = b1; NWS[F.tid] = n0; NWS[F.tid + NTHR] = n1; NWS[1024 + F.tid] = s0; NWS[1024 + F.tid + NTHR] = s1;
        if (F.tid < 8) MP[F.tid] = mp0; }
    __syncthreads();
    if (F.tid < 8) { const int h = F.tid; float pm = -3.0e38f; const float mp = MP[h]; for (int t = 0; t < CH; ++t) { pm = fmaxf(pm, Bc[t * 8 + h]); Mv[t * 8 + h] = fmaxf(mp, pm); } }
    __syncthreads();
    LAS unsigned char* PS = lds + L_RAW + wid * 16 * RLD;
    LAS unsigned char* HS = lds + L_T0 + wid * 8448;
    for (int h = 0; h < 8; ++h) {
        f32x4 wq2[2][4], wk2[2][4]; BD_W(wq2, p16, h, F.tid & 15); BD_W(wk2, p17, h, F.tid & 15);
#pragma unroll
        for (int i = 0; i < 4; ++i) { const int q = F.tid + i * NTHR; const int lo = (q >> 4) * RLD + (q & 15) * 16; *(LAS u32x4*)(lds + L_T0 + lo) = bd8(tq[i], wq2, 1.0f); *(LAS u32x4*)(lds + L_T1 + XLO(q)) = bd8(tq[i], wk2, ML_KSCALE); }
        const int u = (b * 8 + h) * NCHUNK + c;
        u32x4 pc[4], tv[4];
#pragma unroll
        for (int i = 0; i < 4; ++i) { const int q = F.tid + i * NTHR; pc[i] = *(const u32x4*)((const bf16*)(ws + WS_CST) + (size_t)u * 16384 + (size_t)(q >> 4) * 128 + 8 * (q & 15));
            tv[i] = *(const u32x4*)(ws + WS_PROJ + (unsigned)((row0 + (q >> 4)) * EVEN_IN + 2048 + 128 * h + 8 * (q & 15)) * 2u); }
        __syncthreads();
        float rs[4] = {0.f, 0.f, 0.f, 0.f};
        float mrow[4];
#pragma unroll
        for (int j = 0; j < 4; ++j) mrow[j] = Mv[(16 * wid + 4 * fq + j) * 8 + h];
        bf16x8 Aq[4];
#pragma unroll
        for (int ks = 0; ks < 4; ++ks) Aq[ks] = LFRAG(lds + L_T0, 16 * wid + fr, 32 * ks + 8 * fq);
#pragma unroll
        for (int nt = 0; nt < 8; ++nt) {
            if (nt <= wid) {
                f32x4 sacc = (f32x4){0.f, 0.f, 0.f, 0.f};
#pragma unroll
                for (int ks = 0; ks < 4; ++ks) { const bf16x8 B = XFRAG(lds + L_T1, 16 * nt + fr, 4 * ks + fq); sacc = MFMA16(Aq[ks], B, sacc); }
                const int s_ = 16 * nt + fr; const float bs = Bc[s_ * 8 + h];
#pragma unroll
                for (int j = 0; j < 4; ++j) { const int t = 16 * wid + 4 * fq + j; const float p = (s_ <= t) ? sacc[j] * __expf(bs - mrow[j]) : 0.f; rs[j] += p;
                    *(LAS bf16*)(PS + (4 * fq + j) * RLD + s_ * 2) = (bf16)f2bf(p); }
            } else if (nt == wid + 1) {
#pragma unroll
                for (int j = 0; j < 4; ++j) *(LAS bf16*)(PS + (4 * fq + j) * RLD + (16 * nt + fr) * 2) = (bf16)0;
            }
        }
#pragma unroll
        for (int j = 0; j < 4; ++j) rs[j] = red16(rs[j]);
        f32x4 wv2[2][4]; BD_W(wv2, p18, h, F.tid & 15);
        __syncthreads();
#pragma unroll
        for (int i = 0; i < 4; ++i) { const int q = F.tid + i * NTHR; *(LAS u32x4*)(lds + L_T1 + XLO(q)) = pc[i]; *(LAS u32x4*)(lds + L_T2 + (q >> 4) * RLD + (q & 15) * 16) = bd8(tv[i], wv2, 1.0f); }
        __syncthreads();
        if (h < 7) QKV_PF(h + 1);
        f32x4 oacc[8];
#pragma unroll
        for (int ne = 0; ne < 8; ++ne) oacc[ne] = (f32x4){0.f, 0.f, 0.f, 0.f};
#pragma unroll
        for (int ks = 0; ks < 4; ++ks) {
#pragma unroll
            for (int ne = 0; ne < 8; ++ne) { const bf16x8 B = XFRAG(lds + L_T1, 16 * ne + fr, 4 * ks + fq); oacc[ne] = MFMA16(Aq[ks], B, oacc[ne]); } }
        const float mp = MP[h];
        float winter[4];
#pragma unroll
        for (int j = 0; j < 4; ++j) winter[j] = __expf(mp - mrow[j]);
#pragma unroll
        for (int ne = 0; ne < 8; ++ne)
#pragma unroll
            for (int j = 0; j < 4; ++j) oacc[ne][j] *= winter[j];
        const int kmax = (wid + 2) >> 1;
        bf16x8 Ap[4];
#pragma unroll
        for (int ks = 0; ks < 4; ++ks) Ap[ks] = LFRAG(PS, fr, 32 * ks + 8 * fq);
#pragma unroll
        for (int ne = 0; ne < 8; ++ne) { bf16x8 Bv[4]; tr_frag4<RLD>(tr_addr(lds + L_T2, 16 * ne, lane), Bv);
#pragma unroll
            for (int ks = 0; ks < 4; ++ks) if (ks < kmax) oacc[ne] = MFMA16(Ap[ks], Bv[ks], oacc[ne]); }
        float qn[4];
        { const float* np = (const float*)(ws + WS_ML_NST) + (size_t)u * 128 + 8 * fr; const f32x4 n0 = *(const f32x4*)np, n1 = *(const f32x4*)(np + 4);
#pragma unroll
            for (int j = 0; j < 4; ++j) { const bf16x8 qq = LFRAG(lds + L_T0, 16 * wid + 4 * fq + j, 8 * fr); float s = 0.f;
#pragma unroll
                for (int d = 0; d < 4; ++d) s += bf2f((unsigned short)qq[d]) * n0[d] + bf2f((unsigned short)qq[4 + d]) * n1[d];
                qn[j] = red16(s); } }
        float inv[4], mean[4], rstd[4];
#pragma unroll
        for (int j = 0; j < 4; ++j) { const int t = 16 * wid + 4 * fq + j; const float den = rs[j] + winter[j] * qn[j]; inv[j] = frcp(fmaxf(fabsf(den), __expf(-(Gc[t * 8 + h] + mrow[j])))); }
#pragma unroll
        for (int ne = 0; ne < 8; ++ne)
#pragma unroll
            for (int j = 0; j < 4; ++j) oacc[ne][j] *= inv[j];
#pragma unroll
        for (int j = 0; j < 4; ++j) { float s = 0.f;
#pragma unroll
            for (int ne = 0; ne < 8; ++ne) s += oacc[ne][j];
            mean[j] = red16(s) * (1.0f / 128.0f); float q2 = 0.f;
#pragma unroll
            for (int ne = 0; ne < 8; ++ne) { const float d = oacc[ne][j] - mean[j]; q2 += d * d; }
            rstd[j] = __builtin_amdgcn_rsqf(red16(q2) * (1.0f / 128.0f) + EPS); }
        const int er = lane >> 2, esg = lane & 3; const size_t egrow = (size_t)(row0 + 16 * wid + er); const int ec0 = 128 * h + 32 * esg;
        u32x4 exw[4], ezw[4];
#pragma unroll
        for (int q = 0; q < 4; ++q) { exw[q] = *(const u32x4*)((const bf16*)(ws + WS_XC) + egrow * D + ec0 + 8 * q); ezw[q] = *(const u32x4*)(proj + egrow * EVEN_IN + 3072 + ec0 + 8 * q); }
        __syncthreads();
#pragma unroll
        for (int ne = 0; ne < 8; ++ne)
#pragma unroll
            for (int j = 0; j < 4; ++j) *(LAS float*)(HS + (4 * fq + j) * 528 + (16 * ne + fr) * 4) = (oacc[ne][j] - mean[j]) * rstd[j];
        asm volatile("s_waitcnt lgkmcnt(0)" ::: "memory");
        { const int r = er, sg = esg; const size_t grow = egrow; const int c0 = ec0;
#pragma unroll
            for (int q = 0; q < 4; ++q) { const int cc = c0 + 8 * q;
                const f32x4 h0 = *(const LAS f32x4*)(HS + r * 528 + (32 * sg + 8 * q) * 4), h1 = *(const LAS f32x4*)(HS + r * 528 + (32 * sg + 8 * q + 4) * 4);
                const u32x4 xw = exw[q]; const u32x4 zw = ezw[q];
                const f32x4 nw0 = *(const LAS f32x4*)(NWS + cc), nw1 = *(const LAS f32x4*)(NWS + cc + 4), sk0 = *(const LAS f32x4*)(NWS + 1024 + cc), sk1 = *(const LAS f32x4*)(NWS + 1024 + cc + 4);
                float o[8];
#pragma unroll
                for (int e = 0; e < 4; ++e) { const unsigned xa = (e < 2) ? xw.x : xw.y, xb_ = (e < 2) ? xw.z : xw.w, za = (e < 2) ? zw.x : zw.y, zb_ = (e < 2) ? zw.z : zw.w;
                    const float x0 = bf2f((e & 1) ? (xa >> 16) : (xa & 0xffffu)), x1 = bf2f((e & 1) ? (xb_ >> 16) : (xb_ & 0xffffu));
                    const float z0 = bf2f((e & 1) ? (za >> 16) : (za & 0xffffu)), z1 = bf2f((e & 1) ? (zb_ >> 16) : (zb_ & 0xffffu));
                    o[e] = (h0[e] * nw0[e] + sk0[e] * x0) * siluf_(z0); o[4 + e] = (h1[e] * nw1[e] + sk1[e] * x1) * siluf_(z1); }
                u32x4 w; w.x = pk2(o[0], o[1]); w.y = pk2(o[2], o[3]); w.z = pk2(o[4], o[5]); w.w = pk2(o[6], o[7]);
                *(u32x4*)(mix + grow * MIXW + 1024 + cc) = w; } }
        __syncthreads();
    }
#undef QKV_PF
}


template <bool OUT>
__device__ __forceinline__ void lru_unit2(const PArgs& a, Frame& F0, int b, int c) { Frame F = relaunder(F0);
    unsigned char* ws = F.ws; LAS unsigned char* lds = F.lds;
    const bf16* proj = (const bf16*)(ws + WS_PROJ);
    const int wid = F.wave, lane = F.lane, fr = lane & 15, fq = lane >> 4;
    const int n = F.tid & 31, tg = F.tid >> 5;
    const int row0 = b * SEQ + c * CH;
    __syncthreads();
    u32x4 pr[5];
    RAW_PF(pr, proj, EVEN_IN, row0, c * CH, 0);
    for (int h = 0; h < 8; ++h) {
        RAW_PW(pr);
        if (OUT) copy_tile(F, proj + (size_t)row0 * EVEN_IN + 1024 + 128 * h, EVEN_IN, L_T1);
        const int gc = 128 * h + 4 * n;
        f32x4 cw[4]; const f32x4 cb = *(const f32x4*)(a.in[8] + gc);
#pragma unroll
        for (int j = 0; j < 4; ++j) cw[j] = *(const f32x4*)(a.in[7] + (size_t)j * D + gc);
        const bf16* wr_ = (const bf16*)(ws + WS_LRUW) + (size_t)(h * 128 + 16 * wid + fr) * 128 + 8 * fq;
        const bf16* wi_ = wr_ + (size_t)8 * 128 * 128;
        bf16x8 Br[4], Bi[4];
#pragma unroll
        for (int ks = 0; ks < 4; ++ks) { Br[ks] = *(const bf16x8*)(wr_ + 32 * ks); Bi[ks] = *(const bf16x8*)(wi_ + 32 * ks); }
        const int ch = 128 * h + 16 * wid + fr;
        const float br = a.in[10][ch], bi = a.in[12][ch], ls8 = -8.0f * log1pf(__expf(-a.in[13][ch]));
        float hin = OUT ? ((const float*)(ws + WS_LRU_CARRY))[(size_t)(b * NCHUNK + c) * D + ch] : 0.f;
        __syncthreads();
        { float w0[4], w1[4], w2[4], w3[4]; const LAS unsigned char* rp = lds + L_RAW + (8 * tg) * RLD + 8 * n; u32x2 u;
          u = *(const LAS u32x2*)(rp); w0[0] = bf2f(u.x & 0xffffu); w0[1] = bf2f(u.x >> 16); w0[2] = bf2f(u.y & 0xffffu); w0[3] = bf2f(u.y >> 16);
          u = *(const LAS u32x2*)(rp + RLD); w1[0] = bf2f(u.x & 0xffffu); w1[1] = bf2f(u.x >> 16); w1[2] = bf2f(u.y & 0xffffu); w1[3] = bf2f(u.y >> 16);
          u = *(const LAS u32x2*)(rp + 2 * RLD); w2[0] = bf2f(u.x & 0xffffu); w2[1] = bf2f(u.x >> 16); w2[2] = bf2f(u.y & 0xffffu); w2[3] = bf2f(u.y >> 16);
#pragma unroll
          for (int i = 0; i < 8; ++i) { const int t = 8 * tg + i;
              u = *(const LAS u32x2*)(rp + (3 + i) * RLD); w3[0] = bf2f(u.x & 0xffffu); w3[1] = bf2f(u.x >> 16); w3[2] = bf2f(u.y & 0xffffu); w3[3] = bf2f(u.y >> 16);
              float y[4];
#pragma unroll
              for (int e = 0; e < 4; ++e) y[e] = cb[e] + cw[0][e] * w0[e] + cw[1][e] * w1[e] + cw[2][e] * w2[e] + cw[3][e] * w3[e];
              u32x2 o; o.x = pk2(y[0], y[1]); o.y = pk2(y[2], y[3]); *(LAS u32x2*)(lds + L_T0 + t * RLD + 8 * n) = o;
#pragma unroll
              for (int e = 0; e < 4; ++e) { w0[e] = w1[e]; w1[e] = w2[e]; w2[e] = w3[e]; } } }
        __syncthreads();
        if (h < 7) RAW_PF(pr, proj, EVEN_IN, row0, c * CH, 128 * (h + 1));
        float aprod = 1.f;
#pragma unroll 4
        for (int mt = 0; mt < 8; ++mt) {
            f32x4 ar = (f32x4){0.f, 0.f, 0.f, 0.f}, ai = ar;
#pragma unroll
            for (int ks = 0; ks < 4; ++ks) { const bf16x8 A = LFRAG(lds + L_T0, 16 * mt + fr, 32 * ks + 8 * fq); ar = MFMA16(A, Br[ks], ar); ai = MFMA16(A, Bi[ks], ai); }
            float av[4], uv[4];
#pragma unroll
            for (int j = 0; j < 4; ++j) { const float rr = sigmoidf_(ar[j] + br), ii = sigmoidf_(ai[j] + bi); av[j] = __expf(rr * ls8);
                const float x = bf2f(*(const LAS bf16*)(lds + L_T0 + (16 * mt + 4 * fq + j) * RLD + (16 * wid + fr) * 2));
                uv[j] = __builtin_amdgcn_sqrtf(fmaxf(1.0f - av[j] * av[j], 0.f)) * ii * x; }
            const float As = av[0] * av[1] * av[2] * av[3];
            const float Hs = ((uv[0] * av[1] + uv[1]) * av[2] + uv[2]) * av[3] + uv[3];
            const float A0 = __shfl(As, fr), H0 = __shfl(Hs, fr), A1 = __shfl(As, 16 + fr), H1 = __shfl(Hs, 16 + fr), A2 = __shfl(As, 32 + fr), H2 = __shfl(Hs, 32 + fr), A3 = __shfl(As, 48 + fr), H3 = __shfl(Hs, 48 + fr);
            const float h0 = hin, h1 = A0 * h0 + H0, h2 = A1 * h1 + H1, h3 = A2 * h2 + H2, hend = A3 * h3 + H3;
            if (OUT) { float hs = fq == 0 ? h0 : (fq == 1 ? h1 : (fq == 2 ? h2 : h3));
#pragma unroll
                for (int j = 0; j < 4; ++j) { hs = av[j] * hs + uv[j]; const int off = (16 * mt + 4 * fq + j) * RLD + (16 * wid + fr) * 2;
                    const float g = bf2f(*(const LAS bf16*)(lds + L_T1 + off)); *(LAS bf16*)(lds + L_T2 + off) = (bf16)f2bf(hs * gelu_tanh(g)); } }
            else { float hs = fq == 0 ? h0 : (fq == 1 ? h1 : (fq == 2 ? h2 : h3));
                float pp = aprod * (fq == 0 ? 1.0f : (fq == 1 ? A0 : (fq == 2 ? A0 * A1 : A0 * A1 * A2)));
#pragma unroll
                for (int j = 0; j < 4; ++j) { hs = av[j] * hs + uv[j]; pp *= av[j]; const int off = (16 * mt + 4 * fq + j) * RLD + (16 * wid + fr) * 2;
                    *(LAS bf16*)(lds + L_T1 + off) = (bf16)f2bf(hs); *(LAS bf16*)(lds + L_T2 + off) = (bf16)f2bf(pp); } }
            hin = hend; aprod *= (A0 * A1) * (A2 * A3);
        }
        if (!OUT && fq == 0) { ((float*)(ws + WS_LRU_AT))[(size_t)(b * NCHUNK + c) * D + ch] = aprod; ((float*)(ws + WS_LRU_HT))[(size_t)(b * NCHUNK + c) * D + ch] = hin; }
        __syncthreads();
        if (OUT) {
#pragma unroll
            for (int i = 0; i < 4; ++i) { const int q = F.tid + i * NTHR, r = q >> 4, cc = q & 15; *(u32x4*)((bf16*)(ws + WS_MIX) + (size_t)(row0 + r) * MIXW + 128 * h + 8 * cc) = *(const LAS u32x4*)(lds + L_T2 + r * RLD + cc * 16); }
        } else {
#pragma unroll
            for (int i = 0; i < 4; ++i) { const int q = F.tid + i * NTHR, r = q >> 4, cc = q & 15; const size_t go = (size_t)(row0 + r) * D + 128 * h + 8 * cc;
                __builtin_nontemporal_store(*(const LAS u32x4*)(lds + L_T1 + r * RLD + cc * 16), (u32x4*)((bf16*)(ws + WS_LRU_HL) + go)); __builtin_nontemporal_store(*(const LAS u32x4*)(lds + L_T2 + r * RLD + cc * 16), (u32x4*)((bf16*)(ws + WS_LRU_PC) + go)); }
        }
    }
    __syncthreads();
}

__device__ __forceinline__ void ph_ev_local(const PArgs& a, Frame& F) { for (int u = F.bid; u < NB * NCHUNK; u += F.G) { const int b = u / NCHUNK, c = u % NCHUNK; lru_unit2<false>(a, F, b, c); ml_pre(a, F, b, c); { Frame F2 = relaunder(F); ml_local2(a, F2, b, c); } } }
__device__ __forceinline__ void ph_ev_out(const PArgs& a, Frame& F) { for (int u = F.bid; u < NB * NCHUNK; u += F.G) { const int b = u / NCHUNK, c = u % NCHUNK; lru_fix(a, F, b, c); ml_out2(a, F, b, c); } }
__device__ __forceinline__ void ph_ev_scan(const PArgs& a, Frame& F) {
    unsigned char* ws = F.ws; const size_t gt = (size_t)F.bid * NTHR + F.tid, NT = (size_t)F.G * NTHR;
    for (size_t i = gt; i < (size_t)NB * D; i += NT) { const int b = (int)(i / D), ch = (int)(i % D); float carry = 0.f;
        for (int c = 0; c < NCHUNK; ++c) { const size_t o = (size_t)(b * NCHUNK + c) * D + ch; ((float*)(ws + WS_LRU_CARRY))[o] = carry; carry = ((const float*)(ws + WS_LRU_AT))[o] * carry + ((const float*)(ws + WS_LRU_HT))[o]; } }
    for (size_t i = gt; i < (size_t)64 * 4096; i += NT) { const int bh = (int)(i >> 12), e4 = (int)(i & 4095);
        float m = -1.0e30f; f32x4 val = (f32x4){0.f, 0.f, 0.f, 0.f};
#pragma unroll 1
        for (int c0 = 0; c0 < NCHUNK; c0 += 8) { u32x2 loc[8]; float Gv[8], mlv[8];
#pragma unroll
            for (int k = 0; k < 8; ++k) { const int u = bh * NCHUNK + c0 + k; Gv[k] = ((const float*)(ws + WS_ML_GT))[u]; mlv[k] = ((const float*)(ws + WS_ML_ML))[u]; loc[k] = *(const u32x2*)((const bf16*)(ws + WS_CLOC) + (size_t)u * 16384 + 4 * e4); }
#pragma unroll
            for (int k = 0; k < 8; ++k) { const int u = bh * NCHUNK + c0 + k;
                u32x2 w; w.x = pk2(val[0], val[1]); w.y = pk2(val[2], val[3]); *(u32x2*)((bf16*)(ws + WS_CST) + (size_t)u * 16384 + 4 * e4) = w;
                if (e4 == 0) ((float*)(ws + WS_ML_MS))[u] = m;
                const float mn = fmaxf(m + Gv[k], mlv[k]); const float wc = __expf(m + Gv[k] - mn), wl = __expf(mlv[k] - mn);
                const f32x4 lv = (f32x4){bf2f(loc[k].x & 0xffffu), bf2f(loc[k].x >> 16), bf2f(loc[k].y & 0xffffu), bf2f(loc[k].y >> 16)};
                val = val * wc + lv * wl; m = mn; } } }
    for (size_t i = gt; i < (size_t)64 * 128; i += NT) { const int bh = (int)(i >> 7), e = (int)(i & 127);
        float m = -1.0e30f, val = 0.f;
#pragma unroll 1
        for (int c0 = 0; c0 < NCHUNK; c0 += 8) { float loc[8], Gv[8], mlv[8];
#pragma unroll
            for (int k = 0; k < 8; ++k) { const int u = bh * NCHUNK + c0 + k; Gv[k] = ((const float*)(ws + WS_ML_GT))[u]; mlv[k] = ((const float*)(ws + WS_ML_ML))[u]; loc[k] = ((const float*)(ws + WS_ML_NLOC))[(size_t)u * 128 + e]; }
#pragma unroll
            for (int k = 0; k < 8; ++k) { const int u = bh * NCHUNK + c0 + k;
                ((float*)(ws + WS_ML_NST))[(size_t)u * 128 + e] = val;
                const float mn = fmaxf(m + Gv[k], mlv[k]); const float wc = __expf(m + Gv[k] - mn), wl = __expf(mlv[k] - mn);
                val = wc * val + wl * loc[k]; m = mn; } } }
}

__device__ __forceinline__ void ssd_pre(const PArgs& a, Frame& F0, int b, int c) { Frame F = relaunder(F0);
    unsigned char* ws = F.ws; const bf16* proj = (const bf16*)(ws + WS_PROJ); bf16* xbc = (bf16*)(ws + WS_XBC);
    const int row0 = b * SEQ + c * CH, ch0 = 8 * F.tid;
    float cw[4][8], cb[8];
#pragma unroll
    for (int j = 0; j < 4; ++j) { const f32x4 lo = *(const f32x4*)(a.in[27] + (size_t)j * 4096 + ch0), hi = *(const f32x4*)(a.in[27] + (size_t)j * 4096 + ch0 + 4);
#pragma unroll
        for (int e = 0; e < 4; ++e) { cw[j][e] = lo[e]; cw[j][4 + e] = hi[e]; } }
    { const f32x4 lo = *(const f32x4*)(a.in[28] + ch0), hi = *(const f32x4*)(a.in[28] + ch0 + 4);
#pragma unroll
        for (int e = 0; e < 4; ++e) { cb[e] = lo[e]; cb[4 + e] = hi[e]; } }
    const bf16* src = proj + (size_t)row0 * OD_INP + 2048 + ch0;
    u32x4 r0 = (u32x4){0u, 0u, 0u, 0u}, r1 = r0, r2 = r0;
    if (c > 0) { r0 = *(const u32x4*)(src - 3 * (ptrdiff_t)OD_INP); r1 = *(const u32x4*)(src - 2 * (ptrdiff_t)OD_INP); r2 = *(const u32x4*)(src - (ptrdiff_t)OD_INP); }
#pragma unroll 1
    for (int t0 = 0; t0 < CH; t0 += 8) {
        u32x4 rr[8];
#pragma unroll
        for (int i = 0; i < 8; ++i) rr[i] = *(const u32x4*)(src + (size_t)(t0 + i) * OD_INP);
#pragma unroll
        for (int i = 0; i < 8; ++i) { const u32x4 r3 = rr[i]; float o[8];
#pragma unroll
            for (int e = 0; e < 8; ++e) { const unsigned w0 = (e < 2) ? r0.x : (e < 4) ? r0.y : (e < 6) ? r0.z : r0.w, w1 = (e < 2) ? r1.x : (e < 4) ? r1.y : (e < 6) ? r1.z : r1.w,
                    w2 = (e < 2) ? r2.x : (e < 4) ? r2.y : (e < 6) ? r2.z : r2.w, w3 = (e < 2) ? r3.x : (e < 4) ? r3.y : (e < 6) ? r3.z : r3.w;
                const float x0 = bf2f((e & 1) ? (w0 >> 16) : (w0 & 0xffffu)), x1 = bf2f((e & 1) ? (w1 >> 16) : (w1 & 0xffffu)), x2 = bf2f((e & 1) ? (w2 >> 16) : (w2 & 0xffffu)), x3 = bf2f((e & 1) ? (w3 >> 16) : (w3 & 0xffffu));
                o[e] = siluf_(cb[e] + cw[0][e] * x0 + cw[1][e] * x1 + cw[2][e] * x2 + cw[3][e] * x3); }
            u32x4 w; w.x = pk2(o[0], o[1]); w.y = pk2(o[2], o[3]); w.z = pk2(o[4], o[5]); w.w = pk2(o[6], o[7]);
            *(u32x4*)(xbc + (size_t)(row0 + t0 + i) * 4096 + ch0) = w;
            r0 = r1; r1 = r2; r2 = r3; }
    }
}
constexpr int L_DT2 = L_T2, L_AC2 = L_T2 + 16384;
constexpr int L_DT4 = L_SM, L_AC4 = L_SM + 2048;
__device__ __forceinline__ void ssd_local2(const PArgs& a, Frame& F0, int b, int c) { Frame F = relaunder(F0);
    unsigned char* ws = F.ws; LAS unsigned char* lds = F.lds;
    const bf16* proj = (const bf16*)(ws + WS_PROJ); const bf16* xbc = (const bf16*)(ws + WS_XBC);
    const int wid = F.wave, lane = F.lane, fr = lane & 15, fq = lane >> 4, row0 = b * SEQ + c * CH;
    LAS float* DT = (LAS float*)(lds + L_DT2); LAS float* AC = (LAS float*)(lds + L_AC2);
    __syncthreads();
    {
        const unsigned char* u8 = ws + WS_U + (unsigned)((row0 + 16 * wid + fr) * D + 32 * fq);
        const unsigned char* w8 = ws + WS_WODIN + (unsigned)((OD_GN + fr) * D + 32 * fq);
        const float dtb0 = a.in[29][fr], dtb1 = a.in[29][16 + fr];
        f32x4 dd[2][2];
#pragma unroll
        for (int i = 0; i < 2; ++i)
#pragma unroll
            for (int j = 0; j < 2; ++j) { dd[i][j] = (f32x4){0.f, 0.f, 0.f, 0.f}; asm volatile("" : "+v"(dd[i][j])); }
        unsigned scl8 = 0x7f7f7f7fu; asm volatile("" : "+v"(scl8));
#pragma unroll
        for (int kb = 0; kb < 2; ++kb) {
            i32x8 ua[4], wb0[4], wb1[4];
#pragma unroll
            for (int k = 0; k < 4; ++k) { const int ko = 128 * (4 * kb + k);
                { const i32x4 p0 = *(const i32x4*)(u8 + ko), p1 = *(const i32x4*)(u8 + ko + 16); ua[k] = __builtin_shufflevector(p0, p1, 0, 1, 2, 3, 4, 5, 6, 7); }
                { const i32x4 p0 = *(const i32x4*)(w8 + ko), p1 = *(const i32x4*)(w8 + ko + 16); wb0[k] = __builtin_shufflevector(p0, p1, 0, 1, 2, 3, 4, 5, 6, 7); }
                { const i32x4 p0 = *(const i32x4*)(w8 + 16 * D + ko), p1 = *(const i32x4*)(w8 + 16 * D + ko + 16); wb1[k] = __builtin_shufflevector(p0, p1, 0, 1, 2, 3, 4, 5, 6, 7); } }
#pragma unroll
            for (int k = 0; k < 4; ++k) {
                asm volatile("v_mfma_scale_f32_16x16x128_f8f6f4 %0, %1, %2, %0, %3, %3 op_sel_hi:[0,0,0]" : "+v"(dd[k & 1][0]) : "v"(ua[k]), "v"(wb0[k]), "v"(scl8));
                asm volatile("v_mfma_scale_f32_16x16x128_f8f6f4 %0, %1, %2, %0, %3, %3 op_sel_hi:[0,0,0]" : "+v"(dd[k & 1][1]) : "v"(ua[k]), "v"(wb1[k]), "v"(scl8)); }
        }
        asm volatile("s_nop 15\n\ts_nop 15" ::: "memory");
#pragma unroll
        for (int j = 0; j < 4; ++j) { const int t = 16 * wid + 4 * fq + j;
            DT[t * 32 + fr] = softplusf_((dd[0][0][j] + dd[1][0][j]) * pg8::WINV8 + dtb0); DT[t * 32 + 16 + fr] = softplusf_((dd[0][1][j] + dd[1][1][j]) * pg8::WINV8 + dtb1); }
    }
    __syncthreads();
    if (F.tid < 32) { const float A = -__expf(a.in[30][F.tid]); float acc = 0.f; for (int t = 0; t < CH; ++t) { acc += DT[t * 32 + F.tid] * A; AC[t * 32 + F.tid] = acc; }
        ((float*)(ws + WS_SSD_ALAST))[(size_t)(b * NCHUNK + c) * 32 + F.tid] = acc; }
    __syncthreads();
    for (int q = F.tid; q < CH * 32; q += NTHR) { ((float*)(ws + WS_DTG))[(size_t)row0 * 32 + q] = DT[q]; ((float*)(ws + WS_ACG))[(size_t)row0 * 32 + q] = AC[q]; }
    ssd_pre(a, F, b, c);
    WSYNC();
    for (int g = 0; g < 8; ++g) {
        copy_tile(F, xbc + (size_t)row0 * 4096 + 2048 + 128 * g, 4096, L_T1);
        for (int jp = 0; jp < 2; ++jp) { const int hd0 = 4 * g + 2 * jp;
            const bf16* xs = xbc + (size_t)row0 * 4096 + 64 * hd0;
#pragma unroll
            for (int i = 0; i < 4; ++i) { const int q = F.tid + i * NTHR, r = q >> 4, cc = q & 15, hd = hd0 + (cc >> 3);
                const float sc = __expf(AC[127 * 32 + hd] - AC[r * 32 + hd]) * DT[r * 32 + hd];
                *(LAS u32x4*)(lds + L_T0 + r * RLD + cc * 16) = scale8(*(const u32x4*)(xs + (size_t)r * 4096 + 8 * cc), sc); }
            __syncthreads();
            bf16x8 Ax[4]; tr_frag4<RLD>(tr_addr(lds + L_T0, 16 * wid, lane), Ax);
            bf16* sl = (bf16*)(ws + WS_SLOC) + ((size_t)(b * NCHUNK + c) * 32 + hd0 + (wid >> 2)) * 8192;
#pragma unroll
            for (int nt = 0; nt < 8; ++nt) { bf16x8 Bb[4]; tr_frag4<RLD>(tr_addr(lds + L_T1, 16 * nt, lane), Bb);
                f32x4 acc = (f32x4){0.f, 0.f, 0.f, 0.f};
#pragma unroll
                for (int ks = 0; ks < 4; ++ks) acc = MFMA16(Ax[ks], Bb[ks], acc);
#pragma unroll
                for (int jj = 0; jj < 4; ++jj) sl[(16 * (wid & 3) + 4 * fq + jj) * 128 + 16 * nt + fr] = (bf16)f2bf(acc[jj]); }
            __syncthreads();
        }
    }
}
constexpr int L_NW4 = L_SM + 4096, L_SS = L_SM + 5120;
__device__ __forceinline__ void ssd_out3(const PArgs& a, Frame& F0, int b, int c) { Frame F = relaunder(F0);
    unsigned char* ws = F.ws; LAS unsigned char* lds = F.lds;
    const bf16* proj = (const bf16*)(ws + WS_PROJ); const bf16* xbc = (const bf16*)(ws + WS_XBC); bf16* mix = (bf16*)(ws + WS_MIX);
    const int wid = F.wave, lane = F.lane, fr = lane & 15, fq = lane >> 4, row0 = b * SEQ + c * CH;
    LAS float* DT4 = (LAS float*)(lds + L_DT4); LAS float* AC4 = (LAS float*)(lds + L_AC4); LAS float* NW4 = (LAS float*)(lds + L_NW4);
    LAS unsigned char* PS = lds + L_RAW + wid * 16 * RLD;
    LAS unsigned char* YS = lds + L_T0 + wid * 8448;
    const bf16* sstb = (const bf16*)(ws + WS_SST) + (size_t)(b * NCHUNK + c) * 32 * 8192;
    u32x4 pss[2];
#define SS_PF(hd_) do { const bf16* sp_ = sstb + (size_t)(hd_) * 8192; _Pragma("unroll") for (int i_ = 0; i_ < 2; ++i_) { const int q_ = F.tid + i_ * NTHR; pss[i_] = *(const u32x4*)(sp_ + (size_t)(q_ >> 4) * 128 + 8 * (q_ & 15)); } } while (0)
#define SS_PW() do { _Pragma("unroll") for (int i_ = 0; i_ < 2; ++i_) { const int q_ = F.tid + i_ * NTHR; *(LAS u32x4*)(lds + L_SS + (q_ >> 4) * 256 + (((q_ & 15) ^ ((q_ >> 4) & 15)) << 4)) = pss[i_]; } } while (0)
    const GAS float* p31 = uptr(a.in[31]); const GAS float* p32 = uptr(a.in[32]);
    SS_PF(0);
    for (int g = 0; g < 8; ++g) {
        __syncthreads();
        u32x4 tc[4], tb[4], tx[4], px1[4];
        const unsigned char* xb0 = ws + WS_XBC;
#pragma unroll
        for (int i = 0; i < 4; ++i) { const int q = F.tid + i * NTHR; const unsigned o = (unsigned)((row0 + (q >> 4)) * 4096 + 8 * (q & 15)) * 2u;
            tc[i] = *(const u32x4*)(xb0 + o + (3072 + 128 * g) * 2); tb[i] = *(const u32x4*)(xb0 + o + (2048 + 128 * g) * 2);
            tx[i] = *(const u32x4*)(xb0 + o + (256 * g) * 2); px1[i] = *(const u32x4*)(xb0 + o + (256 * g + 128) * 2); }
        const unsigned dto = (unsigned)((row0 + (F.tid >> 2)) * 32 + 4 * g + (F.tid & 3)) * 4u;
        const float dt4 = *(const float*)(ws + WS_DTG + dto), ac4 = *(const float*)(ws + WS_ACG + dto);
        const float nw4 = p32[256 * g + (F.tid & 255)];
        const f32x4 dsk4 = *(const GAS f32x4*)(p31 + 4 * g);
        asm volatile("" ::: "memory");
#pragma unroll
        for (int i = 0; i < 4; ++i) { const int q = F.tid + i * NTHR; const int lo = (q >> 4) * RLD + (q & 15) * 16; *(LAS u32x4*)(lds + L_T0 + lo) = tc[i]; *(LAS u32x4*)(lds + L_T1 + lo) = tb[i]; *(LAS u32x4*)(lds + L_T2 + lo) = tx[i]; }
        DT4[F.tid] = dt4; AC4[F.tid] = ac4;
        if (F.tid < 256) NW4[F.tid] = nw4;
        __syncthreads();
        bf16x8 Ac[4];
#pragma unroll
        for (int ks = 0; ks < 4; ++ks) Ac[ks] = LFRAG(lds + L_T0, 16 * wid + fr, 32 * ks + 8 * fq);
        f32x4 cb[8];
#pragma unroll
        for (int nt = 0; nt < 8; ++nt) { cb[nt] = (f32x4){0.f, 0.f, 0.f, 0.f};
            if (nt <= wid) {
#pragma unroll
                for (int ks = 0; ks < 4; ++ks) { const bf16x8 B = LFRAG(lds + L_T1, 16 * nt + fr, 32 * ks + 8 * fq); cb[nt] = MFMA16(Ac[ks], B, cb[nt]); } } }
        __syncthreads();
#pragma unroll
        for (int i = 0; i < 4; ++i) { const int q = F.tid + i * NTHR; *(LAS u32x4*)(lds + L_T1 + (q >> 4) * RLD + (q & 15) * 16) = px1[i]; }
        SS_PW();
        __syncthreads();
        unsigned yp[4][4][2];
#pragma unroll 1
        for (int j = 0; j < 4; ++j) { const int hd = 4 * g + j; const int xoff = (j < 2 ? L_T2 : L_T1), xcol = 64 * (j & 1);
            if (hd < 31) SS_PF(hd + 1);
            float at[4];
#pragma unroll
            for (int jj = 0; jj < 4; ++jj) at[jj] = AC4[(16 * wid + 4 * fq + jj) * 4 + j];
#pragma unroll
            for (int nt = 0; nt < 8; ++nt) {
                if (nt <= wid) { const int s_ = 16 * nt + fr; const float as = AC4[s_ * 4 + j], ds = DT4[s_ * 4 + j];
#pragma unroll
                    for (int jj = 0; jj < 4; ++jj) { const int t = 16 * wid + 4 * fq + jj; const float w = (s_ <= t) ? cb[nt][jj] * __expf(at[jj] - as) * ds : 0.f;
                        *(LAS bf16*)(PS + (4 * fq + jj) * RLD + s_ * 2) = (bf16)f2bf(w); }
                } else if (nt == wid + 1) {
#pragma unroll
                    for (int jj = 0; jj < 4; ++jj) *(LAS bf16*)(PS + (4 * fq + jj) * RLD + (16 * nt + fr) * 2) = (bf16)0;
                }
            }
            asm volatile("s_waitcnt lgkmcnt(0)" ::: "memory");
            f32x4 ya[4];
#pragma unroll
            for (int np = 0; np < 4; ++np) ya[np] = (f32x4){0.f, 0.f, 0.f, 0.f};
#pragma unroll
            for (int ks = 0; ks < 4; ++ks) {
#pragma unroll
                for (int np = 0; np < 4; ++np) { const bf16x8 B = *(const LAS bf16x8*)(lds + L_SS + (16 * np + fr) * 256 + (((4 * ks + fq) ^ fr) << 4)); ya[np] = MFMA16(Ac[ks], B, ya[np]); } }
#pragma unroll
            for (int np = 0; np < 4; ++np)
#pragma unroll
                for (int jj = 0; jj < 4; ++jj) ya[np][jj] *= __expf(at[jj]);
            const int kmax = (wid + 2) >> 1;
            bf16x8 Ap[4];
#pragma unroll
            for (int ks = 0; ks < 4; ++ks) Ap[ks] = LFRAG(PS, fr, 32 * ks + 8 * fq);
            const float dsk = (j == 0) ? dsk4[0] : (j == 1) ? dsk4[1] : (j == 2) ? dsk4[2] : dsk4[3];
#pragma unroll
            for (int np = 0; np < 4; ++np) { bf16x8 Bx[4]; tr_frag4<RLD>(tr_addr(lds + xoff, xcol + 16 * np, lane), Bx);
#pragma unroll
                for (int ks = 0; ks < 4; ++ks) if (ks < kmax) ya[np] = MFMA16(Ap[ks], Bx[ks], ya[np]);
                float yg[4];
#pragma unroll
                for (int jj = 0; jj < 4; ++jj) { const int t = 16 * wid + 4 * fq + jj; const float x = bf2f(*(const LAS bf16*)(lds + xoff + t * RLD + (xcol + 16 * np + fr) * 2)); yg[jj] = ya[np][jj] + dsk * x; }
                const unsigned p0 = pk2(yg[0], yg[1]), p1 = pk2(yg[2], yg[3]);
                if (j == 0) { yp[0][np][0] = p0; yp[0][np][1] = p1; } else if (j == 1) { yp[1][np][0] = p0; yp[1][np][1] = p1; } else if (j == 2) { yp[2][np][0] = p0; yp[2][np][1] = p1; } else { yp[3][np][0] = p0; yp[3][np][1] = p1; } }
            __syncthreads();
            if (j < 3) { SS_PW(); __syncthreads(); }
        }
        const int er = lane >> 2, ej = lane & 3; const size_t egrow = (size_t)(row0 + 16 * wid + er); const int ehd = 4 * g + ej;
        u32x4 zw[8];
#pragma unroll
        for (int q = 0; q < 8; ++q) zw[q] = *(const u32x4*)(proj + egrow * OD_INP + 64 * ehd + 8 * q);
#pragma unroll
        for (int j = 0; j < 4; ++j)
#pragma unroll
            for (int np = 0; np < 4; ++np)
#pragma unroll
                for (int jj = 0; jj < 4; ++jj) { const unsigned pw = yp[j][np][jj >> 1]; *(LAS bf16*)(YS + (4 * fq + jj) * 528 + (64 * j + 16 * np + fr) * 2) = (bf16)((jj & 1) ? (pw >> 16) : (pw & 0xffffu)); }
        asm volatile("s_waitcnt lgkmcnt(0)" ::: "memory");
        { float ssq = 0.f;
#pragma unroll
            for (int q = 0; q < 8; ++q) { LAS u32x4* yp_ = (LAS u32x4*)(YS + er * 528 + (64 * ej + 8 * q) * 2); const u32x4 yw = *yp_; float o[8];
#pragma unroll
                for (int e = 0; e < 8; ++e) { const unsigned yy = (e < 2) ? yw.x : (e < 4) ? yw.y : (e < 6) ? yw.z : yw.w, zz = (e < 2) ? zw[q].x : (e < 4) ? zw[q].y : (e < 6) ? zw[q].z : zw[q].w;
                    const float y = bf2f((e & 1) ? (yy >> 16) : (yy & 0xffffu)), z = bf2f((e & 1) ? (zz >> 16) : (zz & 0xffffu)); o[e] = y * siluf_(z); ssq += o[e] * o[e]; }
                u32x4 w; w.x = pk2(o[0], o[1]); w.y = pk2(o[2], o[3]); w.z = pk2(o[4], o[5]); w.w = pk2(o[6], o[7]); *yp_ = w; }
            ssq += __shfl_xor(ssq, 1); ssq += __shfl_xor(ssq, 2);
            const float rstd = __builtin_amdgcn_rsqf(ssq * (1.0f / 256.0f) + EPS);
#pragma unroll
            for (int q = 0; q < 8; ++q) { const int cl = 64 * ej + 8 * q; const f32x4 n0 = *(const LAS f32x4*)(NW4 + cl), n1 = *(const LAS f32x4*)(NW4 + cl + 4); const u32x4 yw = *(const LAS u32x4*)(YS + er * 528 + cl * 2);
                u32x4 w; w.x = pk2(bf2f(yw.x & 0xffffu) * rstd * n0[0], bf2f(yw.x >> 16) * rstd * n0[1]); w.y = pk2(bf2f(yw.y & 0xffffu) * rstd * n0[2], bf2f(yw.y >> 16) * rstd * n0[3]);
                w.z = pk2(bf2f(yw.z & 0xffffu) * rstd * n1[0], bf2f(yw.z >> 16) * rstd * n1[1]); w.w = pk2(bf2f(yw.w & 0xffffu) * rstd * n1[2], bf2f(yw.w >> 16) * rstd * n1[3]);
                *(u32x4*)(mix + egrow * MIXW + 256 * g + cl) = w; } }
    }
    __syncthreads();
#undef SS_PF
#undef SS_PW
}
__device__ __forceinline__ void ph_od_local(const PArgs& a, Frame& F) { for (int u = F.bid; u < NB * NCHUNK; u += F.G) ssd_local2(a, F, u / NCHUNK, u % NCHUNK); }
__device__ __forceinline__ void ph_od_out(const PArgs& a, Frame& F) { for (int u = F.bid; u < NB * NCHUNK; u += F.G) ssd_out3(a, F, u / NCHUNK, u % NCHUNK); }
__device__ __forceinline__ void ph_od_scan(const PArgs& a, Frame& F) {
    unsigned char* ws = F.ws; const size_t gt = (size_t)F.bid * NTHR + F.tid, NT = (size_t)F.G * NTHR;
    for (size_t i = gt; i < (size_t)NB * 32 * 8192 / 4; i += NT) { const int b = (int)(i / (32 * 2048)), rem = (int)(i % (32 * 2048)), hd = rem / 2048, e4 = rem % 2048;
        f32x4 st = (f32x4){0.f, 0.f, 0.f, 0.f};
#pragma unroll 1
        for (int c0 = 0; c0 < NCHUNK; c0 += 8) { f32x4 loc[8]; float dec[8];
#pragma unroll
            for (int k = 0; k < 8; ++k) { const size_t u = (size_t)(b * NCHUNK + c0 + k) * 32 + hd; { const u32x2 lw = *(const u32x2*)((const bf16*)(ws + WS_SLOC) + u * 8192 + 4 * e4); loc[k] = (f32x4){bf2f(lw.x & 0xffffu), bf2f(lw.x >> 16), bf2f(lw.y & 0xffffu), bf2f(lw.y >> 16)}; } dec[k] = ((const float*)(ws + WS_SSD_ALAST))[u]; }
#pragma unroll
            for (int k = 0; k < 8; ++k) { const size_t u = (size_t)(b * NCHUNK + c0 + k) * 32 + hd;
                u32x2 w; w.x = pk2(st[0], st[1]); w.y = pk2(st[2], st[3]); *(u32x2*)((bf16*)(ws + WS_SST) + u * 8192 + 4 * e4) = w;
                st = st * __expf(dec[k]) + loc[k]; } } }
}

__device__ __forceinline__ int moe_tables(Frame& F, int l) {
    LAS int* tab = (LAS int*)(F.lds + L_SCHED);
    __syncthreads();
    if (F.tid == 0) { int o = 0, ts = 0; for (int e = 0; e < NE; ++e) { const int cnt = (int)F.ctl[CW_CNT + l * 2048 + e * 64]; tab[e] = cnt; tab[32 + e] = o; tab[65 + e] = ts; o += cnt; ts += (cnt + 255) >> 8; } tab[64] = o; tab[97] = ts; }
    __syncthreads();
    return tab[97];
}
__device__ __forceinline__ void ph_moe1(const PArgs& a, Frame& F, int l) {
    const int ntiles = moe_tables(F, l);
    pg8::MoeSched<true, 8, 4> S; S.A = (const void*)(F.ws + WS_U); S.Bt = (const void*)(F.ws + WS_WGU + (size_t)l * 32 * 2048 * D); S.rowtok = (const int*)(F.ws + WS_ROWTOK);
    S.PB = D; S.G = F.G; S.c = F.bid; S.ntiles = ntiles; S.tab = (const LAS int*)(F.lds + L_SCHED); S.bstride = 2048;
    pg8::EpiSwiglu E{(unsigned char*)(F.ws + WS_ACT), a.in[37] + (size_t)l * 32 * 2048, (unsigned char*)(F.ws + WS_DUMMY) + F.tid * 16};
    pg8::gemm_phase<pg8::EpiSwiglu, pg8::MoeSched<true, 8, 4>, true>(F.lds, S, E);
}
__device__ __forceinline__ void ph_moe2(const PArgs& a, Frame& F, int l) {
    const int ntiles = moe_tables(F, l);
    pg8::MoeSched<false, 4, 8> S; S.A = (const void*)(F.ws + WS_ACT); S.Bt = (const void*)(F.ws + WS_WDN + (size_t)l * 32 * D * DFF); S.rowtok = nullptr;
    S.PB = DFF; S.G = F.G; S.c = F.bid; S.ntiles = ntiles; S.tab = (const LAS int*)(F.lds + L_SCHED); S.bstride = 1024;
    pg8::EpiDown E{(unsigned char*)(F.ws + WS_YBUF), a.in[39] + (size_t)l * 32 * D, (const float*)(F.ws + WS_ROWGATE), (unsigned char*)(F.ws + WS_DUMMY) + F.tid * 16};
    pg8::gemm_phase<pg8::EpiDown, pg8::MoeSched<false, 4, 8>, true>(F.lds, S, E);
}
__device__ __forceinline__ void ph_gemm_plain_bf16(Frame& F, size_t wsA, size_t wsB, int N, int K, size_t wsO) {
    pg8::PlainSched S; S.init((const bf16*)(F.ws + wsA), (const bf16*)(F.ws + wsB), MTOK, N, K, F.G, F.bid);
    pg8::EpiBf16 E{(bf16*)(F.ws + wsO), N, 1.0f};
    pg8::gemm_phase<pg8::EpiBf16, pg8::PlainSched>(F.lds, S, E);
}
__device__ __forceinline__ void ph_gemm_plain_fp8(Frame& F, size_t wsA, size_t wsB, int N, int K, size_t wsO) {
    pg8::PlainSched S; S.init((const void*)(F.ws + wsA), (const void*)(F.ws + wsB), MTOK, N, K, F.G, F.bid, 1);
    pg8::EpiBf16 E{(bf16*)(F.ws + wsO), N == OD_GN ? OD_INP : N, pg8::WINV8};
    pg8::gemm_phase<pg8::EpiBf16, pg8::PlainSched, true>(F.lds, S, E);
}
template <bool HIN_F32>
__device__ __forceinline__ void ph_gemm_resid(Frame& F, size_t wsB, const GAS void* hin, bf16* hout, int l) {
    pg8::PlainSched S; S.init((const bf16*)(F.ws + WS_MIX), (const bf16*)(F.ws + wsB), MTOK, D, MIXW, F.G, F.bid);
    pg8::EpiResid<HIN_F32> E{hin, hout, (const float*)(F.ws + WS_MODF) + (size_t)l * 8 * 6144 + 2048};
    pg8::gemm_phase<pg8::EpiResid<HIN_F32>, pg8::PlainSched>(F.lds, S, E);
}

__global__ void __launch_bounds__(NTHR, 2) mk_fwd(Args args) {
    extern __shared__ __attribute__((aligned(16))) unsigned char lds_[];
    Frame F;
    F.lds = (LAS unsigned char*)lds_; F.tid = threadIdx.x; F.lane = F.tid & 63; F.wave = __builtin_amdgcn_readfirstlane(F.tid >> 6);
    F.G = gridDim.x; F.bid = blockIdx.x; F.ws = args.ws; F.ctl = (unsigned*)(args.ws + WS_CTL);
    const int lo = args.ph_lo, hi = args.ph_hi;
    volatile LAS unsigned* misc = (volatile LAS unsigned*)(F.lds + L_MISC);
    if (F.tid < 4) misc[F.tid] = 0u;
    __syncthreads();
    XcdBarrier bar; bar.bar = F.ctl + CW_BAR; bar.x = 0; bar.st = misc;
    if (hi - lo > 1) bar = xcd_barrier_post(F.ctl + CW_BAR, misc);
#define IN(k) (lo <= (k) && (k) < hi)
#define SEAM(k) do { if (IN(k) && IN((k) + 1)) xcd_barrier(bar); } while (0)
    bf16* H1 = (bf16*)(F.ws + WS_H1); bf16* H2 = (bf16*)(F.ws + WS_H2);
    PArgs pa; pa.in.p = (const float* const*)(const GAS unsigned char*)(F.ws + WS_ARGTAB);
    if (IN(0)) ph_prep(args, F);
    SEAM(0);
    if (IN(1)) ph_rows<0>(pa, F, 0);
    SEAM(1);
    if (IN(2)) ph_gemm_plain_bf16(F, WS_U, WS_WEVIN, EVEN_IN, D, WS_PROJ);
    SEAM(2);
    if (IN(3)) ph_ev_local(pa, F);
    SEAM(3);
    if (IN(4)) ph_ev_scan(pa, F);
    SEAM(4);
    if (IN(5)) ph_ev_out(pa, F);
    SEAM(5);
    if (IN(6)) ph_gemm_resid<true>(F, WS_WEVOUT, (const GAS void*)pa.in[0], H1, 0);
    SEAM(6);
    if (IN(7)) ph_route(pa, F, 0);
    SEAM(7);
    if (IN(8)) ph_moe1(pa, F, 0);
    SEAM(8);
    if (IN(9)) ph_moe2(pa, F, 0);
    SEAM(9);
    if (IN(10)) ph_rows<1>(pa, F, 0);
    SEAM(10);
    if (IN(11)) ph_gemm_plain_fp8(F, WS_U, WS_WODIN, OD_GN, D, WS_PROJ);
    SEAM(11);
    if (IN(12)) ph_od_local(pa, F);
    SEAM(12);
    if (IN(13)) ph_od_scan(pa, F);
    SEAM(13);
    if (IN(14)) ph_od_out(pa, F);
    SEAM(14);
    if (IN(15)) ph_gemm_resid<false>(F, WS_WODOUT, (const GAS void*)H2, H1, 1);
    SEAM(15);
    if (IN(16)) ph_route(pa, F, 1);
    SEAM(16);
    if (IN(17)) ph_moe1(pa, F, 1);
    SEAM(17);
    if (IN(18)) ph_moe2(pa, F, 1);
    SEAM(18);
    if (IN(19)) ph_rows<2>(pa, F, 1);
#undef IN
#undef SEAM
}

extern "C" void kernel_launch(void* const* d_in, const int* in_sizes, int n_in, void* d_out, int out_size, void* d_ws, size_t ws_size, hipStream_t stream) {
    static int grid = 0;
    if (grid == 0) {
        if (n_in != 41 || out_size != MTOK * D || ws_size < WS_END) { fprintf(stderr, "kernel_launch: unexpected shapes (n_in %d, out %d, ws %zu < %zu)\n", n_in, out_size, ws_size, (size_t)WS_END); grid = -1; return; }
        int dev = 0, cus = 0, per_cu = 0;
        if (hipGetDevice(&dev) != hipSuccess || hipDeviceGetAttribute(&cus, hipDeviceAttributeMultiprocessorCount, dev) != hipSuccess) { grid = -1; return; }
        if (hipFuncSetAttribute((const void*)mk_fwd, hipFuncAttributeMaxDynamicSharedMemorySize, LDS_BYTES) != hipSuccess) { fprintf(stderr, "kernel_launch: hipFuncSetAttribute failed\n"); grid = -1; return; }
        if (hipOccupancyMaxActiveBlocksPerMultiprocessor(&per_cu, (const void*)mk_fwd, NTHR, LDS_BYTES) != hipSuccess || per_cu < 1) fprintf(stderr, "kernel_launch: occupancy query says %d\n", per_cu);
        (void)hipGetLastError();
        grid = cus;
    }
    if (grid < 0) return;
    (void)hipMemsetAsync((char*)d_ws + WS_CTL, 0, CTL_ZERO_BYTES, stream);
    Args a{};
    for (int i = 0; i < 41; ++i) a.in[i] = (const float*)d_in[i];
    a.out = (float*)d_out; a.ws = (unsigned char*)d_ws;
#if MK_ONE_LAUNCH
    a.ph_lo = 0; a.ph_hi = NPH;
    hipLaunchKernelGGL(mk_fwd, dim3(grid), dim3(NTHR), LDS_BYTES, stream, a);
#else
    for (int k = 0; k < NPH; ++k) { a.ph_lo = k; a.ph_hi = k + 1; hipLaunchKernelGGL(mk_fwd, dim3(grid), dim3(NTHR), LDS_BYTES, stream, a); }
#endif
}
```
